# Optimizing an MI355X kernel written in HIP

```python
import math
import jax, jax.numpy as jnp
from jax import lax
import numpy as np

D_MODEL = 1024
BATCH = 8
SEQ = 2048
DEPTH = 4

GRID_W = 64
CTX_LEN = 256
N_EVEN = (DEPTH + 1) // 2
N_ODD = DEPTH // 2
MIX_WIDTH = D_MODEL
FFN_HIDDEN = ((8 * D_MODEL + 3 * 256 - 1) // (3 * 256)) * 256
S5_WIDTH = D_MODEL // 2
S5_GROUP = 16
S5_GROUPS = S5_WIDTH // S5_GROUP
S5_STATE = 64
HGRN_HEADS = 4
HGRN_HEAD_DIM = D_MODEL // 8
HGRN_WIDTH = HGRN_HEADS * HGRN_HEAD_DIM
HGRN_CHUNK = 64
MAX_EXP_ARG = 60.0
DIFF_HEADS = 4
DIFF_HEAD_DIM = D_MODEL // 16
DIFF_WIDTH = DIFF_HEADS * 2 * DIFF_HEAD_DIM
MLA_HEADS = 4
MLA_NOPE_DIM = D_MODEL // 8
MLA_ROPE_DIM = D_MODEL // 16
MLA_V_DIM = D_MODEL // 8
MLA_Q_RANK = 3 * D_MODEL // 8
MLA_KV_RANK = D_MODEL // 4
MLA_WIDTH = MLA_HEADS * MLA_V_DIM
ROPE_DIM = D_MODEL // 16
ROPE_BASE = 10000.0
Q_BLOCK = 128
EPS = 1e-6
AB_SPLITS = (S5_WIDTH, S5_WIDTH + HGRN_WIDTH, S5_WIDTH + 2 * HGRN_WIDTH, S5_WIDTH + 3 * HGRN_WIDTH, S5_WIDTH + 4 * HGRN_WIDTH)
AB_IN = S5_WIDTH + 5 * HGRN_WIDTH
CD_SPLITS = (DIFF_WIDTH, 2 * DIFF_WIDTH, 3 * DIFF_WIDTH, 3 * DIFF_WIDTH + MLA_Q_RANK, 3 * DIFF_WIDTH + MLA_Q_RANK + MLA_KV_RANK)
CD_IN = 3 * DIFF_WIDTH + MLA_Q_RANK + MLA_KV_RANK + MLA_ROPE_DIM

kernel_name = "hybrid_s5_hgrn2_diffattn_mla_dit"


def _rmsnorm(x, g):
    xf = x.astype(jnp.float32)
    y = xf * lax.rsqrt(jnp.mean(xf * xf, axis=-1, keepdims=True) + EPS)
    return (y * g.astype(jnp.float32)).astype(x.dtype)


def _modulate(x, shift, scale):
    return x * (1 + scale) + shift


def _swiglu(a, w_in, w_out):
    gate, up = jnp.split(a @ w_in, 2, axis=-1)
    return (jax.nn.silu(gate) * up) @ w_out


def _rope_tables(rows, cols):
    n_freq = ROPE_DIM // 4
    inv = jnp.power(ROPE_BASE, -jnp.arange(n_freq, dtype=jnp.float32) / n_freq)
    ang_r = rows.astype(jnp.float32)[:, None] * inv
    ang_c = cols.astype(jnp.float32)[:, None] * inv
    ang = jnp.concatenate([ang_r, ang_r, ang_c, ang_c], axis=-1)
    return jnp.cos(ang), jnp.sin(ang)


def _apply_rope(x, cos, sin):
    xr = x.reshape(x.shape[:-1] + (2, 2, ROPE_DIM // 4))
    rot = jnp.concatenate([-xr[..., 1:2, :], xr[..., 0:1, :]], axis=-2).reshape(x.shape)
    out = x.astype(jnp.float32) * cos[None, :, None, :] + rot.astype(jnp.float32) * sin[None, :, None, :]
    return out.astype(x.dtype)


def _sweep_query_blocks(fn, *qs):
    b, l = qs[0].shape[:2]
    nb = l // Q_BLOCK
    blocks = tuple(jnp.moveaxis(q.reshape((b, nb, Q_BLOCK) + q.shape[2:]), 1, 0) for q in qs)
    out = lax.map(lambda blk: fn(*blk), blocks)
    return jnp.moveaxis(out, 0, 1).reshape((b, l) + out.shape[3:])


def _softmax_attention(q, k, v, scale):
    def blk(bq):
        s = jnp.einsum('bqhd,bkhd->bhqk', bq, k).astype(jnp.float32) * scale
        p = jax.nn.softmax(s, axis=-1)
        return jnp.einsum('bhqk,bkhe->bqhe', p.astype(v.dtype), v)
    return _sweep_query_blocks(blk, q)


def _diff_attention(q1, q2, k1, k2, v, lam):
    scale = DIFF_HEAD_DIM ** -0.5
    def blk(b1, b2):
        s1 = jnp.einsum('bqhd,bkhd->bhqk', b1, k1).astype(jnp.float32) * scale
        s2 = jnp.einsum('bqhd,bkhd->bhqk', b2, k2).astype(jnp.float32) * scale
        p = jax.nn.softmax(s1, axis=-1) - lam * jax.nn.softmax(s2, axis=-1)
        return jnp.einsum('bhqk,bkhe->bqhe', p.astype(v.dtype), v)
    return _sweep_query_blocks(blk, q1, q2)


def _s5_discretize(lam_re, lam_im, log_step, b_re, b_im):
    lr = jnp.minimum(lam_re.astype(jnp.float32), -1e-4)
    li = lam_im.astype(jnp.float32)
    step = jnp.exp(log_step.astype(jnp.float32))[:, None]
    mag = jnp.exp(lr * step)
    a_r = mag * jnp.cos(li * step)
    a_i = mag * jnp.sin(li * step)
    den = lr * lr + li * li
    coef_r = ((a_r - 1) * lr + a_i * li) / den
    coef_i = (a_i * lr - (a_r - 1) * li) / den
    br = b_re.astype(jnp.float32)
    bi = b_im.astype(jnp.float32)
    bb_r = coef_r[..., None] * br - coef_i[..., None] * bi
    bb_i = coef_r[..., None] * bi + coef_i[..., None] * br
    return a_r, a_i, bb_r, bb_i


def _complex_affine_combine(e1, e2):
    a1r, a1i, b1r, b1i = e1
    a2r, a2i, b2r, b2i = e2
    return (a2r * a1r - a2i * a1i, a2r * a1i + a2i * a1r,
            a2r * b1r - a2i * b1i + b2r, a2r * b1i + a2i * b1r + b2i)


def _s5_scan(u, a_r, a_i, bb_r, bb_i, h0_r, h0_i):
    bu_r = jnp.einsum('blgc,gpc->blgp', u, bb_r)
    bu_i = jnp.einsum('blgc,gpc->blgp', u, bb_i)
    bu_r = bu_r.at[:, 0].add(a_r * h0_r - a_i * h0_i)
    bu_i = bu_i.at[:, 0].add(a_r * h0_i + a_i * h0_r)
    l = u.shape[1]
    ar = jnp.broadcast_to(a_r, (1, l) + a_r.shape)
    ai = jnp.broadcast_to(a_i, (1, l) + a_i.shape)
    _, _, h_r, h_i = lax.associative_scan(_complex_affine_combine, (ar, ai, bu_r, bu_i), axis=1)
    return h_r, h_i


def _s5_readout(h_r, h_i, c_re, c_im):
    return jnp.einsum('blgp,gcp->blgc', h_r, c_re) - jnp.einsum('blgp,gcp->blgc', h_i, c_im)


def _s5_mixer(ux, uc, lam_re, lam_im, log_step, b_re, b_im, c_re, c_im, d_skip, glu_w, glu_b, need_ctx):
    def groups(u):
        return u.astype(jnp.float32).reshape(u.shape[:2] + (S5_GROUPS, S5_GROUP))
    gx, gc = groups(ux), groups(uc)
    d_g = d_skip.astype(jnp.float32).reshape(S5_GROUPS, S5_GROUP)
    zeros = jnp.zeros((ux.shape[0], S5_GROUPS, S5_STATE), jnp.float32)
    y_x = gx * d_g
    y_c = gc * d_g
    for d in range(2):
        a_r, a_i, bb_r, bb_i = _s5_discretize(lam_re[d], lam_im[d], log_step[d], b_re[d], b_im[d])
        cr, ci = c_re[d].astype(jnp.float32), c_im[d].astype(jnp.float32)
        flip = d == 1
        def orient(t):
            return jnp.flip(t, axis=1) if flip else t
        hc_r, hc_i = _s5_scan(orient(gc), a_r, a_i, bb_r, bb_i, zeros, zeros)
        hx_r, hx_i = _s5_scan(orient(gx), a_r, a_i, bb_r, bb_i, hc_r[:, -1], hc_i[:, -1])
        y_x = y_x + orient(_s5_readout(hx_r, hx_i, cr, ci))
        if need_ctx:
            y_c = y_c + orient(_s5_readout(hc_r, hc_i, cr, ci))
    def glu(y):
        z = jax.nn.gelu(y.reshape(y.shape[:2] + (S5_WIDTH,)))
        return z * jax.nn.sigmoid(z @ glu_w.astype(jnp.float32) + glu_b.astype(jnp.float32))
    out_x = glu(y_x).astype(ux.dtype)
    out_c = glu(y_c).astype(uc.dtype) if need_ctx else None
    return out_x, out_c


def _gla_chunk_scan(q, k, log_f, v, s0):
    b, l, h, _ = q.shape
    dv = v.shape[-1]
    n = l // HGRN_CHUNK
    def chunks(t):
        return t.reshape(b, n, HGRN_CHUNK, h, t.shape[-1]).transpose(1, 0, 3, 2, 4)
    seen = jnp.tril(jnp.ones((HGRN_CHUNK, HGRN_CHUNK), dtype=bool))[None, None, :, :, None]
    def step(state, inp):
        qc, kc, gc, vc = inp
        cum = jnp.cumsum(gc, axis=2)
        inter = jnp.einsum('bhtk,bhkv->bhtv', qc * jnp.exp(cum), state)
        rel = cum[:, :, :, None, :] - cum[:, :, None, :, :]
        decay = jnp.where(seen, jnp.exp(jnp.where(seen, rel, 0.0)), 0.0)
        scores = jnp.einsum('bhtk,bhsk,bhtsk->bhts', qc, kc, decay)
        intra = jnp.einsum('bhts,bhsv->bhtv', scores, vc)
        last = cum[:, :, -1:, :]
        new_state = (jnp.exp(last[:, :, 0, :])[..., None] * state
                     + jnp.einsum('bhsk,bhsv->bhkv', kc * jnp.exp(last - cum), vc))
        return new_state, inter + intra
    s_fin, o = lax.scan(step, s0, (chunks(q), chunks(k), chunks(log_f), chunks(v)))
    o = o.transpose(1, 0, 3, 2, 4).reshape(b, l, h, dv)
    return o, s_fin


def _hgrn2_mixer(qx, qc, ffx, ffc, fbx, fbc, ix, ic, gx, gc, lb, out_norm, need_ctx):
    def heads(t):
        return t.astype(jnp.float32).reshape(t.shape[:2] + (HGRN_HEADS, HGRN_HEAD_DIM))
    lb_h = lb.reshape(HGRN_HEADS, HGRN_HEAD_DIM)
    def gates(fl):
        fl = heads(fl)
        k = (1 - lb_h) * jax.nn.sigmoid(-fl)
        log_f = jax.nn.log_sigmoid(fl) + jnp.log1p(lb_h * jnp.exp(jnp.minimum(-fl, MAX_EXP_ARG)))
        return k, log_f
    q_x, q_c = jax.nn.silu(heads(qx)), jax.nn.silu(heads(qc))
    i_x, i_c = heads(ix), heads(ic)
    s0 = jnp.zeros((qx.shape[0], HGRN_HEADS, HGRN_HEAD_DIM, HGRN_HEAD_DIM), jnp.float32)
    o_x_parts, o_c_parts = [], []
    for d, (f_x, f_c) in enumerate(((ffx, ffc), (fbx, fbc))):
        flip = d == 1
        def orient(t):
            return jnp.flip(t, axis=1) if flip else t
        k_x, lf_x = gates(f_x)
        k_c, lf_c = gates(f_c)
        o_c, s_ctx = _gla_chunk_scan(orient(q_c), orient(k_c), orient(lf_c), orient(i_c), s0)
        o_x, _ = _gla_chunk_scan(orient(q_x), orient(k_x), orient(lf_x), orient(i_x), s_ctx)
        o_x_parts.append(orient(o_x))
        o_c_parts.append(orient(o_c))
    def readout(o, g):
        y = _rmsnorm(o, out_norm) * jax.nn.silu(heads(g))
        return y.reshape(o.shape[:2] + (HGRN_WIDTH,)).astype(g.dtype)
    out_x = readout(o_x_parts[0] + o_x_parts[1], gx)
    out_c = readout(o_c_parts[0] + o_c_parts[1], gc) if need_ctx else None
    return out_x, out_c


def _even_mixer(ax, ac, w_in, lam_re, lam_im, log_step, b_re, b_im, c_re, c_im, d_skip, glu_w, glu_b,
                lb, out_norm, need_ctx):
    ux, qx, ffx, fbx, ix, gx = jnp.split(ax @ w_in, AB_SPLITS, axis=-1)
    uc, qc, ffc, fbc, ic, gc = jnp.split(ac @ w_in, AB_SPLITS, axis=-1)
    s5x, s5c = _s5_mixer(ux, uc, lam_re, lam_im, log_step, b_re, b_im, c_re, c_im, d_skip, glu_w, glu_b, need_ctx)
    hx, hc = _hgrn2_mixer(qx, qc, ffx, ffc, fbx, fbc, ix, ic, gx, gc, lb, out_norm, need_ctx)
    out_x = jnp.concatenate([s5x, hx], axis=-1)
    out_c = jnp.concatenate([s5c, hc], axis=-1) if need_ctx else None
    return out_x, out_c


def _odd_mixer(ax, ac, w_in, lam_vec, lam_init, qk_norm, subln, q_a_norm, kv_a_norm, w_uq, w_ukv,
               nope_norm, rope_norm, cos, sin, need_ctx):
    dqx, dkx, dvx, cqx, ckvx, krx = jnp.split(ax @ w_in, CD_SPLITS, axis=-1)
    dqc, dkc, dvc, cqc, ckvc, krc = jnp.split(ac @ w_in, CD_SPLITS, axis=-1)
    lv = lam_vec.astype(jnp.float32)
    lam = jnp.exp(jnp.sum(lv[0] * lv[1])) - jnp.exp(jnp.sum(lv[2] * lv[3])) + lam_init

    def diff_q(p, rope):
        q = _rmsnorm(p.reshape(p.shape[:2] + (DIFF_HEADS, 2, DIFF_HEAD_DIM)), qk_norm[0])
        q1, q2 = q[..., 0, :], q[..., 1, :]
        if rope:
            q1, q2 = _apply_rope(q1, cos, sin), _apply_rope(q2, cos, sin)
        return q1, q2

    def diff_kv(pk, pv, rope):
        k = _rmsnorm(pk.reshape(pk.shape[:2] + (DIFF_HEADS, 2, DIFF_HEAD_DIM)), qk_norm[1])
        k1, k2 = k[..., 0, :], k[..., 1, :]
        if rope:
            k1, k2 = _apply_rope(k1, cos, sin), _apply_rope(k2, cos, sin)
        return k1, k2, pv.reshape(pv.shape[:2] + (DIFF_HEADS, 2 * DIFF_HEAD_DIM))

    def mla_q(cq, rope):
        q = (_rmsnorm(cq, q_a_norm) @ w_uq).reshape(cq.shape[:2] + (MLA_HEADS, MLA_NOPE_DIM + MLA_ROPE_DIM))
        q_nope = _rmsnorm(q[..., :MLA_NOPE_DIM], nope_norm[0])
        q_rope = _rmsnorm(q[..., MLA_NOPE_DIM:], rope_norm[0])
        if rope:
            q_rope = _apply_rope(q_rope, cos, sin)
        return jnp.concatenate([q_nope, q_rope], axis=-1)

    def mla_kv(ckv, kr, rope):
        shp = ckv.shape[:2]
        kv = (_rmsnorm(ckv, kv_a_norm) @ w_ukv).reshape(shp + (MLA_HEADS, MLA_NOPE_DIM + MLA_V_DIM))
        k_nope = _rmsnorm(kv[..., :MLA_NOPE_DIM], nope_norm[1])
        k_rope = _rmsnorm(kr[:, :, None, :], rope_norm[1])
        if rope:
            k_rope = _apply_rope(k_rope, cos, sin)
        k = jnp.concatenate([k_nope, jnp.broadcast_to(k_rope, shp + (MLA_HEADS, MLA_ROPE_DIM))], axis=-1)
        return k, kv[..., MLA_NOPE_DIM:]

    def cat(a, b):
        return jnp.concatenate([a, b], axis=1)

    def diff_out(o):
        return (_rmsnorm(o, subln) * (1.0 - lam_init)).reshape(o.shape[:2] + (DIFF_WIDTH,))

    mla_scale = (MLA_NOPE_DIM + MLA_ROPE_DIM) ** -0.5
    k1c, k2c, vc = diff_kv(dkc, dvc, False)
    k1x, k2x, vx = diff_kv(dkx, dvx, True)
    mkc, mvc = mla_kv(ckvc, krc, False)
    mkx, mvx = mla_kv(ckvx, krx, True)
    q1x, q2x = diff_q(dqx, True)
    c_out_x = diff_out(_diff_attention(q1x, q2x, cat(k1c, k1x), cat(k2c, k2x), cat(vc, vx), lam))
    d_out_x = _softmax_attention(mla_q(cqx, True), cat(mkc, mkx), cat(mvc, mvx), mla_scale)
    out_x = jnp.concatenate([c_out_x, d_out_x.reshape(cqx.shape[:2] + (MLA_WIDTH,))], axis=-1)
    out_c = None
    if need_ctx:
        q1c, q2c = diff_q(dqc, False)
        c_out_c = diff_out(_diff_attention(q1c, q2c, k1c, k2c, vc, lam))
        d_out_c = _softmax_attention(mla_q(cqc, False), mkc, mvc, mla_scale)
        out_c = jnp.concatenate([c_out_c, d_out_c.reshape(cqc.shape[:2] + (MLA_WIDTH,))], axis=-1)
    return out_x, out_c


def setup_inputs(seed: int = 0) -> dict:
    key = jax.random.key(seed)
    ks = iter(jax.random.split(key, 34))
    f32 = jnp.float32

    def nrm(shape, std):
        return std * jax.random.normal(next(ks), shape, f32)

    def gain(shape):
        return 1.0 + nrm(shape, 0.1)

    inputs = {
        "x": nrm((BATCH, SEQ, D_MODEL), 1.0),
        "c": nrm((BATCH, D_MODEL), 1.0),
        "ctx": nrm((BATCH, CTX_LEN, D_MODEL), 1.0),
        "c_ctx": nrm((D_MODEL,), 1.0),
        "ada_w": nrm((DEPTH, D_MODEL, 6 * D_MODEL), 0.5 * D_MODEL ** -0.5),
        "ada_b": nrm((DEPTH, 6 * D_MODEL), 0.02),
        "norm_mix": gain((DEPTH, D_MODEL)),
        "norm_ffn": gain((DEPTH, D_MODEL)),
        "w_out": nrm((DEPTH, MIX_WIDTH, D_MODEL), MIX_WIDTH ** -0.5),
        "ffn_w_in": nrm((DEPTH, D_MODEL, 2 * FFN_HIDDEN), D_MODEL ** -0.5),
        "ffn_w_out": nrm((DEPTH, FFN_HIDDEN, D_MODEL), FFN_HIDDEN ** -0.5),
        "ab_w_in": nrm((N_EVEN, D_MODEL, AB_IN), D_MODEL ** -0.5),
        "s5_lambda_re": -0.5 + nrm((N_EVEN, 2, S5_GROUPS, S5_STATE), 0.01),
        "s5_lambda_im": jnp.pi * jnp.arange(S5_STATE, dtype=f32) + nrm((N_EVEN, 2, S5_GROUPS, S5_STATE), 0.01),
        "s5_log_step": jax.random.uniform(next(ks), (N_EVEN, 2, S5_GROUPS), f32, math.log(1e-3), math.log(1e-1)),
        "s5_b_re": nrm((N_EVEN, 2, S5_GROUPS, S5_STATE, S5_GROUP), (2 * S5_GROUP) ** -0.5),
        "s5_b_im": nrm((N_EVEN, 2, S5_GROUPS, S5_STATE, S5_GROUP), (2 * S5_GROUP) ** -0.5),
        "s5_c_re": nrm((N_EVEN, 2, S5_GROUPS, S5_GROUP, S5_STATE), (2 * S5_STATE) ** -0.5),
        "s5_c_im": nrm((N_EVEN, 2, S5_GROUPS, S5_GROUP, S5_STATE), (2 * S5_STATE) ** -0.5),
        "s5_d": nrm((N_EVEN, S5_WIDTH), 1.0),
        "s5_glu_w": nrm((N_EVEN, S5_WIDTH, S5_WIDTH), S5_WIDTH ** -0.5),
        "s5_glu_b": nrm((N_EVEN, S5_WIDTH), 0.02),
        "hgrn_lb_logits": nrm((N_EVEN, HGRN_WIDTH), 0.5),
        "hgrn_out_norm": gain((N_EVEN, HGRN_HEAD_DIM)),
        "cd_w_in": nrm((N_ODD, D_MODEL, CD_IN), D_MODEL ** -0.5),
        "diff_lambda": nrm((N_ODD, 4, DIFF_HEAD_DIM), 0.1),
        "diff_qk_norm": gain((N_ODD, 2, DIFF_HEAD_DIM)),
        "diff_subln": gain((N_ODD, 2 * DIFF_HEAD_DIM)),
        "mla_q_a_norm": gain((N_ODD, MLA_Q_RANK)),
        "mla_kv_a_norm": gain((N_ODD, MLA_KV_RANK)),
        "mla_w_uq": nrm((N_ODD, MLA_Q_RANK, MLA_HEADS * (MLA_NOPE_DIM + MLA_ROPE_DIM)), MLA_Q_RANK ** -0.5),
        "mla_w_ukv": nrm((N_ODD, MLA_KV_RANK, MLA_HEADS * (MLA_NOPE_DIM + MLA_V_DIM)), MLA_KV_RANK ** -0.5),
        "mla_nope_norm": gain((N_ODD, 2, MLA_NOPE_DIM)),
        "mla_rope_norm": gain((N_ODD, 2, MLA_ROPE_DIM)),
    }
    return inputs


def reference(x, c, ctx, c_ctx, ada_w, ada_b, norm_mix, norm_ffn, w_out, ffn_w_in, ffn_w_out, ab_w_in,
              s5_lambda_re, s5_lambda_im, s5_log_step, s5_b_re, s5_b_im, s5_c_re, s5_c_im, s5_d, s5_glu_w,
              s5_glu_b, hgrn_lb_logits, hgrn_out_norm, cd_w_in, diff_lambda, diff_qk_norm, diff_subln,
              mla_q_a_norm, mla_kv_a_norm, mla_w_uq, mla_w_ukv, mla_nope_norm, mla_rope_norm):
    n_tok = x.shape[1]
    ROWS = n_tok // GRID_W
    rows = jnp.repeat(jnp.arange(ROWS, dtype=jnp.int32), GRID_W)
    cols = jnp.tile(jnp.arange(GRID_W, dtype=jnp.int32), ROWS)
    cos, sin = _rope_tables(rows, cols)

    lb_p = jax.nn.softmax(hgrn_lb_logits.astype(jnp.float32), axis=0)
    lower_bounds = jnp.cumsum(lb_p, axis=0) - lb_p[0:1]

    sc = jax.nn.silu(c)
    scc = jax.nn.silu(c_ctx)
    h, hc = x, ctx
    for l in range(DEPTH):
        need_ctx = l < DEPTH - 1
        mod_x = jnp.split((sc @ ada_w[l] + ada_b[l])[:, None, :], 6, axis=-1)
        mod_c = jnp.split((scc @ ada_w[l] + ada_b[l])[None, None, :], 6, axis=-1)
        ax = _modulate(_rmsnorm(h, norm_mix[l]), mod_x[0], mod_x[1])
        ac = _modulate(_rmsnorm(hc, norm_mix[l]), mod_c[0], mod_c[1])
        if l % 2 == 0:
            e = l // 2
            mx, mc = _even_mixer(ax, ac, ab_w_in[e], s5_lambda_re[e], s5_lambda_im[e], s5_log_step[e],
                                 s5_b_re[e], s5_b_im[e], s5_c_re[e], s5_c_im[e], s5_d[e], s5_glu_w[e],
                                 s5_glu_b[e], lower_bounds[e], hgrn_out_norm[e], need_ctx)
        else:
            o = l // 2
            lam_init = 0.8 - 0.6 * math.exp(-0.3 * l)
            mx, mc = _odd_mixer(ax, ac, cd_w_in[o], diff_lambda[o], lam_init, diff_qk_norm[o], diff_subln[o],
                                mla_q_a_norm[o], mla_kv_a_norm[o], mla_w_uq[o], mla_w_ukv[o],
                                mla_nope_norm[o], mla_rope_norm[o], cos, sin, need_ctx)
        h = h + mod_x[2] * (mx @ w_out[l])
        h = h + mod_x[5] * _swiglu(_modulate(_rmsnorm(h, norm_ffn[l]), mod_x[3], mod_x[4]), ffn_w_in[l], ffn_w_out[l])
        if need_ctx:
            hc = hc + mod_c[2] * (mc @ w_out[l])
            hc = hc + mod_c[5] * _swiglu(_modulate(_rmsnorm(hc, norm_ffn[l]), mod_c[3], mod_c[4]), ffn_w_in[l], ffn_w_out[l])
    return h
```

```cpp
#include <hip/hip_runtime.h>
#include <hip/hip_cooperative_groups.h>
#include <cstdio>
namespace cg = cooperative_groups;
#ifndef MK_MODE
#define MK_MODE 0
#endif
__device__ __forceinline__ int mk_tid() { int t = threadIdx.x; asm volatile("" : "+v"(t)); return t; }
namespace pg8 {
#define PG8_LAS __attribute__((address_space(3)))
typedef unsigned short bf16_t;
typedef short bf16x8 __attribute__((ext_vector_type(8)));
typedef float f32x4 __attribute__((ext_vector_type(4)));
typedef unsigned u32x4 __attribute__((ext_vector_type(4)));
constexpr int BM = 256, BK = 64, HALF = 128, HTB = HALF * BK * 2  , STAGE_BYTES = 8 * HTB, NXCD = 8, WGM = 8;

__host__ __device__ __forceinline__ int lds_byte(int r, int c) { const int st = (r >> 4) * 2 + (c >> 5), rr = r & 15, cc = c & 31, ob = rr * 64 + cc * 2; return st * 1024 + (ob ^ (((ob >> 9) & 1) << 5)); }
__host__ __device__ __forceinline__ void stage_rc(int b, int& R, int& C) { const int st = b / 1024, sb = b % 1024, swz = sb ^ (((sb >> 9) & 1) << 5); R = (st >> 1) * 16 + swz / 64; C = (st & 1) * 32 + (swz % 64) / 2; }
__host__ __device__ __forceinline__ int perm32(int rho) { const int n = rho >> 4, i = rho & 15; return 8 * (i >> 2) + 4 * n + (i & 3); }

struct Unit { int pm, pn; };
struct Gemm { const bf16_t* A; const bf16_t* Bt; int M, N, K; };

struct StaticOrder {
    int nM, nN, nwg, G, c;
    __host__ __device__ void init(int M, int N, int G_, int c_) { nM = M / BM; nN = N / BM; nwg = nM * nN; G = G_; c = c_; }
    __host__ __device__ bool next(int i, Unit& u) const {
        const long L = (long)i * G + c; if (L >= nwg) return false;
        int wgid = (int)L; { const int q = nwg / NXCD, r = nwg % NXCD, xcd = wgid % NXCD, off = wgid / NXCD; wgid = (xcd < r ? xcd * (q + 1) : r * (q + 1) + (xcd - r) * q) + off; }
        const int nig = WGM * nN, gid = wgid / nig, fm = gid * WGM, gsz = (nM - fm) < WGM ? (nM - fm) : WGM;
        u.pm = fm + ((wgid % nig) % gsz); u.pn = (wgid % nig) / gsz; return true;
    }
    __device__ __forceinline__ void a_ready(const Unit&) const {}
    __device__ __forceinline__ void done(const Unit&) const {}
};
__device__ __forceinline__ unsigned cvt_pk_bf16(float lo, float hi) { unsigned r; asm volatile("v_cvt_pk_bf16_f32 %0, %1, %2" : "=v"(r) : "v"(lo), "v"(hi)); return r; }
typedef float f32x2 __attribute__((ext_vector_type(2)));
template <class Epi, class Sched, bool STAMP = false>
__device__ __forceinline__ void gemm_phase(PG8_LAS unsigned char* lds, const Gemm g, const Sched& S, const Epi& E, unsigned long long* stamps) {
    const int tid = mk_tid(), wid = __builtin_amdgcn_readfirstlane(tid >> 6), lane = tid & 63, wr = wid >> 2, wc = wid & 3, fr = lane & 15, fq = lane >> 4;
    const int K = g.K, nt = K / BK;
    int ts_lo = 0, ts_hi = 0, nts = 0; const unsigned long long rt_entry = STAMP ? (unsigned long long)wall_clock64() : 0ull;
#define PG8_STAMP() do { if (STAMP && wid == 0 && nts < 64) { const unsigned long long _c = (unsigned long long)clock64(); \
        ts_lo = (lane == nts) ? (int)(unsigned)_c : ts_lo; ts_hi = (lane == nts) ? (int)(unsigned)(_c >> 32) : ts_hi; ++nts; } } while (0)
    PG8_STAMP();
    unsigned voffA[2], voffB[2];
#pragma unroll
    for (int i = 0; i < 2; ++i) { int R, C; stage_rc(tid * 16 + i * 8192, R, C); const int Rb = Epi::PERM ? ((R & ~31) + perm32(R & 31)) : R;
        voffA[i] = (unsigned)(R * K + C) * 2u; voffB[i] = (unsigned)(Rb * K + C) * 2u; }
    const size_t kstep = (size_t)(BK * 2);
    const size_t hstep = (size_t)HALF * K * 2;
    const size_t tstep = 2 * hstep;
    const unsigned ldsw = (unsigned)wid * 1024u;
    const int aoff = lds_byte(wr * 64 + fr, fq * 8), boff = lds_byte(wc * 32 + fr, fq * 8);
#define PG8_SA(b, h) (((b) * 2 + (h)) * HTB)
#define PG8_SB(b, h) ((4 + (b) * 2 + (h)) * HTB)
#define PG8_STAGE(bufoff, gbase, voff) do { _Pragma("unroll") for (int _i = 0; _i < 2; ++_i) \
        __builtin_amdgcn_global_load_lds((const unsigned*)((const char*)(gbase) + (voff)[_i]), (PG8_LAS unsigned*)(lds + (bufoff) + ldsw + _i * 8192), 16, 0, 0); } while (0)
#define PG8_LDA(dst, b, h) do { _Pragma("unroll") for (int m = 0; m < 4; ++m) _Pragma("unroll") for (int k = 0; k < 2; ++k) dst[m][k] = *(const PG8_LAS bf16x8*)(lds + PG8_SA(b, h) + aoff + m * 2048 + k * 1024); } while (0)
#define PG8_LDB(dst, b, h) do { _Pragma("unroll") for (int n = 0; n < 2; ++n) _Pragma("unroll") for (int k = 0; k < 2; ++k) dst[n][k] = *(const PG8_LAS bf16x8*)(lds + PG8_SB(b, h) + boff + n * 2048 + k * 1024); } while (0)
#define PG8_MMA(ai, bj, At, Bt) do { __builtin_amdgcn_s_setprio(1); _Pragma("unroll") for (int m = 0; m < 4; ++m) _Pragma("unroll") for (int n = 0; n < 2; ++n) _Pragma("unroll") for (int k = 0; k < 2; ++k) \
        acc[ai][bj][m][n] = __builtin_amdgcn_mfma_f32_16x16x32_bf16(Bt[n][k], At[m][k], acc[ai][bj][m][n], 0, 0, 0); __builtin_amdgcn_s_setprio(0); } while (0)
#define PG8_WAIT_V(n) asm volatile("s_waitcnt vmcnt(" #n ")" ::: "memory")
#define PG8_WAIT_L(n) asm volatile("s_waitcnt lgkmcnt(" #n ")" ::: "memory")
#define PG8_BAR __builtin_amdgcn_s_barrier()
#define PG8_SCHED __builtin_amdgcn_sched_barrier(0)
    Unit cur, nxt; int ui = 0;
    if (!S.next(0, cur)) return;
    f32x4 acc[2][2][4][2];
#pragma unroll
    for (int a = 0; a < 2; ++a)
#pragma unroll
        for (int b = 0; b < 2; ++b)
#pragma unroll
            for (int m = 0; m < 4; ++m)
#pragma unroll
                for (int n = 0; n < 2; ++n) acc[a][b][m][n] = (f32x4){0.f, 0.f, 0.f, 0.f};
    bf16x8 At[4][2], B0[2][2], B1[2][2];
    const char* cA = (const char*)g.A + (size_t)cur.pm * tstep; const char* cB = (const char*)g.Bt + (size_t)cur.pn * tstep;
    S.a_ready(cur);
    PG8_STAGE(PG8_SB(0, 0), cB, voffB); PG8_STAGE(PG8_SA(0, 0), cA, voffA); PG8_STAGE(PG8_SB(0, 1), cB + hstep, voffB); PG8_STAGE(PG8_SA(0, 1), cA + hstep, voffA);
    if (wr == 1) PG8_BAR;
    PG8_WAIT_V(4); PG8_BAR;
    PG8_STAGE(PG8_SB(1, 0), cB + kstep, voffB); PG8_STAGE(PG8_SA(1, 0), cA + kstep, voffA); PG8_STAGE(PG8_SB(1, 1), cB + hstep + kstep, voffB);
    PG8_WAIT_V(6); PG8_BAR;
    PG8_STAMP();
    for (;;) {
        const bool has_next = S.next(ui + 1, nxt);
        const char* nA = has_next ? (const char*)g.A + (size_t)nxt.pm * tstep : cA; const char* nB = has_next ? (const char*)g.Bt + (size_t)nxt.pn * tstep : cB;
        for (int t = 0; t < nt; t += 2) {
            const bool last = (t == nt - 2);
            const char* a1 = cA + (size_t)(t + 1) * kstep;
            const char* a2 = last ? nA : cA + (size_t)(t + 2) * kstep; const char* b2 = last ? nB : cB + (size_t)(t + 2) * kstep;
            const char* a3 = a2 + kstep; const char* b3 = b2 + kstep;
            if (last && has_next) S.a_ready(nxt);
            PG8_LDB(B0, 0, 0); PG8_SCHED; PG8_LDA(At, 0, 0); PG8_STAGE(PG8_SA(1, 1), a1 + hstep, voffA);
            PG8_WAIT_L(8); PG8_BAR; PG8_WAIT_L(0); PG8_MMA(0, 0, At, B0); PG8_BAR; PG8_SCHED;
            PG8_LDB(B1, 0, 1); PG8_STAGE(PG8_SB(0, 0), b2, voffB);
            PG8_BAR; PG8_WAIT_L(0); PG8_MMA(0, 1, At, B1); PG8_BAR;
            PG8_LDA(At, 0, 1); PG8_STAGE(PG8_SA(0, 0), a2, voffA);
            PG8_BAR; PG8_WAIT_L(0); PG8_MMA(1, 0, At, B0); PG8_BAR; PG8_SCHED;
            PG8_STAGE(PG8_SB(0, 1), b2 + hstep, voffB);
            PG8_WAIT_V(6); PG8_BAR; PG8_MMA(1, 1, At, B1); PG8_BAR;
            PG8_LDB(B0, 1, 0); PG8_SCHED; PG8_LDA(At, 1, 0); PG8_STAGE(PG8_SA(0, 1), a2 + hstep, voffA);
            PG8_WAIT_L(8); PG8_BAR; PG8_WAIT_L(0); PG8_MMA(0, 0, At, B0); PG8_BAR; PG8_SCHED;
            PG8_LDB(B1, 1, 1); PG8_STAGE(PG8_SB(1, 0), b3, voffB);
            PG8_BAR; PG8_WAIT_L(0); PG8_MMA(0, 1, At, B1); PG8_BAR;
            PG8_LDA(At, 1, 1); PG8_STAGE(PG8_SA(1, 0), a3, voffA);
            PG8_BAR; PG8_WAIT_L(0); PG8_MMA(1, 0, At, B0); PG8_BAR; PG8_SCHED;
            PG8_STAGE(PG8_SB(1, 1), b3 + hstep, voffB);
            PG8_WAIT_V(6); PG8_BAR; PG8_MMA(1, 1, At, B1); PG8_BAR;
        }
        PG8_STAMP();
        if constexpr (!Epi::AFTER_DRAIN) { E(acc, cur, wr, wc, fr, fq); S.done(cur); }
        PG8_STAMP();
        if (!has_next) break;
#pragma unroll
        for (int a = 0; a < 2; ++a)
#pragma unroll
            for (int b = 0; b < 2; ++b)
#pragma unroll
                for (int m = 0; m < 4; ++m)
#pragma unroll
                    for (int n = 0; n < 2; ++n) acc[a][b][m][n] = (f32x4){0.f, 0.f, 0.f, 0.f};
        cur = nxt; cA = nA; cB = nB; ++ui;
    }
    PG8_WAIT_V(0);
    if (wr == 0) PG8_BAR;
    PG8_BAR;
    if constexpr (Epi::AFTER_DRAIN) { E.fused(acc, cur, wr, wc, fr, fq, lds, wid, lane); S.done(cur); }
    PG8_STAMP();
    if (STAMP && wid == 0) { stamps[lane] = lane < nts ? (((unsigned long long)(unsigned)ts_hi << 32) | (unsigned)ts_lo) : 0ull;
        if (lane == 62) stamps[62] = rt_entry; if (lane == 63) stamps[63] = (unsigned long long)wall_clock64(); }
#undef PG8_STAMP
#undef PG8_SA
#undef PG8_SB
#undef PG8_STAGE
#undef PG8_LDA
#undef PG8_LDB
#undef PG8_MMA
#undef PG8_WAIT_V
#undef PG8_WAIT_L
#undef PG8_BAR
#undef PG8_SCHED
}
}

using pg8::bf16_t; using pg8::bf16x8; using pg8::f32x4; using pg8::u32x4;
#define LAS __attribute__((address_space(3)))
typedef unsigned u32x2 __attribute__((ext_vector_type(2)));
typedef short bf16x4 __attribute__((ext_vector_type(4)));

constexpr int DM = 1024, ML = 16384, MC = 2048, MT = 18432, FH = 2816;
constexpr int LDS_BYTES = 136 * 1024;
constexpr int NPH = 41;

constexpr size_t WS_H    = 0;
constexpr size_t WS_A    = WS_H + (size_t)MT * DM * 4;
constexpr size_t WS_P    = WS_A + (size_t)MT * DM * 2;
constexpr size_t WS_WFI  = WS_P + (size_t)MT * 3072 * 2;
constexpr size_t WS_WFO  = WS_WFI + 4ull * 5632 * 1024 * 2;
constexpr size_t WS_WO   = WS_WFO + 4ull * 1024 * 2816 * 2;
constexpr size_t WS_WAB  = WS_WO + 4ull * 1024 * 1024 * 2;
constexpr size_t WS_WCD  = WS_WAB + 2ull * 3072 * 1024 * 2;
constexpr size_t WS_WGLU = WS_WCD + 2ull * 2304 * 1024 * 2;
constexpr size_t WS_WU   = WS_WGLU + 2ull * 512 * 512 * 2;
constexpr size_t WS_MOD  = WS_WU + 2ull * 1792 * 640 * 2;
constexpr size_t WS_ROPE = WS_MOD + 4ull * 9 * 6144 * 4;
constexpr size_t WS_S5A  = WS_ROPE + 64 * 16 * 2 * 4;
constexpr size_t WS_S5BB = WS_S5A + 2ull * 2 * 32 * 64 * 4 * 4;
constexpr size_t WS_S5CC = WS_S5BB + 2ull * 2 * 32 * 2 * 64 * 16 * 2;
constexpr size_t WS_LB   = WS_S5CC + 2ull * 2 * 32 * 4 * 16 * 32 * 2;
constexpr size_t WS_TAB  = WS_LB + 2 * 512 * 4;
constexpr size_t WS_X    = (WS_TAB + 64 * 8 + 255) & ~(size_t)255;
constexpr size_t WS_OF   = WS_X;
constexpr size_t WS_OB   = WS_OF + (size_t)MT * 512 * 2;
constexpr size_t WS_Z    = WS_OB + (size_t)MT * 512 * 2;
constexpr size_t WS_E    = WS_Z + (size_t)MT * 512 * 2;
constexpr size_t WS_END_EVEN = WS_E + 8ull * 2 * 36 * 32 * 128 * 4;
constexpr size_t WS_U    = WS_X;
constexpr size_t WS_END_ODD = WS_U + (size_t)MT * 1792 * 2;
constexpr size_t WS_NEED = WS_END_EVEN > WS_END_ODD ? WS_END_EVEN : WS_END_ODD;
static_assert(WS_NEED <= 402653184ull, "workspace too large");

struct Params { const float* in[34]; float* out; unsigned char* ws; int ph_lo, ph_hi; };
struct Ctx { unsigned char* ws; const float* const* in; float* out; };

__device__ __forceinline__ float bf2f(unsigned v) { return __uint_as_float(v << 16); }
__device__ __forceinline__ float bflo(unsigned w) { return __uint_as_float(w << 16); }
__device__ __forceinline__ float bfhi(unsigned w) { return __uint_as_float(w & 0xffff0000u); }
__device__ __forceinline__ bf16_t f2bf(float f) { unsigned u = __float_as_uint(f); u += 0x7FFFu + ((u >> 16) & 1u); return (bf16_t)(u >> 16); }
__device__ __forceinline__ unsigned pk2(float lo, float hi) { return pg8::cvt_pk_bf16(lo, hi); }
__device__ __forceinline__ float wsum(float v) {
#pragma unroll
    for (int o = 32; o >= 1; o >>= 1) v += __shfl_xor(v, o);
    return v; }
__device__ __forceinline__ float siluf(float x) { return x / (1.0f + __expf(-x)); }
__device__ __forceinline__ bf16x8 mk8(unsigned a, unsigned b, unsigned c, unsigned d) { u32x4 w = {a, b, c, d}; return __builtin_bit_cast(bf16x8, w); }
__device__ __forceinline__ bf16x8 zero8() { return mk8(0u, 0u, 0u, 0u); }
#define MFMA(a, b, c) __builtin_amdgcn_mfma_f32_16x16x32_bf16((a), (b), (c), 0, 0, 0)

__device__ __forceinline__ double dexp(double x) {
    const double y = x * (1.0 / 64.0); double s = 1.0, t = 1.0;
#pragma unroll
    for (int i = 1; i <= 13; ++i) { t *= y / (double)i; s += t; }
#pragma unroll
    for (int i = 0; i < 6; ++i) s *= s;
    return s; }
__device__ __forceinline__ void dsincos(double x, double& sn, double& cs) {
    const double TWO_PI = 6.283185307179586476925287; const double k = rint(x / TWO_PI); const double r = (x - k * TWO_PI) * 0.125;
    const double r2 = r * r; double s = r, t = r, c = 1.0, u = 1.0;
#pragma unroll
    for (int i = 1; i <= 7; ++i) { t *= -r2 / (double)((2 * i) * (2 * i + 1)); s += t; u *= -r2 / (double)((2 * i - 1) * (2 * i)); c += u; }
#pragma unroll
    for (int i = 0; i < 3; ++i) { const double s2 = 2.0 * s * c, c2 = c * c - s * s; s = s2; c = c2; }
    sn = s; cs = c; }

struct EpiRes {
    static constexpr bool PERM = false, AFTER_DRAIN = false;
    float* H; const float* gate; float* out;
    __device__ __forceinline__ void operator()(const f32x4 (&acc)[2][2][4][2], const pg8::Unit& u, int wr, int wc, int fr, int fq) const {
        const int r = u.pm < 64 ? (u.pm >> 3) : 8;
        const int row0 = u.pm * 256 + wr * 64 + fr, col0 = u.pn * 256 + wc * 32 + 4 * fq;
        const float* gp = gate + r * 6144 + col0;
        f32x4 gv[2][2];
#pragma unroll
        for (int bj = 0; bj < 2; ++bj)
#pragma unroll
            for (int n = 0; n < 2; ++n) gv[bj][n] = *(const f32x4*)(gp + bj * 128 + n * 16);
#pragma unroll
        for (int ai = 0; ai < 2; ++ai)
#pragma unroll
            for (int m = 0; m < 4; ++m) { const size_t off = (size_t)(row0 + ai * 128 + m * 16) * 1024 + col0;
#pragma unroll
                for (int bj = 0; bj < 2; ++bj)
#pragma unroll
                    for (int n = 0; n < 2; ++n) { float* pp = H + off + bj * 128 + n * 16; const f32x4 v = *(const f32x4*)pp + gv[bj][n] * acc[ai][bj][m][n]; *(f32x4*)pp = v;
                        if (out != nullptr && u.pm < 64) *(f32x4*)(out + off + bj * 128 + n * 16) = v; }
                asm volatile("" ::: "memory"); }
    }
};
struct EpiStore {
    static constexpr bool PERM = true, AFTER_DRAIN = false;
    bf16_t* O; int ldc;
    __device__ __forceinline__ void operator()(const f32x4 (&acc)[2][2][4][2], const pg8::Unit& u, int wr, int wc, int fr, int fq) const {
        const int row0 = u.pm * 256 + wr * 64 + fr, col0 = u.pn * 256 + wc * 32 + 8 * fq;
#pragma unroll
        for (int ai = 0; ai < 2; ++ai)
#pragma unroll
            for (int m = 0; m < 4; ++m) { bf16_t* rowp = O + (size_t)(row0 + ai * 128 + m * 16) * ldc + col0;
#pragma unroll
                for (int bj = 0; bj < 2; ++bj) { const f32x4 v0 = acc[ai][bj][m][0], v1 = acc[ai][bj][m][1];
                    u32x4 w; w.x = pk2(v0[0], v0[1]); w.y = pk2(v0[2], v0[3]); w.z = pk2(v1[0], v1[1]); w.w = pk2(v1[2], v1[3]);
                    *(u32x4*)(rowp + bj * 128) = w; } }
    }
};
struct EpiSwiGLU {
    static constexpr bool PERM = true, AFTER_DRAIN = false;
    bf16_t* G;
    __device__ __forceinline__ void operator()(const f32x4 (&acc)[2][2][4][2], const pg8::Unit& u, int wr, int wc, int fr, int fq) const {
        const int row0 = u.pm * 256 + wr * 64 + fr, col0 = u.pn * 128 + wc * 32 + 8 * fq;
#pragma unroll
        for (int ai = 0; ai < 2; ++ai)
#pragma unroll
            for (int m = 0; m < 4; ++m) { bf16_t* rowp = G + (size_t)(row0 + ai * 128 + m * 16) * FH + col0;
                const f32x4 g0 = acc[ai][0][m][0], g1 = acc[ai][0][m][1], u0 = acc[ai][1][m][0], u1 = acc[ai][1][m][1];
                u32x4 w; w.x = pk2(siluf(g0[0]) * u0[0], siluf(g0[1]) * u0[1]); w.y = pk2(siluf(g0[2]) * u0[2], siluf(g0[3]) * u0[3]);
                w.z = pk2(siluf(g1[0]) * u1[0], siluf(g1[1]) * u1[1]); w.w = pk2(siluf(g1[2]) * u1[2], siluf(g1[3]) * u1[3]);
                *(u32x4*)rowp = w; }
    }
};
struct EpiGLU {
    static constexpr bool PERM = true, AFTER_DRAIN = false;
    bf16_t* MX; const bf16_t* Z; const float* bias;
    __device__ __forceinline__ void operator()(const f32x4 (&acc)[2][2][4][2], const pg8::Unit& u, int wr, int wc, int fr, int fq) const {
        const int row0 = u.pm * 256 + wr * 64 + fr, col0 = u.pn * 256 + wc * 32 + 8 * fq;
#pragma unroll
        for (int ai = 0; ai < 2; ++ai)
#pragma unroll
            for (int m = 0; m < 4; ++m) { const int row = row0 + ai * 128 + m * 16;
#pragma unroll
                for (int bj = 0; bj < 2; ++bj) { const int col = col0 + bj * 128;
                    const u32x4 zz = *(const u32x4*)(Z + (size_t)row * 512 + col); const f32x4 b0 = *(const f32x4*)(bias + col), b1 = *(const f32x4*)(bias + col + 4);
                    const f32x4 v0 = acc[ai][bj][m][0] + b0, v1 = acc[ai][bj][m][1] + b1;
                    u32x4 w;
                    w.x = pk2(bflo(zz.x) / (1.f + __expf(-v0[0])), bfhi(zz.x) / (1.f + __expf(-v0[1])));
                    w.y = pk2(bflo(zz.y) / (1.f + __expf(-v0[2])), bfhi(zz.y) / (1.f + __expf(-v0[3])));
                    w.z = pk2(bflo(zz.z) / (1.f + __expf(-v1[0])), bfhi(zz.z) / (1.f + __expf(-v1[1])));
                    w.w = pk2(bflo(zz.w) / (1.f + __expf(-v1[2])), bfhi(zz.w) / (1.f + __expf(-v1[3])));
                    *(u32x4*)(MX + (size_t)row * 1024 + col) = w; }
                asm volatile("" ::: "memory"); }
    }
};

template <class Epi> __device__ __forceinline__ void run_gemm(LAS unsigned char* lds, const bf16_t* A, const bf16_t* Bt, int M, int N, int K, const Epi& E) {
    pg8::Gemm g; g.A = A; g.Bt = Bt; g.M = M; g.N = N; g.K = K;
    pg8::StaticOrder S; S.init(M, N, (int)gridDim.x, (int)blockIdx.x);
    pg8::gemm_phase<Epi, pg8::StaticOrder, false>(lds, g, S, E, nullptr);
}

__device__ __forceinline__ void tr_job(const float* __restrict__ src, bf16_t* __restrict__ dst, int ldd, int K, int N, int mode, int& rot, LAS float* tile) {
    const int tid = mk_tid(), nb = gridDim.x, tn = N / 64, nt = (K / 64) * tn;
    const int start = (int)((blockIdx.x + nb - (rot % nb)) % nb); rot += nt;
    for (int t = start; t < nt; t += nb) {
        const int k0 = (t / tn) * 64, n0 = (t % tn) * 64;
        { const int c4 = (tid & 15) * 4;
#pragma unroll
          for (int i = 0; i < 2; ++i) { const int r = (tid >> 4) + 32 * i; const float4 v = *(const float4*)(src + (size_t)(k0 + r) * N + n0 + c4);
              tile[r * 65 + c4 + 0] = v.x; tile[r * 65 + c4 + 1] = v.y; tile[r * 65 + c4 + 2] = v.z; tile[r * 65 + c4 + 3] = v.w; } }
        __syncthreads();
        { const int n = tid >> 3, k8 = (tid & 7) * 8; const int nn = n0 + n;
          const int drow = mode == 0 ? nn : (nn < FH ? (nn / 128) * 256 + (nn % 128) : ((nn - FH) / 128) * 256 + 128 + ((nn - FH) % 128));
          u32x4 w; w.x = pk2(tile[(k8 + 0) * 65 + n], tile[(k8 + 1) * 65 + n]); w.y = pk2(tile[(k8 + 2) * 65 + n], tile[(k8 + 3) * 65 + n]);
          w.z = pk2(tile[(k8 + 4) * 65 + n], tile[(k8 + 5) * 65 + n]); w.w = pk2(tile[(k8 + 6) * 65 + n], tile[(k8 + 7) * 65 + n]);
          *(u32x4*)(dst + (size_t)drow * ldd + k0 + k8) = w; }
        __syncthreads();
    }
}

__device__ __forceinline__ void prep_phase(const Ctx& p, LAS unsigned char* lds) {
    const int tid = mk_tid(), nb = gridDim.x, bid = blockIdx.x;
    unsigned char* ws = p.ws;
    { float4* H4 = (float4*)(ws + WS_H); const float4* x4 = (const float4*)p.in[0]; const float4* c4 = (const float4*)p.in[2];
      const size_t nx = (size_t)ML * DM / 4, nc = (size_t)MC * DM / 4;
      for (size_t i = (size_t)bid * 512 + tid; i < nx; i += (size_t)nb * 512) H4[i] = x4[i];
      for (size_t i = (size_t)bid * 512 + tid; i < nc; i += (size_t)nb * 512) H4[nx + i] = c4[i]; }
    { LAS float* tile = (LAS float*)lds; int rot = 0;
      for (int l = 0; l < 4; ++l) {
          tr_job(p.in[9] + (size_t)l * 1024 * 5632, (bf16_t*)(ws + WS_WFI) + (size_t)l * 5632 * 1024, 1024, 1024, 5632, 1, rot, tile);
          tr_job(p.in[10] + (size_t)l * 2816 * 1024, (bf16_t*)(ws + WS_WFO) + (size_t)l * 1024 * 2816, 2816, 2816, 1024, 0, rot, tile);
          tr_job(p.in[8] + (size_t)l * 1024 * 1024, (bf16_t*)(ws + WS_WO) + (size_t)l * 1024 * 1024, 1024, 1024, 1024, 0, rot, tile); }
      for (int e = 0; e < 2; ++e) {
          tr_job(p.in[11] + (size_t)e * 1024 * 3072, (bf16_t*)(ws + WS_WAB) + (size_t)e * 3072 * 1024, 1024, 1024, 3072, 0, rot, tile);
          tr_job(p.in[20] + (size_t)e * 512 * 512, (bf16_t*)(ws + WS_WGLU) + (size_t)e * 512 * 512, 512, 512, 512, 0, rot, tile);
          tr_job(p.in[24] + (size_t)e * 1024 * 2240, (bf16_t*)(ws + WS_WCD) + (size_t)e * 2304 * 1024, 1024, 1024, 2240, 0, rot, tile);
          tr_job(p.in[30] + (size_t)e * 384 * 768, (bf16_t*)(ws + WS_WU) + (size_t)e * 1792 * 640, 640, 384, 768, 0, rot, tile);
          tr_job(p.in[31] + (size_t)e * 256 * 1024, (bf16_t*)(ws + WS_WU) + (size_t)e * 1792 * 640 + 768 * 640 + 384, 640, 256, 1024, 0, rot, tile); } }
    if (bid < 192) {
        LAS float* sc = (LAS float*)(lds + 20480);
        LAS float* red = (LAS float*)(lds + 20480 + 36864);
        for (int i = tid; i < 9 * 1024; i += 512) { const int r = i >> 10, k = i & 1023; const float v = r < 8 ? p.in[1][r * 1024 + k] : p.in[3][k]; sc[i] = siluf(v); }
        __syncthreads();
        for (int u = bid; u < 192; u += nb) {
            const int l = u / 48, n0 = (u % 48) * 128, cl = tid & 127, ks = tid >> 7;
            const float* w = p.in[4] + (size_t)l * 1024 * 6144 + n0 + cl;
            float a0 = 0, a1 = 0, a2 = 0, a3 = 0, a4 = 0, a5 = 0, a6 = 0, a7 = 0, a8 = 0;
#pragma unroll 4
            for (int k = ks * 256; k < ks * 256 + 256; ++k) { const float wv = w[(size_t)k * 6144];
                a0 += sc[k] * wv; a1 += sc[1024 + k] * wv; a2 += sc[2048 + k] * wv; a3 += sc[3072 + k] * wv; a4 += sc[4096 + k] * wv;
                a5 += sc[5120 + k] * wv; a6 += sc[6144 + k] * wv; a7 += sc[7168 + k] * wv; a8 += sc[8192 + k] * wv; }
            LAS float* rp = red + ks * 9 * 128 + cl;
            rp[0] = a0; rp[128] = a1; rp[256] = a2; rp[384] = a3; rp[512] = a4; rp[640] = a5; rp[768] = a6; rp[896] = a7; rp[1024] = a8;
            __syncthreads();
            for (int i = tid; i < 9 * 128; i += 512) { const int r = i >> 7, c = i & 127;
                const float v = red[i] + red[1152 + i] + red[2304 + i] + red[3456 + i] + p.in[5][l * 6144 + n0 + c];
                ((float*)(ws + WS_MOD))[((size_t)l * 9 + r) * 6144 + n0 + c] = v; }
            __syncthreads();
        }
    }
    const int gt = bid * 512 + tid, gs = nb * 512;
    for (int i = gt; i < 2 * 73728; i += gs) {
        const int o = i / 73728, r = i % 73728; bf16_t* wb = (bf16_t*)(ws + WS_WU) + (size_t)o * 1792 * 640; u32x4 zz = {0u, 0u, 0u, 0u};
        if (r < 768 * 32) *(u32x4*)(wb + (size_t)(r >> 5) * 640 + 384 + (r & 31) * 8) = zz;
        else { const int r2 = r - 768 * 32; *(u32x4*)(wb + (size_t)(768 + r2 / 48) * 640 + (r2 % 48) * 8) = zz; } }
    for (int i = gt; i < 1024; i += gs) {
        const int pos = i >> 4, f = i & 15; const double inv = dexp(-(double)f * (9.210340371976182736 / 16.0)); double sn, cs; dsincos((double)pos * inv, sn, cs);
        ((float*)(ws + WS_ROPE))[i * 2] = (float)cs; ((float*)(ws + WS_ROPE))[i * 2 + 1] = (float)sn; }
    for (int i = gt; i < 1024; i += gs) {
        const int e = i >> 9, j = i & 511; float v = 0.f;
        if (e == 1) v = 1.0f / (1.0f + expf(p.in[22][j] - p.in[22][512 + j]));
        ((float*)(ws + WS_LB))[i] = v; }
    for (int i = gt; i < 2 * 2 * 32 * 64; i += gs) {
        const int pp = i & 63, idx = i >> 6;
        const double lr = (double)fminf(p.in[12][i], -1e-4f), li = (double)p.in[13][i], step = dexp((double)p.in[14][idx]);
        const double mag = dexp(lr * step); double sn, cs; dsincos(li * step, sn, cs);
        const double ar = mag * cs, ai = mag * sn, den = lr * lr + li * li;
        const double cr = ((ar - 1.0) * lr + ai * li) / den, ci = (ai * lr - (ar - 1.0) * li) / den;
        double pr = ar, pi = ai;
#pragma unroll
        for (int s = 0; s < 6; ++s) { const double nr = pr * pr - pi * pi, ni = 2.0 * pr * pi; pr = nr; pi = ni; }
        float4 o; o.x = (float)ar; o.y = (float)ai; o.z = (float)pr; o.w = (float)pi; ((float4*)(ws + WS_S5A))[i] = o;
        bf16_t* bbr = (bf16_t*)(ws + WS_S5BB) + ((size_t)idx * 2 + 0) * 1024 + pp * 16; bf16_t* bbi = bbr + 1024;
        const float* bre = p.in[15] + (size_t)i * 16; const float* bim = p.in[16] + (size_t)i * 16;
#pragma unroll
        for (int c = 0; c < 16; ++c) { const double br = bre[c], bi = bim[c]; bbr[c] = f2bf((float)(cr * br - ci * bi)); bbi[c] = f2bf((float)(cr * bi + ci * br)); } }
    for (int i = gt; i < 2 * 2 * 32 * 4 * 16 * 32; i += gs) {
        const int slot = i & 31, c = (i >> 5) & 15, kk = (i >> 9) & 3, idx = i >> 11;
        const int quad = slot >> 3, j8 = slot & 7, st = 16 * (2 * (kk & 1) + (j8 >> 2)) + quad * 4 + (j8 & 3);
        const float v = kk < 2 ? p.in[17][((size_t)idx * 16 + c) * 64 + st] : -p.in[18][((size_t)idx * 16 + c) * 64 + st];
        ((bf16_t*)(ws + WS_S5CC))[i] = f2bf(v); }
}

__device__ __forceinline__ void norm_phase(const Ctx& p, const float* __restrict__ gw, const float* __restrict__ mod, int si, int Mrows) {
    const int lane = mk_tid() & 63, wg = blockIdx.x * 8 + (mk_tid() >> 6), nw = gridDim.x * 8;
    const float* H = (const float*)(p.ws + WS_H); bf16_t* A = (bf16_t*)(p.ws + WS_A);
    for (int row = wg; row < Mrows; row += nw) {
        const float4* hr = (const float4*)(H + (size_t)row * 1024); float4 h[4]; float ss = 0.f;
#pragma unroll
        for (int i = 0; i < 4; ++i) { h[i] = hr[lane + 64 * i]; ss += h[i].x * h[i].x + h[i].y * h[i].y + h[i].z * h[i].z + h[i].w * h[i].w; }
        ss = wsum(ss); const float rs = rsqrtf(ss * (1.0f / 1024.0f) + 1e-6f);
        const int r = row < ML ? (row >> 11) : 8; const float* sh = mod + r * 6144 + si * 1024; const float* sc = sh + 1024;
#pragma unroll
        for (int i = 0; i < 4; ++i) { const int c = 4 * (lane + 64 * i); const float4 g = *(const float4*)(gw + c), s4 = *(const float4*)(sh + c), c4 = *(const float4*)(sc + c);
            u32x2 w; w.x = pk2(h[i].x * rs * g.x * (1.f + c4.x) + s4.x, h[i].y * rs * g.y * (1.f + c4.y) + s4.y);
            w.y = pk2(h[i].z * rs * g.z * (1.f + c4.z) + s4.z, h[i].w * rs * g.w * (1.f + c4.w) + s4.w);
            *(u32x2*)(A + (size_t)row * 1024 + c) = w; }
    }
}

__device__ __forceinline__ void s5_unit(const Ctx& p, int e, int g, int sg, int pass, int lane) {
    const int n = lane & 15, quad = lane >> 4;
    const int seq = sg * 16 + n, b = seq / 36, tc = seq % 36;
    const int rowbase = tc < 4 ? ML + b * 256 + tc * 64 : b * 2048 + (tc - 4) * 64;
    const bf16_t* P = (const bf16_t*)(p.ws + WS_P); bf16_t* Z = (bf16_t*)(p.ws + WS_Z); float* E = (float*)(p.ws + WS_E);
    const f32x4 dsk = *(const f32x4*)(p.in[19] + e * 512 + g * 16 + quad * 4);
    const f32x4 z4 = {0.f, 0.f, 0.f, 0.f};
#pragma unroll 1
    for (int dir = 0; dir < 2; ++dir) {
        const int idx = (e * 2 + dir) * 32 + g;
        const float4* A4 = (const float4*)(p.ws + WS_S5A) + (size_t)idx * 64;
        const bf16_t* BB = (const bf16_t*)(p.ws + WS_S5BB) + (size_t)idx * 2048;
        const bf16_t* CC = (const bf16_t*)(p.ws + WS_S5CC) + (size_t)idx * 2048;
        float ar[4][4], ai[4][4], hr[4][4], hi[4][4];
        bf16x8 Abr[4], Abi[4], Acc[4];
#pragma unroll
        for (int pt = 0; pt < 4; ++pt) {
            Abr[pt] = quad < 2 ? *(const bf16x8*)(BB + (16 * pt + n) * 16 + quad * 8) : zero8();
            Abi[pt] = quad < 2 ? *(const bf16x8*)(BB + 1024 + (16 * pt + n) * 16 + quad * 8) : zero8();
            Acc[pt] = *(const bf16x8*)(CC + (pt * 16 + n) * 32 + quad * 8); }
        const int pc = dir == 0 ? tc : (tc < 4 ? 3 - tc : 39 - tc);
        const float* Eb = E + ((size_t)((b * 2 + dir) * 36) * 32 + g) * 128;
        if (pass == 2) {
#pragma unroll
            for (int pt = 0; pt < 4; ++pt)
#pragma unroll
                for (int j = 0; j < 4; ++j) { const float4 a = A4[16 * pt + quad * 4 + j]; ar[pt][j] = a.x; ai[pt][j] = a.y; hr[pt][j] = 0.f; hi[pt][j] = 0.f; }
#pragma unroll 1
            for (int q = 0; q < 35; ++q) {
                if (q < pc) {
#pragma unroll
                    for (int pt = 0; pt < 4; ++pt) { const float4* ep = (const float4*)(Eb + (size_t)q * 4096 + (16 * pt + quad * 4) * 2); const float4 e0 = ep[0], e1 = ep[1];
                        const float er[4] = {e0.x, e0.z, e1.x, e1.z}, ei[4] = {e0.y, e0.w, e1.y, e1.w};
#pragma unroll
                        for (int j = 0; j < 4; ++j) { const float4 a = A4[16 * pt + quad * 4 + j]; const float nr = a.z * hr[pt][j] - a.w * hi[pt][j] + er[j], ni = a.z * hi[pt][j] + a.w * hr[pt][j] + ei[j]; hr[pt][j] = nr; hi[pt][j] = ni; }
                        asm volatile("" ::: "memory"); }
                }
            }
        } else {
#pragma unroll
            for (int pt = 0; pt < 4; ++pt)
#pragma unroll
                for (int j = 0; j < 4; ++j) { const float4 a = A4[16 * pt + quad * 4 + j]; ar[pt][j] = a.x; ai[pt][j] = a.y; hr[pt][j] = 0.f; hi[pt][j] = 0.f; }
        }
        const bf16_t* up = P + (size_t)rowbase * 3072 + g * 16 + (quad & 1) * 8;
        bf16x8 ub = quad < 2 ? *(const bf16x8*)(up + (size_t)(dir ? 63 : 0) * 3072) : zero8();
#pragma unroll 1
        for (int t = 0; t < 64; ++t) {
            const int tt = dir ? 63 - t : t; const int row = rowbase + tt;
            const bf16x8 uc = ub;
            if (t < 63) { const int t2 = dir ? 62 - t : t + 1; ub = quad < 2 ? *(const bf16x8*)(up + (size_t)t2 * 3072) : zero8(); }
#pragma unroll
            for (int pt = 0; pt < 4; ++pt) { const f32x4 br = MFMA(Abr[pt], uc, z4), bi = MFMA(Abi[pt], uc, z4);
#pragma unroll
                for (int j = 0; j < 4; ++j) { const float nr = ar[pt][j] * hr[pt][j] - ai[pt][j] * hi[pt][j] + br[j], ni = ar[pt][j] * hi[pt][j] + ai[pt][j] * hr[pt][j] + bi[j]; hr[pt][j] = nr; hi[pt][j] = ni; } }
            if (pass == 2) {
                f32x4 y = z4;
#pragma unroll
                for (int kk = 0; kk < 2; ++kk) {
                    const bf16x8 br = mk8(pk2(hr[2 * kk][0], hr[2 * kk][1]), pk2(hr[2 * kk][2], hr[2 * kk][3]), pk2(hr[2 * kk + 1][0], hr[2 * kk + 1][1]), pk2(hr[2 * kk + 1][2], hr[2 * kk + 1][3]));
                    const bf16x8 bi = mk8(pk2(hi[2 * kk][0], hi[2 * kk][1]), pk2(hi[2 * kk][2], hi[2 * kk][3]), pk2(hi[2 * kk + 1][0], hi[2 * kk + 1][1]), pk2(hi[2 * kk + 1][2], hi[2 * kk + 1][3]));
                    y = MFMA(Acc[kk], br, y); y = MFMA(Acc[2 + kk], bi, y); }
                bf16_t* zp = Z + (size_t)row * 512 + g * 16 + quad * 4;
                if (dir == 0) { u32x2 w; w.x = pk2(y[0], y[1]); w.y = pk2(y[2], y[3]); *(u32x2*)zp = w; }
                else { const u32x2 yf = *(const u32x2*)zp; const u32x2 uu = *(const u32x2*)(P + (size_t)row * 3072 + g * 16 + quad * 4);
                    float v[4] = {bflo(yf.x) + y[0] + dsk[0] * bflo(uu.x), bfhi(yf.x) + y[1] + dsk[1] * bfhi(uu.x), bflo(yf.y) + y[2] + dsk[2] * bflo(uu.y), bfhi(yf.y) + y[3] + dsk[3] * bfhi(uu.y)};
#pragma unroll
                    for (int j = 0; j < 4; ++j) { const float x = v[j], uarg = 1.5957691216f * (x + 0.044715f * x * x * x); v[j] = x / (1.0f + __expf(-uarg)); }
                    u32x2 w; w.x = pk2(v[0], v[1]); w.y = pk2(v[2], v[3]); *(u32x2*)zp = w; }
            }
        }
        if (pass == 1) {
#pragma unroll
            for (int pt = 0; pt < 4; ++pt) { float4* ep = (float4*)(Eb + (size_t)pc * 4096 + (16 * pt + quad * 4) * 2);
                float4 e0, e1; e0.x = hr[pt][0]; e0.y = hi[pt][0]; e0.z = hr[pt][1]; e0.w = hi[pt][1]; e1.x = hr[pt][2]; e1.y = hi[pt][2]; e1.z = hr[pt][3]; e1.w = hi[pt][3]; ep[0] = e0; ep[1] = e1; }
        }
    }
}

constexpr int HG_CUM = 0, HG_QT = 33792, HG_KT = HG_QT + 17408, HG_QI = HG_KT + 17408, HG_KET = HG_QI + 17408, HG_VT = HG_KET + 18432, HG_SC = HG_VT + 18432, HG_END = HG_SC + 9216;
static_assert(HG_END <= LDS_BYTES, "hgrn lds");
__device__ __forceinline__ void hgrn_chain(const Ctx& p, int e, int chain, LAS unsigned char* lds) {
    const int tid = mk_tid(), w = tid >> 6, lane = tid & 63, n = lane & 15, quad = lane >> 4;
    const int b = chain >> 3, dir = (chain >> 2) & 1, head = chain & 3;
    const bf16_t* P = (const bf16_t*)(p.ws + WS_P);
    bf16_t* O = (bf16_t*)(p.ws + (dir ? WS_OB : WS_OF));
    LAS float* cum = (LAS float*)(lds + HG_CUM);
    LAS bf16_t* qt = (LAS bf16_t*)(lds + HG_QT);
    LAS bf16_t* kt = (LAS bf16_t*)(lds + HG_KT);
    LAS bf16_t* qi = (LAS bf16_t*)(lds + HG_QI);
    LAS bf16_t* keT = (LAS bf16_t*)(lds + HG_KET);
    LAS bf16_t* vT = (LAS bf16_t*)(lds + HG_VT);
    LAS bf16_t* sc = (LAS bf16_t*)(lds + HG_SC);
    const int t = tid >> 3, kc = (tid & 7) * 16;
    const float* lbp = (const float*)(p.ws + WS_LB) + e * 512 + head * 128 + kc;
    f32x4 S[8];
#pragma unroll
    for (int i = 0; i < 8; ++i) S[i] = (f32x4){0.f, 0.f, 0.f, 0.f};
    const int qcol = 512 + head * 128 + kc, fcol = (dir ? 1536 : 1024) + head * 128 + kc, vcol = 2048 + head * 128 + kc;
#pragma unroll 1
    for (int pc = 0; pc < 36; ++pc) {
        const int tc = dir == 0 ? pc : (pc < 4 ? 3 - pc : 39 - pc);
        const int rowb = tc < 4 ? ML + b * 256 + tc * 64 : b * 2048 + (tc - 4) * 64;
        const int row = rowb + (dir ? 63 - t : t);
        const bf16_t* pr = P + (size_t)row * 3072;
        const u32x4 rq0 = *(const u32x4*)(pr + qcol), rq1 = *(const u32x4*)(pr + qcol + 8), rf0 = *(const u32x4*)(pr + fcol), rf1 = *(const u32x4*)(pr + fcol + 8),
                    rv0 = *(const u32x4*)(pr + vcol), rv1 = *(const u32x4*)(pr + vcol + 8);
        const unsigned rq[8] = {rq0.x, rq0.y, rq0.z, rq0.w, rq1.x, rq1.y, rq1.z, rq1.w}, rf[8] = {rf0.x, rf0.y, rf0.z, rf0.w, rf1.x, rf1.y, rf1.z, rf1.w},
                       rv[8] = {rv0.x, rv0.y, rv0.z, rv0.w, rv1.x, rv1.y, rv1.z, rv1.w};
        float qv[16], kv[16], lf[16], lb[16];
#pragma unroll
        for (int i = 0; i < 4; ++i) { const f32x4 t4 = *(const f32x4*)(lbp + 4 * i); lb[4 * i] = t4[0]; lb[4 * i + 1] = t4[1]; lb[4 * i + 2] = t4[2]; lb[4 * i + 3] = t4[3]; }
#pragma unroll
        for (int i = 0; i < 16; ++i) {
            const float x = (i & 1) ? bfhi(rq[i >> 1]) : bflo(rq[i >> 1]), fl = (i & 1) ? bfhi(rf[i >> 1]) : bflo(rf[i >> 1]);
            qv[i] = siluf(x);
            const float en = __expf(-fabsf(fl));
            const float sgn = fl >= 0.f ? en / (1.f + en) : 1.f / (1.f + en);
            kv[i] = (1.f - lb[i]) * sgn;
            const float lsig = fminf(fl, 0.f) - log1pf(en);
            lf[i] = lsig + log1pf(lb[i] * __expf(fminf(-fl, 60.f)));
            vT[(kc + i) * 72 + t] = (bf16_t)((i & 1) ? (rv[i >> 1] >> 16) : (rv[i >> 1] & 0xffffu));
        }
#pragma unroll
        for (int i = 0; i < 4; ++i) *(LAS f32x4*)(cum + t * 132 + kc + 4 * i) = (f32x4){lf[4 * i], lf[4 * i + 1], lf[4 * i + 2], lf[4 * i + 3]};
        __syncthreads();
        if (tid < 128) { float run = 0.f;
#pragma unroll 8
            for (int s = 0; s < 64; ++s) { run += cum[s * 132 + tid]; cum[s * 132 + tid] = run; } }
        __syncthreads();
        {
            unsigned wq[8], wk[8], wi[8];
#pragma unroll
            for (int i = 0; i < 16; i += 2) {
                float a[2], bq[2], cq[2];
#pragma unroll
                for (int h2 = 0; h2 < 2; ++h2) { const int ii = i + h2; const float ct = cum[t * 132 + kc + ii], c31 = cum[31 * 132 + kc + ii], c63 = cum[63 * 132 + kc + ii];
                    a[h2] = qv[ii] * __expf(fminf(ct - c31, 80.f)); bq[h2] = kv[ii] * __expf(fminf(c31 - ct, 80.f)); cq[h2] = qv[ii] * __expf(ct);
                    keT[(kc + ii) * 72 + t] = f2bf(kv[ii] * __expf(c63 - ct)); }
                wq[i >> 1] = pk2(a[0], a[1]); wk[i >> 1] = pk2(bq[0], bq[1]); wi[i >> 1] = pk2(cq[0], cq[1]);
            }
            *(LAS u32x4*)(qt + t * 136 + kc) = (u32x4){wq[0], wq[1], wq[2], wq[3]}; *(LAS u32x4*)(qt + t * 136 + kc + 8) = (u32x4){wq[4], wq[5], wq[6], wq[7]};
            *(LAS u32x4*)(kt + t * 136 + kc) = (u32x4){wk[0], wk[1], wk[2], wk[3]}; *(LAS u32x4*)(kt + t * 136 + kc + 8) = (u32x4){wk[4], wk[5], wk[6], wk[7]};
            *(LAS u32x4*)(qi + t * 136 + kc) = (u32x4){wi[0], wi[1], wi[2], wi[3]}; *(LAS u32x4*)(qi + t * 136 + kc + 8) = (u32x4){wi[4], wi[5], wi[6], wi[7]};
        }
        __syncthreads();
        {
            const int tt = w >> 1;
#pragma unroll
            for (int si = 0; si < 2; ++si) { const int st = (w & 1) * 2 + si; f32x4 acc = {0.f, 0.f, 0.f, 0.f};
                if (st <= tt) {
#pragma unroll
                    for (int kb = 0; kb < 4; ++kb) { const bf16x8 a = *(const LAS bf16x8*)(qt + (16 * tt + n) * 136 + 32 * kb + quad * 8), bb = *(const LAS bf16x8*)(kt + (16 * st + n) * 136 + 32 * kb + quad * 8);
                        acc = MFMA(a, bb, acc); } }
#pragma unroll
                for (int j = 0; j < 4; ++j) { const int ti = 16 * tt + quad * 4 + j, sidx = 16 * st + n; sc[ti * 72 + sidx] = (st <= tt && sidx <= ti) ? f2bf(acc[j]) : (bf16_t)0; } }
        }
        __syncthreads();
        {
            bf16x8 Sb[4], vB[2];
#pragma unroll
            for (int kb = 0; kb < 4; ++kb) Sb[kb] = mk8(pk2(S[2 * kb][0], S[2 * kb][1]), pk2(S[2 * kb][2], S[2 * kb][3]), pk2(S[2 * kb + 1][0], S[2 * kb + 1][1]), pk2(S[2 * kb + 1][2], S[2 * kb + 1][3]));
#pragma unroll
            for (int sb = 0; sb < 2; ++sb) vB[sb] = *(const LAS bf16x8*)(vT + (16 * w + n) * 72 + 32 * sb + quad * 8);
#pragma unroll
            for (int tt = 0; tt < 4; ++tt) { f32x4 acc = {0.f, 0.f, 0.f, 0.f};
#pragma unroll
                for (int kb = 0; kb < 4; ++kb) { const bf16x4 a0 = *(const LAS bf16x4*)(qi + (16 * tt + n) * 136 + 32 * kb + quad * 4), a1 = *(const LAS bf16x4*)(qi + (16 * tt + n) * 136 + 32 * kb + 16 + quad * 4);
                    acc = MFMA(__builtin_shufflevector(a0, a1, 0, 1, 2, 3, 4, 5, 6, 7), Sb[kb], acc); }
#pragma unroll
                for (int sb = 0; sb < 2; ++sb) if (32 * sb <= 16 * tt + 15) { const bf16x8 a = *(const LAS bf16x8*)(sc + (16 * tt + n) * 72 + 32 * sb + quad * 8); acc = MFMA(a, vB[sb], acc); }
#pragma unroll
                for (int j = 0; j < 4; ++j) { const int ti = 16 * tt + quad * 4 + j; O[(size_t)(rowb + (dir ? 63 - ti : ti)) * 512 + head * 128 + 16 * w + n] = f2bf(acc[j]); } }
#pragma unroll
            for (int k8 = 0; k8 < 8; ++k8) { const f32x4 c4 = *(const LAS f32x4*)(cum + 63 * 132 + 16 * k8 + quad * 4);
                f32x4 s = S[k8]; s[0] *= __expf(c4[0]); s[1] *= __expf(c4[1]); s[2] *= __expf(c4[2]); s[3] *= __expf(c4[3]);
#pragma unroll
                for (int sb = 0; sb < 2; ++sb) { const bf16x8 a = *(const LAS bf16x8*)(keT + (16 * k8 + n) * 72 + 32 * sb + quad * 8); s = MFMA(a, vB[sb], s); }
                S[k8] = s; }
        }
        __syncthreads();
    }
}

__device__ __forceinline__ void hgrn_combine(const Ctx& p, int e) {
    const int lane = mk_tid() & 63, wg = blockIdx.x * 8 + (mk_tid() >> 6), nw = gridDim.x * 8;
    const bf16_t* P = (const bf16_t*)(p.ws + WS_P); const unsigned* OF = (const unsigned*)(p.ws + WS_OF); const unsigned* OB = (const unsigned*)(p.ws + WS_OB);
    unsigned* MX = (unsigned*)(p.ws + WS_A); const float* on = p.in[23] + e * 128;
    const float g0 = on[lane * 2], g1 = on[lane * 2 + 1];
    for (int row = wg; row < MT; row += nw) {
#pragma unroll
        for (int h = 0; h < 4; ++h) { const unsigned a = OF[(size_t)row * 256 + h * 64 + lane], bq = OB[(size_t)row * 256 + h * 64 + lane];
            const float v0 = bflo(a) + bflo(bq), v1 = bfhi(a) + bfhi(bq); const float ss = wsum(v0 * v0 + v1 * v1); const float rs = rsqrtf(ss * (1.0f / 128.0f) + 1e-6f);
            const unsigned gg = *(const unsigned*)(P + (size_t)row * 3072 + 2560 + h * 128 + lane * 2);
            MX[(size_t)row * 512 + 256 + h * 64 + lane] = pk2(v0 * rs * g0 * siluf(bflo(gg)), v1 * rs * g1 * siluf(bfhi(gg))); }
    }
}

__device__ __forceinline__ void odd_post1(const Ctx& p, int o) {
    const int lane = mk_tid() & 63, wg = blockIdx.x * 8 + (mk_tid() >> 6), nw = gridDim.x * 8;
    bf16_t* P = (bf16_t*)(p.ws + WS_P); bf16_t* A23 = (bf16_t*)(p.ws + WS_A);
    const float* rope = (const float*)(p.ws + WS_ROPE);
    const float nq = p.in[26][o * 128 + lane], nk = p.in[26][o * 128 + 64 + lane], nr = p.in[33][o * 128 + 64 + lane];
    const int ax = lane >> 5, f = lane & 15, hh = (lane >> 4) & 1;
    for (int row = wg; row < MT; row += nw) {
        bf16_t* pr = P + (size_t)row * 2304; const bool lat = row < ML; const int tk = row & 2047; const int pos = ax ? (tk & 63) : (tk >> 6);
        const float cs = rope[(pos * 16 + f) * 2], sn = rope[(pos * 16 + f) * 2 + 1];
#pragma unroll 1
        for (int v = 0; v < 17; ++v) { const int col = v < 16 ? v * 64 : 2176; const float gn = v < 8 ? nq : (v < 16 ? nk : nr);
            const float x = bf2f(pr[col + lane]); const float ss = wsum(x * x); float y = x * rsqrtf(ss * (1.0f / 64.0f) + 1e-6f) * gn;
            if (lat) { const float pt = __shfl_xor(y, 16); y = y * cs + (hh ? pt : -pt) * sn; }
            if (v < 8) y *= 0.125f;
            pr[col + lane] = f2bf(y); }
        { float x[6]; float ss = 0.f;
#pragma unroll
          for (int i = 0; i < 6; ++i) { x[i] = bf2f(pr[1536 + lane + 64 * i]); ss += x[i] * x[i]; }
          ss = wsum(ss); const float rs = rsqrtf(ss * (1.0f / 384.0f) + 1e-6f);
#pragma unroll
          for (int i = 0; i < 6; ++i) A23[(size_t)row * 640 + lane + 64 * i] = f2bf(x[i] * rs * p.in[28][o * 384 + lane + 64 * i]); }
        { float x[4]; float ss = 0.f;
#pragma unroll
          for (int i = 0; i < 4; ++i) { x[i] = bf2f(pr[1920 + lane + 64 * i]); ss += x[i] * x[i]; }
          ss = wsum(ss); const float rs = rsqrtf(ss * (1.0f / 256.0f) + 1e-6f);
#pragma unroll
          for (int i = 0; i < 4; ++i) A23[(size_t)row * 640 + 384 + lane + 64 * i] = f2bf(x[i] * rs * p.in[29][o * 256 + lane + 64 * i]); }
    }
}
__device__ __forceinline__ void odd_post2(const Ctx& p, int o) {
    const int lane = mk_tid() & 63, wg = blockIdx.x * 8 + (mk_tid() >> 6), nw = gridDim.x * 8;
    bf16_t* UQ = (bf16_t*)(p.ws + WS_U); bf16_t* UKV = UQ + 768;
    const float* rope = (const float*)(p.ws + WS_ROPE);
    const float qn0 = p.in[32][o * 256 + lane], qn1 = p.in[32][o * 256 + 64 + lane], kn0 = p.in[32][o * 256 + 128 + lane], kn1 = p.in[32][o * 256 + 192 + lane], rn = p.in[33][o * 128 + lane];
    const int ax = lane >> 5, f = lane & 15, hh = (lane >> 4) & 1; const float scl = 0.07216878364870322f;
    for (int row = wg; row < MT; row += nw) {
        const bool lat = row < ML; const int tk = row & 2047; const int pos = ax ? (tk & 63) : (tk >> 6);
        const float cs = rope[(pos * 16 + f) * 2], sn = rope[(pos * 16 + f) * 2 + 1];
        bf16_t* uq = UQ + (size_t)row * 1792; bf16_t* ukv = UKV + (size_t)row * 1792;
#pragma unroll 1
        for (int h = 0; h < 4; ++h) {
            { const float x0 = bf2f(uq[h * 192 + lane]), x1 = bf2f(uq[h * 192 + 64 + lane]); const float ss = wsum(x0 * x0 + x1 * x1); const float rs = rsqrtf(ss * (1.0f / 128.0f) + 1e-6f) * scl;
              uq[h * 192 + lane] = f2bf(x0 * rs * qn0); uq[h * 192 + 64 + lane] = f2bf(x1 * rs * qn1); }
            { const float x = bf2f(uq[h * 192 + 128 + lane]); const float ss = wsum(x * x); float y = x * rsqrtf(ss * (1.0f / 64.0f) + 1e-6f) * rn;
              if (lat) { const float pt = __shfl_xor(y, 16); y = y * cs + (hh ? pt : -pt) * sn; }
              uq[h * 192 + 128 + lane] = f2bf(y * scl); }
            { const float x0 = bf2f(ukv[h * 256 + lane]), x1 = bf2f(ukv[h * 256 + 64 + lane]); const float ss = wsum(x0 * x0 + x1 * x1); const float rs = rsqrtf(ss * (1.0f / 128.0f) + 1e-6f);
              ukv[h * 256 + lane] = f2bf(x0 * rs * kn0); ukv[h * 256 + 64 + lane] = f2bf(x1 * rs * kn1); }
        }
    }
}

constexpr int AT_VT = 25600;
template <int DQ, int K1W>
__device__ __forceinline__ void attn_core(LAS unsigned char* lds, const bf16_t* __restrict__ Q, int qld, int qrow0, const bf16_t* __restrict__ K1, int k1ld,
                                          const bf16_t* __restrict__ K2, int k2ld, const bf16_t* __restrict__ V, int vld, int b, int ntiles, f32x4 (&O)[8][2]) {
    constexpr int NDK = DQ / 32, KP = DQ + 8, NKL = DQ / 64, C8 = DQ / 8;
    const int tid = mk_tid(), w = tid >> 6, lane = tid & 63, n = lane & 15, quad = lane >> 4;
    LAS bf16_t* Ks = (LAS bf16_t*)lds; LAS bf16_t* Vt = (LAS bf16_t*)(lds + AT_VT);
    bf16x8 Qf[2][NDK];
#pragma unroll
    for (int qt = 0; qt < 2; ++qt)
#pragma unroll
        for (int dk = 0; dk < NDK; ++dk) Qf[qt][dk] = *(const bf16x8*)(Q + (size_t)(qrow0 + w * 32 + qt * 16 + n) * qld + dk * 32 + quad * 8);
    float mrun[2] = {-1e30f, -1e30f}, lrun[2] = {0.f, 0.f};
#pragma unroll
    for (int dt = 0; dt < 8; ++dt) { O[dt][0] = (f32x4){0.f, 0.f, 0.f, 0.f}; O[dt][1] = (f32x4){0.f, 0.f, 0.f, 0.f}; }
    u32x4 kr[NKL], vr[2];
    auto issue = [&](int ktile) {
        const int rowb = ktile < 4 ? ML + b * 256 + ktile * 64 : b * 2048 + (ktile - 4) * 64;
#pragma unroll
        for (int i = 0; i < NKL; ++i) { const int idx = tid + i * 512, key = idx / C8, d0 = (idx % C8) * 8;
            const bf16_t* src = d0 < K1W ? K1 + (size_t)(rowb + key) * k1ld + d0 : K2 + (size_t)(rowb + key) * k2ld + (d0 - K1W);
            kr[i] = *(const u32x4*)src; }
#pragma unroll
        for (int i = 0; i < 2; ++i) { const int idx = tid + i * 512, key = idx >> 4, d0 = (idx & 15) * 8; vr[i] = *(const u32x4*)(V + (size_t)(rowb + key) * vld + d0); }
    };
    issue(0);
#pragma unroll 1
    for (int ktile = 0; ktile < ntiles; ++ktile) {
        __syncthreads();
#pragma unroll
        for (int i = 0; i < NKL; ++i) { const int idx = tid + i * 512, key = idx / C8, d0 = (idx % C8) * 8; *(LAS u32x4*)(Ks + key * KP + d0) = kr[i]; }
#pragma unroll
        for (int i = 0; i < 2; ++i) { const int idx = tid + i * 512, key = idx >> 4, d0 = (idx & 15) * 8; const unsigned ww[4] = {vr[i].x, vr[i].y, vr[i].z, vr[i].w};
#pragma unroll
            for (int j = 0; j < 4; ++j) { Vt[(d0 + 2 * j) * 72 + key] = (bf16_t)(ww[j] & 0xffffu); Vt[(d0 + 2 * j + 1) * 72 + key] = (bf16_t)(ww[j] >> 16); } }
        __syncthreads();
        if (ktile + 1 < ntiles) issue(ktile + 1);
        f32x4 s[4][2];
#pragma unroll
        for (int st = 0; st < 4; ++st) { s[st][0] = (f32x4){0.f, 0.f, 0.f, 0.f}; s[st][1] = (f32x4){0.f, 0.f, 0.f, 0.f};
#pragma unroll
            for (int dk = 0; dk < NDK; ++dk) { const bf16x8 a = *(const LAS bf16x8*)(Ks + (16 * st + n) * KP + 32 * dk + quad * 8);
                s[st][0] = MFMA(a, Qf[0][dk], s[st][0]); s[st][1] = MFMA(a, Qf[1][dk], s[st][1]); }
            asm volatile("" ::: "memory"); }
        bf16x8 Pf[2][2];
#pragma unroll
        for (int qt = 0; qt < 2; ++qt) {
            float mx = s[0][qt][0];
#pragma unroll
            for (int st = 0; st < 4; ++st)
#pragma unroll
                for (int j = 0; j < 4; ++j) mx = fmaxf(mx, s[st][qt][j]);
            mx = fmaxf(mx, __shfl_xor(mx, 16)); mx = fmaxf(mx, __shfl_xor(mx, 32));
            const float mnew = fmaxf(mrun[qt], mx); const float alpha = __expf(mrun[qt] - mnew); mrun[qt] = mnew;
            float ls = 0.f;
#pragma unroll
            for (int st = 0; st < 4; ++st)
#pragma unroll
                for (int j = 0; j < 4; ++j) { const float pv = __expf(s[st][qt][j] - mnew); s[st][qt][j] = pv; ls += pv; }
            lrun[qt] = lrun[qt] * alpha + ls;
#pragma unroll
            for (int dt = 0; dt < 8; ++dt) O[dt][qt] *= alpha;
#pragma unroll
            for (int kb = 0; kb < 2; ++kb) Pf[qt][kb] = mk8(pk2(s[2 * kb][qt][0], s[2 * kb][qt][1]), pk2(s[2 * kb][qt][2], s[2 * kb][qt][3]), pk2(s[2 * kb + 1][qt][0], s[2 * kb + 1][qt][1]), pk2(s[2 * kb + 1][qt][2], s[2 * kb + 1][qt][3]));
        }
#pragma unroll
        for (int dt = 0; dt < 8; ++dt)
#pragma unroll
            for (int kb = 0; kb < 2; ++kb) { const bf16x4 a0 = *(const LAS bf16x4*)(Vt + (16 * dt + n) * 72 + 32 * kb + quad * 4), a1 = *(const LAS bf16x4*)(Vt + (16 * dt + n) * 72 + 32 * kb + 16 + quad * 4);
                const bf16x8 a = __builtin_shufflevector(a0, a1, 0, 1, 2, 3, 4, 5, 6, 7);
                O[dt][0] = MFMA(a, Pf[0][kb], O[dt][0]); O[dt][1] = MFMA(a, Pf[1][kb], O[dt][1]); if (kb == 1 && (dt & 1)) asm volatile("" ::: "memory"); }
    }
#pragma unroll
    for (int qt = 0; qt < 2; ++qt) { float l = lrun[qt]; l += __shfl_xor(l, 16); l += __shfl_xor(l, 32); const float inv = 1.0f / l;
#pragma unroll
        for (int dt = 0; dt < 8; ++dt) O[dt][qt] *= inv; }
    __syncthreads();
}

__device__ __forceinline__ void attn_phase(const Ctx& p, int o, int l, bool need_ctx, LAS unsigned char* lds) {
    const int tid = mk_tid(), w = tid >> 6, lane = tid & 63, n = lane & 15, quad = lane >> 4;
    const bf16_t* P = (const bf16_t*)(p.ws + WS_P); const bf16_t* UQ = (const bf16_t*)(p.ws + WS_U); const bf16_t* UKV = UQ + 768;
    bf16_t* MX = (bf16_t*)(p.ws + WS_A);
    const float lam_init = l == 1 ? 0.35550906759f : 0.55605820416f;
    float lam;
    { const float* lv = p.in[25] + o * 256; const float d1 = wsum(lv[lane] * lv[64 + lane]), d2 = wsum(lv[128 + lane] * lv[192 + lane]);
      lam = __uint_as_float(__builtin_amdgcn_readfirstlane(__float_as_uint(expf(d1) - expf(d2) + lam_init))); }
    const int nunits = need_ctx ? 576 : 512;
#pragma unroll 1
    for (int u = blockIdx.x; u < nunits; u += gridDim.x) {
        const bool isctx = u >= 512; const int uu = isctx ? u - 512 : u;
        const bool mla = isctx ? (uu < 32) : (uu < 256); const int v = isctx ? (uu & 31) : (uu & 255);
        int b, head, qb;
        if (isctx) { b = v >> 2; head = v & 3; qb = 0; } else { b = v >> 5; head = (v >> 3) & 3; qb = v & 7; }
        const int qrow0 = isctx ? ML + b * 256 : b * 2048 + qb * 256; const int ntiles = isctx ? 4 : 36;
        f32x4 O[8][2];
        if (mla) {
            attn_core<192, 128>(lds, UQ + head * 192, 1792, qrow0, UKV + head * 256, 1792, P + 2176, 2304, UKV + head * 256 + 128, 1792, b, ntiles, O);
#pragma unroll
            for (int qt = 0; qt < 2; ++qt) { const size_t row = (size_t)(qrow0 + w * 32 + qt * 16 + n);
#pragma unroll
                for (int dt = 0; dt < 8; ++dt) { u32x2 ww; ww.x = pk2(O[dt][qt][0], O[dt][qt][1]); ww.y = pk2(O[dt][qt][2], O[dt][qt][3]); *(u32x2*)(MX + row * 1024 + 512 + head * 128 + 16 * dt + quad * 4) = ww; } }
        } else {
            u32x2 O1[8][2];
            attn_core<64, 64>(lds, P + head * 128, 2304, qrow0, P + 512 + head * 128, 2304, P, 2304, P + 1024 + head * 128, 2304, b, ntiles, O);
#pragma unroll
            for (int dt = 0; dt < 8; ++dt)
#pragma unroll
                for (int qt = 0; qt < 2; ++qt) { O1[dt][qt].x = pk2(O[dt][qt][0], O[dt][qt][1]); O1[dt][qt].y = pk2(O[dt][qt][2], O[dt][qt][3]); }
            attn_core<64, 64>(lds, P + head * 128 + 64, 2304, qrow0, P + 512 + head * 128 + 64, 2304, P, 2304, P + 1024 + head * 128, 2304, b, ntiles, O);
            const float* sl = p.in[27] + o * 128;
#pragma unroll
            for (int qt = 0; qt < 2; ++qt) { const size_t row = (size_t)(qrow0 + w * 32 + qt * 16 + n); float ss = 0.f;
#pragma unroll
                for (int dt = 0; dt < 8; ++dt) { O[dt][qt] = (f32x4){bflo(O1[dt][qt].x), bfhi(O1[dt][qt].x), bflo(O1[dt][qt].y), bfhi(O1[dt][qt].y)} - lam * O[dt][qt]; ss += O[dt][qt][0] * O[dt][qt][0] + O[dt][qt][1] * O[dt][qt][1] + O[dt][qt][2] * O[dt][qt][2] + O[dt][qt][3] * O[dt][qt][3]; }
                ss += __shfl_xor(ss, 16); ss += __shfl_xor(ss, 32); const float rs = rsqrtf(ss * (1.0f / 128.0f) + 1e-6f) * (1.0f - lam_init);
#pragma unroll
                for (int dt = 0; dt < 8; ++dt) { const f32x4 g = *(const f32x4*)(sl + 16 * dt + quad * 4); u32x2 ww; ww.x = pk2(O[dt][qt][0] * rs * g[0], O[dt][qt][1] * rs * g[1]); ww.y = pk2(O[dt][qt][2] * rs * g[2], O[dt][qt][3] * rs * g[3]);
                    *(u32x2*)(MX + row * 1024 + head * 128 + 16 * dt + quad * 4) = ww; } }
        }
    }
}

#ifdef GONLY
#define GSEL(k) && (GONLY == k)
#else
#define GSEL(k)
#endif
__global__ void __launch_bounds__(512) mega(Params kp) {
    extern __shared__ __attribute__((aligned(16))) unsigned char shm[];
    LAS unsigned char* lds = (LAS unsigned char*)shm;
    cg::grid_group grid = cg::this_grid();
    { const float** tabw = (const float**)(kp.ws + WS_TAB); const int t = threadIdx.x; if (t < 34) tabw[t] = kp.in[t]; }
    __syncthreads();
    const int ph_hi = kp.ph_hi;
#pragma unroll 1
    for (int ph = kp.ph_lo; ph < ph_hi; ++ph) {
        unsigned char* ws = kp.ws; asm volatile("" : "+s"(ws));
        Ctx p; p.ws = ws; p.in = (const float* const*)(ws + WS_TAB); p.out = kp.out;
        const int bid = blockIdx.x, nb = gridDim.x, w = mk_tid() >> 6, lane = mk_tid() & 63;
        if (ph == 0) {
#if !defined(ONLY) || ONLY==0
 prep_phase(p, lds);
#endif
 }
        else {
            const int l = (ph - 1) / 10, s = (ph - 1) % 10, eo = l >> 1; const bool odd = l & 1; const bool need_ctx = l < 3; const int Mres = need_ctx ? MT : ML;
            if (!odd && s == 5) continue;
            const float* mod = (const float*)(ws + WS_MOD) + (size_t)l * 9 * 6144;
            const bf16_t* Abuf = (const bf16_t*)(ws + WS_A);
            if (s == 0) norm_phase(p, p.in[6] + l * 1024, mod, 0, MT);
            else if (s == 1) {
#if !defined(ONLY) || ONLY==4
                EpiStore E; E.O = (bf16_t*)(ws + WS_P);
                if (!odd) { E.ldc = 3072; run_gemm(lds, Abuf, (const bf16_t*)(ws + WS_WAB) + (size_t)eo * 3072 * 1024, MT, 3072, 1024, E); }
                else { E.ldc = 2304; run_gemm(lds, Abuf, (const bf16_t*)(ws + WS_WCD) + (size_t)eo * 2304 * 1024, MT, 2304, 1024, E); }
#endif
            }
            else if (s == 2) {
                if (!odd) {
#if !defined(ONLY) || ONLY==1
                    for (int ch = bid; ch < 64; ch += nb) hgrn_chain(p, eo, ch, lds);
#endif
#if !defined(ONLY) || ONLY==2
                    const bool split = nb >= 128;
                    if (!split || bid >= 64) { const int wi = (split ? bid - 64 : bid) * 8 + w, wn = (split ? nb - 64 : nb) * 8;
                        for (int u = wi; u < 576; u += wn) s5_unit(p, eo, u / 18, u % 18, 1, lane); }
#endif
                } else odd_post1(p, eo);
            }
            else if (s == 3) {
                if (!odd) {
#if !defined(ONLY) || ONLY==2
                    for (int u = bid * 8 + w; u < 576; u += nb * 8) s5_unit(p, eo, u / 18, u % 18, 2, lane);
#endif
                } else {
#if !defined(ONLY) || ONLY==4
                    EpiStore E; E.O = (bf16_t*)(ws + WS_U); E.ldc = 1792; run_gemm(lds, Abuf, (const bf16_t*)(ws + WS_WU) + (size_t)eo * 1792 * 640, MT, 1792, 640, E);
#endif
                }
            }
            else if (s == 4) {
                if (!odd) {
#if !defined(ONLY) || ONLY==4
                    EpiGLU E; E.MX = (bf16_t*)(ws + WS_A); E.Z = (const bf16_t*)(ws + WS_Z); E.bias = p.in[21] + eo * 512;
                    run_gemm(lds, (const bf16_t*)(ws + WS_Z), (const bf16_t*)(ws + WS_WGLU) + (size_t)eo * 512 * 512, MT, 512, 512, E);
                    __syncthreads();
#endif
                    hgrn_combine(p, eo);
                } else odd_post2(p, eo);
            }
            else if (s == 5) {
#if !defined(ONLY) || ONLY==3
                attn_phase(p, eo, l, need_ctx, lds);
#endif
            }
            else if (s == 6 || s == 9) {
#if !defined(ONLY) || ONLY==4
                EpiRes E; E.H = (float*)(ws + WS_H); E.gate = mod + (s == 6 ? 2 : 5) * 1024; E.out = (l == 3 && s == 9) ? p.out : nullptr;
                if (s == 6) run_gemm(lds, Abuf, (const bf16_t*)(ws + WS_WO) + (size_t)l * 1024 * 1024, Mres, 1024, 1024, E);
                else run_gemm(lds, (const bf16_t*)(ws + WS_P), (const bf16_t*)(ws + WS_WFO) + (size_t)l * 1024 * 2816, Mres, 1024, 2816, E);
#endif
            }
            else if (s == 7) norm_phase(p, p.in[7] + l * 1024, mod, 3, Mres);
            else if (s == 8) {
#if !defined(ONLY) || ONLY==4
                EpiSwiGLU E; E.G = (bf16_t*)(ws + WS_P); run_gemm(lds, Abuf, (const bf16_t*)(ws + WS_WFI) + (size_t)l * 5632 * 1024, Mres, 5632, 1024, E);
#endif
            }
        }
        if (ph + 1 < ph_hi) grid.sync();
    }
}

extern "C" void kernel_launch(void* const* d_in, const int* in_sizes, int n_in, void* d_out, int out_size, void* d_ws, size_t ws_size, hipStream_t stream) {
    static int grid = 0;
    if (grid == 0) {
        if (n_in != 34 || ws_size < WS_NEED) { fprintf(stderr, "kernel_launch: unexpected n_in %d / ws_size %zu (need %zu)\n", n_in, ws_size, (size_t)WS_NEED); }
        int dev = 0, cus = 0, per_cu = 0;
        hipGetDevice(&dev); hipDeviceGetAttribute(&cus, hipDeviceAttributeMultiprocessorCount, dev);
        hipFuncSetAttribute((const void*)mega, hipFuncAttributeMaxDynamicSharedMemorySize, LDS_BYTES);
        hipOccupancyMaxActiveBlocksPerMultiprocessor(&per_cu, (const void*)mega, 512, LDS_BYTES);
        (void)hipGetLastError();
        if (per_cu < 1) fprintf(stderr, "kernel_launch: occupancy query says %d blocks per CU\n", per_cu);
        grid = cus > 0 ? cus : 256;
    }
    Params p{};
    for (int i = 0; i < 34; ++i) p.in[i] = (const float*)d_in[i];
    p.out = (float*)d_out; p.ws = (unsigned char*)d_ws;
#if MK_MODE == 0
    p.ph_lo = 0; p.ph_hi = NPH;
    void* args[] = {&p};
    hipError_t e = hipLaunchCooperativeKernel((const void*)mega, dim3(grid), dim3(512), args, LDS_BYTES, stream);
    if (e != hipSuccess) fprintf(stderr, "cooperative launch failed: %s (grid %d)\n", hipGetErrorString(e), grid);
#else
    for (int ph = 0; ph < NPH; ++ph) { const int l = (ph - 1) / 10, s = (ph - 1) % 10; if (ph > 0 && !(l & 1) && s == 5) continue;
        p.ph_lo = ph; p.ph_hi = ph + 1; hipLaunchKernelGGL(mega, dim3(grid), dim3(512), LDS_BYTES, stream, p); }
#endif
}
```

```cpp
#include <hip/hip_runtime.h>
#include <hip/hip_cooperative_groups.h>
#include <cstdio>
namespace cg = cooperative_groups;
#ifndef MK_MODE
#define MK_MODE 0
#endif
__device__ __forceinline__ int mk_tid() { int t = threadIdx.x; asm volatile("" : "+v"(t)); return t; }
namespace pg8 {
#define PG8_LAS __attribute__((address_space(3)))
typedef unsigned short bf16_t;
typedef short bf16x8 __attribute__((ext_vector_type(8)));
typedef float f32x4 __attribute__((ext_vector_type(4)));
typedef unsigned u32x4 __attribute__((ext_vector_type(4)));
constexpr int BM = 256, BK = 64, HALF = 128, HTB = HALF * BK * 2  , STAGE_BYTES = 8 * HTB, NXCD = 8, WGM = 8;

__host__ __device__ __forceinline__ int lds_byte(int r, int c) { const int st = (r >> 4) * 2 + (c >> 5), rr = r & 15, cc = c & 31, ob = rr * 64 + cc * 2; return st * 1024 + (ob ^ (((ob >> 9) & 1) << 5)); }
__host__ __device__ __forceinline__ void stage_rc(int b, int& R, int& C) { const int st = b / 1024, sb = b % 1024, swz = sb ^ (((sb >> 9) & 1) << 5); R = (st >> 1) * 16 + swz / 64; C = (st & 1) * 32 + (swz % 64) / 2; }
__host__ __device__ __forceinline__ int perm32(int rho) { const int n = rho >> 4, i = rho & 15; return 8 * (i >> 2) + 4 * n + (i & 3); }

struct Unit { int pm, pn, ks; };
struct Gemm { const bf16_t* A; const bf16_t* Bt; int M, N, K, ld; };

struct StaticOrder {
    int nM, nN, nwg, G, c;
    __host__ __device__ void init(int M, int N, int G_, int c_) { nM = M / BM; nN = N / BM; nwg = nM * nN; G = G_; c = c_; }
    __host__ __device__ bool next(int i, Unit& u) const {
        const long L = (long)i * G + c; if (L >= nwg) return false;
        int wgid = (int)L; { const int q = nwg / NXCD, r = nwg % NXCD, xcd = wgid % NXCD, off = wgid / NXCD; wgid = (xcd < r ? xcd * (q + 1) : r * (q + 1) + (xcd - r) * q) + off; }
        const int nig = WGM * nN, gid = wgid / nig, fm = gid * WGM, gsz = (nM - fm) < WGM ? (nM - fm) : WGM;
        u.pm = fm + ((wgid % nig) % gsz); u.pn = (wgid % nig) / gsz; u.ks = 0; return true;
    }
    __device__ __forceinline__ void a_ready(const Unit&) const {}
    __device__ __forceinline__ void done(const Unit&) const {}
};
struct SliceOrder {
    int pm0, nN, nsplit, total, G, c;
    __host__ __device__ void init(int pm0_, int ntm, int N, int nsplit_, int G_, int c_) { pm0 = pm0_; nN = N / BM; nsplit = nsplit_; total = ntm * nN * nsplit_; G = G_; c = c_; }
    __host__ __device__ bool next(int i, Unit& u) const { const int L = i * G + c; if (L >= total) return false; const int tile = L / nsplit; u.ks = L - tile * nsplit; u.pm = pm0 + tile / nN; u.pn = tile % nN; return true; }
    __device__ __forceinline__ void a_ready(const Unit&) const {}
    __device__ __forceinline__ void done(const Unit&) const {}
};
typedef __bf16 bf16x2_native __attribute__((ext_vector_type(2)));
typedef float f32x2_native __attribute__((ext_vector_type(2)));
__device__ __forceinline__ unsigned cvt_pk_bf16(float lo, float hi) { const f32x2_native v = {lo, hi}; const bf16x2_native r = __builtin_convertvector(v, bf16x2_native); return __builtin_bit_cast(unsigned, r); }
typedef float f32x2 __attribute__((ext_vector_type(2)));
template <class Epi, class Sched, bool STAMP = false>
__device__ __forceinline__ void gemm_phase(PG8_LAS unsigned char* lds, const Gemm g, const Sched& S, const Epi& E, unsigned long long* stamps) {
    const int tid = mk_tid(), wid = __builtin_amdgcn_readfirstlane(tid >> 6), lane = tid & 63, wr = wid >> 2, wc = wid & 3, fr = lane & 15, fq = lane >> 4;
    const int K = g.K, nt = K / BK;
    int ts_lo = 0, ts_hi = 0, nts = 0; const unsigned long long rt_entry = STAMP ? (unsigned long long)wall_clock64() : 0ull;
#define PG8_STAMP() do { if (STAMP && wid == 0 && nts < 64) { const unsigned long long _c = (unsigned long long)clock64(); \
        ts_lo = (lane == nts) ? (int)(unsigned)_c : ts_lo; ts_hi = (lane == nts) ? (int)(unsigned)(_c >> 32) : ts_hi; ++nts; } } while (0)
    PG8_STAMP();
    unsigned voffA[2], voffB[2];
#pragma unroll
    for (int i = 0; i < 2; ++i) { int R, C; stage_rc(tid * 16 + i * 8192, R, C); const int Rb = Epi::PERM ? ((R & ~31) + perm32(R & 31)) : R;
        voffA[i] = (unsigned)(R * g.ld + C) * 2u; voffB[i] = (unsigned)(Rb * g.ld + C) * 2u; }
    const size_t kstep = (size_t)(BK * 2);
    const size_t hstep = (size_t)HALF * g.ld * 2;
    const size_t tstep = 2 * hstep;
    const unsigned ldsw = (unsigned)wid * 1024u;
    const int aoff = lds_byte(wr * 64 + fr, fq * 8), boff = lds_byte(wc * 32 + fr, fq * 8);
#define PG8_SA(b, h) (((b) * 2 + (h)) * HTB)
#define PG8_SB(b, h) ((4 + (b) * 2 + (h)) * HTB)
#define PG8_STAGE(bufoff, gbase, voff) do { _Pragma("unroll") for (int _i = 0; _i < 2; ++_i) \
        __builtin_amdgcn_global_load_lds((const unsigned*)((const char*)(gbase) + (voff)[_i]), (PG8_LAS unsigned*)(lds + (bufoff) + ldsw + _i * 8192), 16, 0, 0); } while (0)
#define PG8_LDA(dst, b, h) do { _Pragma("unroll") for (int m = 0; m < 4; ++m) _Pragma("unroll") for (int k = 0; k < 2; ++k) dst[m][k] = *(const PG8_LAS bf16x8*)(lds + PG8_SA(b, h) + aoff + m * 2048 + k * 1024); } while (0)
#define PG8_LDB(dst, b, h) do { _Pragma("unroll") for (int n = 0; n < 2; ++n) _Pragma("unroll") for (int k = 0; k < 2; ++k) dst[n][k] = *(const PG8_LAS bf16x8*)(lds + PG8_SB(b, h) + boff + n * 2048 + k * 1024); } while (0)
#define PG8_MMA(ai, bj, At, Bt) do { __builtin_amdgcn_s_setprio(1); _Pragma("unroll") for (int m = 0; m < 4; ++m) _Pragma("unroll") for (int n = 0; n < 2; ++n) _Pragma("unroll") for (int k = 0; k < 2; ++k) \
        acc[ai][bj][m][n] = __builtin_amdgcn_mfma_f32_16x16x32_bf16(Bt[n][k], At[m][k], acc[ai][bj][m][n], 0, 0, 0); __builtin_amdgcn_s_setprio(0); } while (0)
#define PG8_WAIT_V(n) asm volatile("s_waitcnt vmcnt(" #n ")" ::: "memory")
#define PG8_WAIT_L(n) asm volatile("s_waitcnt lgkmcnt(" #n ")" ::: "memory")
#define PG8_BAR __builtin_amdgcn_s_barrier()
#define PG8_SCHED __builtin_amdgcn_sched_barrier(0)
    Unit cur, nxt; int ui = 0;
    if (!S.next(0, cur)) return;
    f32x4 acc[2][2][4][2];
#pragma unroll
    for (int a = 0; a < 2; ++a)
#pragma unroll
        for (int b = 0; b < 2; ++b)
#pragma unroll
            for (int m = 0; m < 4; ++m)
#pragma unroll
                for (int n = 0; n < 2; ++n) acc[a][b][m][n] = (f32x4){0.f, 0.f, 0.f, 0.f};
    bf16x8 At[4][2], B0[2][2], B1[2][2];
    const char* cA = (const char*)g.A + (size_t)cur.pm * tstep + (size_t)cur.ks * K * 2; const char* cB = (const char*)g.Bt + (size_t)cur.pn * tstep + (size_t)cur.ks * K * 2;
    S.a_ready(cur);
    PG8_STAGE(PG8_SB(0, 0), cB, voffB); PG8_STAGE(PG8_SA(0, 0), cA, voffA); PG8_STAGE(PG8_SB(0, 1), cB + hstep, voffB); PG8_STAGE(PG8_SA(0, 1), cA + hstep, voffA);
    if (wr == 1) PG8_BAR;
    PG8_WAIT_V(4); PG8_BAR;
    PG8_STAGE(PG8_SB(1, 0), cB + kstep, voffB); PG8_STAGE(PG8_SA(1, 0), cA + kstep, voffA); PG8_STAGE(PG8_SB(1, 1), cB + hstep + kstep, voffB);
    PG8_WAIT_V(6); PG8_BAR;
    PG8_STAMP();
    for (;;) {
        const bool has_next = S.next(ui + 1, nxt);
        const char* nA = has_next ? (const char*)g.A + (size_t)nxt.pm * tstep + (size_t)nxt.ks * K * 2 : cA; const char* nB = has_next ? (const char*)g.Bt + (size_t)nxt.pn * tstep + (size_t)nxt.ks * K * 2 : cB;
        for (int t = 0; t < nt; t += 2) {
            const bool last = (t == nt - 2);
            const char* a1 = cA + (size_t)(t + 1) * kstep;
            const char* a2 = last ? nA : cA + (size_t)(t + 2) * kstep; const char* b2 = last ? nB : cB + (size_t)(t + 2) * kstep;
            const char* a3 = a2 + kstep; const char* b3 = b2 + kstep;
            if (last && has_next) S.a_ready(nxt);
            PG8_LDB(B0, 0, 0); PG8_SCHED; PG8_LDA(At, 0, 0); PG8_STAGE(PG8_SA(1, 1), a1 + hstep, voffA);
            PG8_WAIT_L(8); PG8_BAR; PG8_WAIT_L(0); PG8_MMA(0, 0, At, B0); PG8_BAR; PG8_SCHED;
            PG8_LDB(B1, 0, 1); PG8_STAGE(PG8_SB(0, 0), b2, voffB);
            PG8_BAR; PG8_WAIT_L(0); PG8_MMA(0, 1, At, B1); PG8_BAR;
            PG8_LDA(At, 0, 1); PG8_STAGE(PG8_SA(0, 0), a2, voffA);
            PG8_BAR; PG8_WAIT_L(0); PG8_MMA(1, 0, At, B0); PG8_BAR; PG8_SCHED;
            PG8_STAGE(PG8_SB(0, 1), b2 + hstep, voffB);
            PG8_WAIT_V(6); PG8_BAR; PG8_MMA(1, 1, At, B1); PG8_BAR;
            PG8_LDB(B0, 1, 0); PG8_SCHED; PG8_LDA(At, 1, 0); PG8_STAGE(PG8_SA(0, 1), a2 + hstep, voffA);
            PG8_WAIT_L(8); PG8_BAR; PG8_WAIT_L(0); PG8_MMA(0, 0, At, B0); PG8_BAR; PG8_SCHED;
            PG8_LDB(B1, 1, 1); PG8_STAGE(PG8_SB(1, 0), b3, voffB);
            PG8_BAR; PG8_WAIT_L(0); PG8_MMA(0, 1, At, B1); PG8_BAR;
            PG8_LDA(At, 1, 1); PG8_STAGE(PG8_SA(1, 0), a3, voffA);
            PG8_BAR; PG8_WAIT_L(0); PG8_MMA(1, 0, At, B0); PG8_BAR; PG8_SCHED;
            PG8_STAGE(PG8_SB(1, 1), b3 + hstep, voffB);
            PG8_WAIT_V(6); PG8_BAR; PG8_MMA(1, 1, At, B1); PG8_BAR;
        }
        PG8_STAMP();
        if constexpr (!Epi::AFTER_DRAIN) { E(acc, cur, wr, wc, fr, fq); S.done(cur); }
        PG8_STAMP();
        if (!has_next) break;
#pragma unroll
        for (int a = 0; a < 2; ++a)
#pragma unroll
            for (int b = 0; b < 2; ++b)
#pragma unroll
                for (int m = 0; m < 4; ++m)
#pragma unroll
                    for (int n = 0; n < 2; ++n) acc[a][b][m][n] = (f32x4){0.f, 0.f, 0.f, 0.f};
        cur = nxt; cA = nA; cB = nB; ++ui;
    }
    PG8_WAIT_V(0);
    if (wr == 0) PG8_BAR;
    PG8_BAR;
    if constexpr (Epi::AFTER_DRAIN) { E.fused(acc, cur, wr, wc, fr, fq, lds, wid, lane); S.done(cur); }
    PG8_STAMP();
    if (STAMP && wid == 0) { stamps[lane] = lane < nts ? (((unsigned long long)(unsigned)ts_hi << 32) | (unsigned)ts_lo) : 0ull;
        if (lane == 62) stamps[62] = rt_entry; if (lane == 63) stamps[63] = (unsigned long long)wall_clock64(); }
#undef PG8_STAMP
#undef PG8_SA
#undef PG8_SB
#undef PG8_STAGE
#undef PG8_LDA
#undef PG8_LDB
#undef PG8_MMA
#undef PG8_WAIT_V
#undef PG8_WAIT_L
#undef PG8_BAR
#undef PG8_SCHED
}
}

using pg8::bf16_t; using pg8::bf16x8; using pg8::f32x4; using pg8::u32x4;
#define LAS __attribute__((address_space(3)))
typedef unsigned u32x2 __attribute__((ext_vector_type(2)));
typedef short bf16x4 __attribute__((ext_vector_type(4)));

#define XB_TMO      128
#define XB_XCNT(j)  (256  + 64 * (j))
#define XB_XSUB(j)  (1280 + 64 * (j))
#define XB_XGEN(j)  (2304 + 64 * (j))
#define XB_TOP      3328
#define XB_TOPGEN   3392
#define XCD_BAR_WORDS 3456
#define XB_SPIN_CAP (1u << 18)

__device__ __forceinline__ unsigned xb_ld(unsigned* p)              { return __hip_atomic_load(p, __ATOMIC_RELAXED, __HIP_MEMORY_SCOPE_AGENT); }
__device__ __forceinline__ unsigned xb_add(unsigned* p, unsigned v) { return __hip_atomic_fetch_add(p, v, __ATOMIC_RELAXED, __HIP_MEMORY_SCOPE_AGENT); }
__device__ __forceinline__ unsigned xb_xcc_id() { return (unsigned)__builtin_amdgcn_s_getreg((3 << 11) | 20) & 0xFu; }
#define XB_SPIN(cond, bar) do { unsigned _sp = 0; while (cond) { __builtin_amdgcn_s_sleep(1); \
    if ((++_sp & 255u) == 0u) { if (xb_ld(&(bar)[XB_TMO])) break; if (_sp > XB_SPIN_CAP) { atomicAdd(&(bar)[XB_TMO], 1u); break; } } } } while (0)

struct XcdBarrier {
    unsigned* bar; unsigned x;
    volatile LAS unsigned* st;
};

__device__ __forceinline__ XcdBarrier xcd_barrier_post(unsigned* bar, volatile LAS unsigned* st) {
    XcdBarrier b; b.bar = bar; b.x = xb_xcc_id(); b.st = st;
    if (threadIdx.x == 0) (void)xb_add(&bar[XB_XCNT(b.x)], 1u);
    return b;
}
__device__ __forceinline__ void xcd_barrier_complete(unsigned* bar, unsigned x, unsigned& nloc, unsigned& nx) {
    const unsigned G = gridDim.x * gridDim.y * gridDim.z;
    unsigned sum, cnt, mine, sp = 0u;
    for (;;) {
        sum = 0u; cnt = 0u; mine = 0u;
#pragma unroll
        for (unsigned j = 0; j < 16; ++j) { const unsigned c = xb_ld(&bar[XB_XCNT(j)]); sum += c; cnt += (c > 0u) ? 1u : 0u; mine = (j == x) ? c : mine; }
        if (sum == G) break;
        __builtin_amdgcn_s_sleep(1);
        if ((++sp & 255u) == 0u) { if (xb_ld(&bar[XB_TMO])) break; if (sp > XB_SPIN_CAP) { atomicAdd(&bar[XB_TMO], 1u); break; } }
    }
    nloc = mine > 0u ? mine : 1u; nx = cnt > 0u ? cnt : 1u;
}

__device__ __forceinline__ void xcd_barrier(const XcdBarrier& b) {
    asm volatile("s_waitcnt vmcnt(0)" ::: "memory");
    __syncthreads();
    if (threadIdx.x == 0) {
        unsigned* bar = b.bar;
        __builtin_amdgcn_s_waitcnt(0);
        unsigned nloc = b.st[0], nx = b.st[1];
        if (nloc == 0u) { xcd_barrier_complete(bar, b.x, nloc, nx); b.st[0] = nloc; b.st[1] = nx; }
        const unsigned old = xb_add(&bar[XB_XSUB(b.x)], 1u);
        const unsigned gen = old / nloc;
        if (old + 1u == (gen + 1u) * nloc) {
            __builtin_amdgcn_fence(__ATOMIC_RELEASE, "agent");
            asm volatile("s_waitcnt vmcnt(0)" ::: "memory");
            const unsigned og = xb_add(&bar[XB_TOP], 1u);
            const unsigned tg = og / nx;
            if (og + 1u == (tg + 1u) * nx) xb_add(&bar[XB_TOPGEN], 1u);
            else XB_SPIN(xb_ld(&bar[XB_TOPGEN]) == tg, bar);
            __builtin_amdgcn_fence(__ATOMIC_ACQUIRE, "agent");
            xb_add(&bar[XB_XGEN(b.x)], 1u);
            asm volatile("s_waitcnt vmcnt(0)" ::: "memory");
        } else {
            XB_SPIN(xb_ld(&bar[XB_XGEN(b.x)]) == gen, bar);
            __builtin_amdgcn_fence(__ATOMIC_ACQUIRE, "agent");
            asm volatile("s_waitcnt vmcnt(0)" ::: "memory");
        }
    }
    __syncthreads();
}

constexpr int DM = 1024, ML = 16384, MC = 2048, MT = 18432, FH = 2816;
constexpr int LDS_BYTES = 152 * 1024 + 256;
constexpr int NPH = 42;

constexpr size_t WS_H    = 0;
constexpr size_t WS_A    = WS_H + (size_t)MT * DM * 4;
constexpr size_t WS_P    = WS_A + (size_t)MT * DM * 2;
constexpr size_t WS_WFI  = WS_P + (size_t)MT * 3072 * 2;
constexpr size_t WS_WFO  = WS_WFI + 4ull * 5632 * 1024 * 2;
constexpr size_t WS_WO   = WS_WFO + 4ull * 1024 * 2816 * 2;
constexpr size_t WS_WAB  = WS_WO + 4ull * 1024 * 1024 * 2;
constexpr size_t WS_WCD  = WS_WAB + 2ull * 3072 * 1024 * 2;
constexpr size_t WS_WGLU = WS_WCD + 2ull * 2304 * 1024 * 2;
constexpr size_t WS_WU   = WS_WGLU + 2ull * 512 * 512 * 2;
constexpr size_t WS_MOD  = WS_WU + 2ull * 1792 * 640 * 2;
constexpr size_t WS_ROPE = WS_MOD + 4ull * 9 * 6144 * 4;
constexpr size_t WS_S5A  = WS_ROPE + 64 * 16 * 2 * 4;
constexpr size_t WS_S5BB = WS_S5A + 2ull * 2 * 32 * 64 * 4 * 4;
constexpr size_t WS_S5CC = WS_S5BB + 2ull * 2 * 32 * 2 * 64 * 16 * 2;
constexpr size_t WS_LB   = WS_S5CC + 2ull * 2 * 32 * 4 * 16 * 32 * 2;
constexpr size_t WS_TAB  = WS_LB + 2 * 512 * 4;
constexpr size_t WS_SS   = (WS_TAB + 64 * 8 + 255) & ~(size_t)255;
constexpr size_t WS_BAR  = WS_SS + 8ull * MT * 4;
constexpr size_t WS_BIAS = WS_BAR + XCD_BAR_WORDS * 4;
constexpr size_t WS_X    = WS_BIAS + 4ull * 9 * 8704 * 4;
constexpr size_t WS_HB1  = WS_X;
constexpr size_t WS_OF   = WS_X;
constexpr size_t WS_OB   = WS_OF + (size_t)MT * 512 * 2;
constexpr size_t WS_Z    = WS_OB + (size_t)MT * 512 * 2;
constexpr size_t WS_E    = WS_Z + (size_t)MT * 512 * 2;
constexpr size_t WS_E63  = WS_E + 8ull * 2 * 36 * 32 * 128 * 4;
constexpr size_t WS_END_EVEN = WS_E63 + 2ull * 288 * 4 * 128 * 2;
constexpr size_t WS_Q1   = WS_A;
constexpr size_t WS_VT1  = WS_A + (size_t)MT * 512 * 2;
constexpr size_t WS_U    = WS_X;
constexpr size_t WS_END_ODD = WS_U + (size_t)MT * 1792 * 2;
constexpr size_t WS_NEED = WS_END_EVEN > WS_END_ODD ? WS_END_EVEN : WS_END_ODD;
static_assert(WS_NEED <= 402653184ull, "workspace too large");

struct Params { const float* in[34]; float* out; unsigned char* ws; int ph_lo, ph_hi; };
struct Ctx { unsigned char* ws; const float* const* in; float* out; };

__device__ __forceinline__ float bf2f(unsigned v) { return __uint_as_float(v << 16); }
__device__ __forceinline__ float bflo(unsigned w) { return __uint_as_float(w << 16); }
__device__ __forceinline__ float bfhi(unsigned w) { return __uint_as_float(w & 0xffff0000u); }
__device__ __forceinline__ unsigned pk2(float lo, float hi) { return pg8::cvt_pk_bf16(lo, hi); }
__device__ __forceinline__ bf16_t f2bf(float f) { unsigned u = __float_as_uint(f); u += 0x7FFFu + ((u >> 16) & 1u); return (bf16_t)(u >> 16); }
__device__ __forceinline__ float wsum(float v) {
#pragma unroll
    for (int o = 32; o >= 1; o >>= 1) v += __shfl_xor(v, o);
    return v; }
__device__ __forceinline__ float rcpf_(float x) { return __builtin_amdgcn_rcpf(x); }
__device__ __forceinline__ float siluf(float x) { return x * rcpf_(1.0f + __expf(-x)); }
__device__ __forceinline__ bf16x8 mk8(unsigned a, unsigned b, unsigned c, unsigned d) { u32x4 w = {a, b, c, d}; return __builtin_bit_cast(bf16x8, w); }
__device__ __forceinline__ bf16x8 zero8() { return mk8(0u, 0u, 0u, 0u); }
#define MFMA(a, b, c) __builtin_amdgcn_mfma_f32_16x16x32_bf16((a), (b), (c), 0, 0, 0)

__device__ __forceinline__ double dexp(double x) {
    const double y = x * (1.0 / 64.0); double s = 1.0, t = 1.0;
#pragma unroll
    for (int i = 1; i <= 13; ++i) { t *= y * (1.0 / (double)i); s += t; }
#pragma unroll
    for (int i = 0; i < 6; ++i) s *= s;
    return s; }
__device__ __forceinline__ void dsincos(double x, double& sn, double& cs) {
    const double TWO_PI = 6.283185307179586476925287; const double k = rint(x * (1.0 / TWO_PI)); const double r = (x - k * TWO_PI) * 0.125;
    const double r2 = r * r; double s = r, t = r, c = 1.0, u = 1.0;
#pragma unroll
    for (int i = 1; i <= 7; ++i) { t *= -r2 * (1.0 / (double)((2 * i) * (2 * i + 1))); s += t; u *= -r2 * (1.0 / (double)((2 * i - 1) * (2 * i))); c += u; }
#pragma unroll
    for (int i = 0; i < 3; ++i) { const double s2 = 2.0 * s * c, c2 = c * c - s * s; s = s2; c = c2; }
    sn = s; cs = c; }

struct EpiRes {
    static constexpr bool PERM = false, AFTER_DRAIN = false;
    float* H; const float* gate; float* out;
    bf16_t* Hb; const float* gn; const float* scn; float* ss;
    __device__ __forceinline__ void operator()(const f32x4 (&acc)[2][2][4][2], const pg8::Unit& u, int wr, int wc, int fr, int fq) const {
        const int r = u.pm < 64 ? (u.pm >> 3) : 8;
        const int row0 = u.pm * 256 + wr * 64 + fr, col0 = u.pn * 256 + wc * 32 + 4 * fq;
        const float* gp = gate + r * 6144 + col0;
        f32x4 gv[2][2], gs[2][2];
#pragma unroll
        for (int bj = 0; bj < 2; ++bj)
#pragma unroll
            for (int n = 0; n < 2; ++n) { const int co = bj * 128 + n * 16; gv[bj][n] = *(const f32x4*)(gp + co); gs[bj][n] = (f32x4){0.f, 0.f, 0.f, 0.f};
                if (Hb != nullptr) gs[bj][n] = *(const f32x4*)(gn + col0 + co) * (*(const f32x4*)(scn + r * 6144 + col0 + co) + 1.0f); }
#pragma unroll
        for (int am = 0; am < 4; ++am) { const int ai = am >> 1, m0 = (am & 1) * 2;
            f32x4 hv[2][2][2];
#pragma unroll
            for (int mm = 0; mm < 2; ++mm)
#pragma unroll
                for (int bj = 0; bj < 2; ++bj)
#pragma unroll
                    for (int n = 0; n < 2; ++n) hv[mm][bj][n] = *(const f32x4*)(H + (size_t)(row0 + ai * 128 + (m0 + mm) * 16) * 1024 + col0 + bj * 128 + n * 16);
            asm volatile("" ::: "memory");
#pragma unroll
            for (int mm = 0; mm < 2; ++mm) { const int m = m0 + mm; const int row = row0 + ai * 128 + m * 16; float sq = 0.f;
#pragma unroll
                for (int bj = 0; bj < 2; ++bj)
#pragma unroll
                    for (int n = 0; n < 2; ++n) { const size_t off = (size_t)row * 1024 + col0 + bj * 128 + n * 16;
                        const f32x4 v = hv[mm][bj][n] + gv[bj][n] * acc[ai][bj][m][n];
                        if (out == nullptr) *(f32x4*)(H + off) = v; else if (u.pm < 64) *(f32x4*)(out + off) = v;
                        if (Hb != nullptr) { sq += v[0] * v[0] + v[1] * v[1] + v[2] * v[2] + v[3] * v[3]; const f32x4 hb = v * gs[bj][n];
                            u32x2 w; w.x = pk2(hb[0], hb[1]); w.y = pk2(hb[2], hb[3]); *(u32x2*)(Hb + off) = w; } }
                if (Hb != nullptr) { sq += __shfl_xor(sq, 16); sq += __shfl_xor(sq, 32); if (fq == 0) (void)__hip_atomic_fetch_add(ss + row, sq, __ATOMIC_RELAXED, __HIP_MEMORY_SCOPE_AGENT); } }
            asm volatile("" ::: "memory");
        }
    }
};
template <bool NORM> struct EpiStore {
    static constexpr bool PERM = true, AFTER_DRAIN = false;
    bf16_t* O; int ldc; const float* ss; const float* bias;
    __device__ __forceinline__ void operator()(const f32x4 (&acc)[2][2][4][2], const pg8::Unit& u, int wr, int wc, int fr, int fq) const {
        const int row0 = u.pm * 256 + wr * 64 + fr, col0 = u.pn * 256 + wc * 32 + 8 * fq;
        const int r = u.pm < 64 ? (u.pm >> 3) : 8;
        f32x4 bv[2][2];
#pragma unroll
        for (int bj = 0; bj < 2; ++bj)
#pragma unroll
            for (int n = 0; n < 2; ++n) bv[bj][n] = NORM ? *(const f32x4*)(bias + r * 8704 + col0 + bj * 128 + 4 * n) : (f32x4){0.f, 0.f, 0.f, 0.f};
        float rsv[2][4];
#pragma unroll
        for (int ai = 0; ai < 2; ++ai)
#pragma unroll
            for (int m = 0; m < 4; ++m) rsv[ai][m] = NORM ? ss[row0 + ai * 128 + m * 16] : 1.0f;
        asm volatile("" ::: "memory");
#pragma unroll
        for (int ai = 0; ai < 2; ++ai)
#pragma unroll
            for (int m = 0; m < 4; ++m) { const int row = row0 + ai * 128 + m * 16; bf16_t* rowp = O + (size_t)row * ldc + col0;
                const float rs = NORM ? rsqrtf(rsv[ai][m] * (1.0f / 1024.0f) + 1e-6f) : 1.0f;
#pragma unroll
                for (int bj = 0; bj < 2; ++bj) { const f32x4 v0 = acc[ai][bj][m][0] * rs + bv[bj][0], v1 = acc[ai][bj][m][1] * rs + bv[bj][1];
                    u32x4 w; w.x = pk2(v0[0], v0[1]); w.y = pk2(v0[2], v0[3]); w.z = pk2(v1[0], v1[1]); w.w = pk2(v1[2], v1[3]);
                    *(u32x4*)(rowp + bj * 128) = w; } }
    }
};
struct EpiSwiGLU {
    static constexpr bool PERM = true, AFTER_DRAIN = false;
    bf16_t* G; const float* ss; const float* bias;
    __device__ __forceinline__ void operator()(const f32x4 (&acc)[2][2][4][2], const pg8::Unit& u, int wr, int wc, int fr, int fq) const {
        const int row0 = u.pm * 256 + wr * 64 + fr, col0 = u.pn * 128 + wc * 32 + 8 * fq;
        const int r = u.pm < 64 ? (u.pm >> 3) : 8;
        const float* bp = bias + r * 8704 + u.pn * 256 + wc * 32 + 8 * fq;
        const f32x4 bg0 = *(const f32x4*)bp, bg1 = *(const f32x4*)(bp + 4), bu0 = *(const f32x4*)(bp + 128), bu1 = *(const f32x4*)(bp + 132);
        float rsv[2][4];
#pragma unroll
        for (int ai = 0; ai < 2; ++ai)
#pragma unroll
            for (int m = 0; m < 4; ++m) rsv[ai][m] = ss[row0 + ai * 128 + m * 16];
        asm volatile("" ::: "memory");
#pragma unroll
        for (int ai = 0; ai < 2; ++ai)
#pragma unroll
            for (int m = 0; m < 4; ++m) { const int row = row0 + ai * 128 + m * 16; bf16_t* rowp = G + (size_t)row * FH + col0;
                const float rs = rsqrtf(rsv[ai][m] * (1.0f / 1024.0f) + 1e-6f);
                const f32x4 g0 = acc[ai][0][m][0] * rs + bg0, g1 = acc[ai][0][m][1] * rs + bg1, u0 = acc[ai][1][m][0] * rs + bu0, u1 = acc[ai][1][m][1] * rs + bu1;
                u32x4 w; w.x = pk2(siluf(g0[0]) * u0[0], siluf(g0[1]) * u0[1]); w.y = pk2(siluf(g0[2]) * u0[2], siluf(g0[3]) * u0[3]);
                w.z = pk2(siluf(g1[0]) * u1[0], siluf(g1[1]) * u1[1]); w.w = pk2(siluf(g1[2]) * u1[2], siluf(g1[3]) * u1[3]);
                *(u32x4*)rowp = w; }
    }
};
struct EpiGLU {
    static constexpr bool PERM = true, AFTER_DRAIN = false;
    bf16_t* MX; const bf16_t* Z; const float* bias;
    __device__ __forceinline__ void operator()(const f32x4 (&acc)[2][2][4][2], const pg8::Unit& u, int wr, int wc, int fr, int fq) const {
        const int row0 = u.pm * 256 + wr * 64 + fr, col0 = u.pn * 256 + wc * 32 + 8 * fq;
        f32x4 b0[2], b1[2];
#pragma unroll
        for (int bj = 0; bj < 2; ++bj) { b0[bj] = *(const f32x4*)(bias + col0 + bj * 128); b1[bj] = *(const f32x4*)(bias + col0 + bj * 128 + 4); }
#pragma unroll
        for (int ai = 0; ai < 2; ++ai) {
            u32x4 zz[4][2];
#pragma unroll
            for (int m = 0; m < 4; ++m)
#pragma unroll
                for (int bj = 0; bj < 2; ++bj) zz[m][bj] = *(const u32x4*)(Z + (size_t)(row0 + ai * 128 + m * 16) * 512 + col0 + bj * 128);
            asm volatile("" ::: "memory");
#pragma unroll
            for (int m = 0; m < 4; ++m) { const int row = row0 + ai * 128 + m * 16;
#pragma unroll
                for (int bj = 0; bj < 2; ++bj) { const int col = col0 + bj * 128; const u32x4 z = zz[m][bj];
                    const f32x4 v0 = acc[ai][bj][m][0] + b0[bj], v1 = acc[ai][bj][m][1] + b1[bj];
                    u32x4 w;
                    w.x = pk2(bflo(z.x) * rcpf_(1.f + __expf(-v0[0])), bfhi(z.x) * rcpf_(1.f + __expf(-v0[1])));
                    w.y = pk2(bflo(z.y) * rcpf_(1.f + __expf(-v0[2])), bfhi(z.y) * rcpf_(1.f + __expf(-v0[3])));
                    w.z = pk2(bflo(z.z) * rcpf_(1.f + __expf(-v1[0])), bfhi(z.z) * rcpf_(1.f + __expf(-v1[1])));
                    w.w = pk2(bflo(z.w) * rcpf_(1.f + __expf(-v1[2])), bfhi(z.w) * rcpf_(1.f + __expf(-v1[3])));
                    *(u32x4*)(MX + (size_t)row * 1024 + col) = w; } }
            asm volatile("" ::: "memory");
        }
    }
};

template <class Epi> __device__ __forceinline__ void run_gemm(LAS unsigned char* lds, const bf16_t* A, const bf16_t* Bt, int M, int N, int K, const Epi& E) {
    pg8::Gemm g; g.A = A; g.Bt = Bt; g.M = M; g.N = N; g.K = K; g.ld = K;
    pg8::StaticOrder S; S.init(M, N, (int)gridDim.x, (int)blockIdx.x);
    pg8::gemm_phase<Epi, pg8::StaticOrder, false>(lds, g, S, E, nullptr);
}

struct EpiResAtomic {
    static constexpr bool PERM = false, AFTER_DRAIN = false;
    float* H; const float* gate;
    __device__ __forceinline__ void operator()(const f32x4 (&acc)[2][2][4][2], const pg8::Unit& u, int wr, int wc, int fr, int fq) const {
        const int r = u.pm < 64 ? (u.pm >> 3) : 8;
        const int row0 = u.pm * 256 + wr * 64 + fr, col0 = u.pn * 256 + wc * 32 + 4 * fq;
        const float* gp = gate + r * 6144 + col0;
        f32x4 gv[2][2];
#pragma unroll
        for (int bj = 0; bj < 2; ++bj)
#pragma unroll
            for (int n = 0; n < 2; ++n) gv[bj][n] = *(const f32x4*)(gp + bj * 128 + n * 16);
#pragma unroll
        for (int ai = 0; ai < 2; ++ai)
#pragma unroll
            for (int m = 0; m < 4; ++m) { const size_t off = (size_t)(row0 + ai * 128 + m * 16) * 1024 + col0;
#pragma unroll
                for (int bj = 0; bj < 2; ++bj)
#pragma unroll
                    for (int n = 0; n < 2; ++n) { float* pp = H + off + bj * 128 + n * 16; const f32x4 v = gv[bj][n] * acc[ai][bj][m][n];
#pragma unroll
                        for (int q = 0; q < 4; ++q) (void)__hip_atomic_fetch_add(pp + q, v[q], __ATOMIC_RELAXED, __HIP_MEMORY_SCOPE_AGENT); } }
    }
};
template <class Epi> __device__ __forceinline__ void run_gemm_slices(LAS unsigned char* lds, const bf16_t* A, const bf16_t* Bt, int Kfull, int nsplit, const Epi& E) {
    pg8::Gemm g; g.A = A; g.Bt = Bt; g.M = MT; g.N = 1024; g.K = Kfull / nsplit; g.ld = Kfull;
    pg8::SliceOrder S; S.init(64, 8, 1024, nsplit, (int)gridDim.x, (int)blockIdx.x);
    pg8::gemm_phase<Epi, pg8::SliceOrder, false>(lds, g, S, E, nullptr);
}

__device__ __forceinline__ void tr_job(const float* __restrict__ src, bf16_t* __restrict__ dst, int ldd, int K, int N, int mode, int& rot, LAS float* tile) {
    const int tid = mk_tid(), nb = gridDim.x, tn = (N + 255) / 256, nt = (K / 64) * tn;
    const int start = (int)((blockIdx.x + nb - (rot % nb)) % nb); rot += nt;
    const int c4 = (tid & 15) * 4, r0 = tid >> 4;
    float4 v[8], vn[8];
    auto ld = [&](int t, float4 (&x)[8]) { const int k0 = (t / tn) * 64, n0 = (t % tn) * 256;
#pragma unroll
        for (int i = 0; i < 2; ++i)
#pragma unroll
            for (int j = 0; j < 4; ++j) { const int nn = n0 + c4 + 64 * j; x[i * 4 + j] = nn < N ? *(const float4*)(src + (size_t)(k0 + r0 + 32 * i) * N + nn) : (float4){0.f, 0.f, 0.f, 0.f}; } };
#pragma unroll
    for (int q = 0; q < 8; ++q) { v[q] = (float4){0.f, 0.f, 0.f, 0.f}; vn[q] = (float4){0.f, 0.f, 0.f, 0.f}; }
    if (start < nt) ld(start, v);
    if (start + nb < nt) ld(start + nb, vn);
    for (int t = start; t < nt; t += nb) {
        const int k0 = (t / tn) * 64, n0 = (t % tn) * 256;
#pragma unroll
        for (int i = 0; i < 2; ++i)
#pragma unroll
            for (int j = 0; j < 4; ++j) { LAS float* tp = tile + (r0 + 32 * i) * 257 + c4 + 64 * j; tp[0] = v[i * 4 + j].x; tp[1] = v[i * 4 + j].y; tp[2] = v[i * 4 + j].z; tp[3] = v[i * 4 + j].w; }
        __syncthreads();
#pragma unroll
        for (int q = 0; q < 8; ++q) v[q] = vn[q];
        if (t + 2 * nb < nt) ld(t + 2 * nb, vn);
        { const int n = tid >> 1, kh = (tid & 1) * 32; const int nn = n0 + n;
          if (nn < N) {
              const int drow = mode == 0 ? nn : (nn < FH ? (nn / 128) * 256 + (nn % 128) : ((nn - FH) / 128) * 256 + 128 + ((nn - FH) % 128));
#pragma unroll
              for (int q = 0; q < 4; ++q) { const int k8 = kh + q * 8;
                  u32x4 w; w.x = pk2(tile[(k8 + 0) * 257 + n], tile[(k8 + 1) * 257 + n]); w.y = pk2(tile[(k8 + 2) * 257 + n], tile[(k8 + 3) * 257 + n]);
                  w.z = pk2(tile[(k8 + 4) * 257 + n], tile[(k8 + 5) * 257 + n]); w.w = pk2(tile[(k8 + 6) * 257 + n], tile[(k8 + 7) * 257 + n]);
                  *(u32x4*)(dst + (size_t)drow * ldd + k0 + k8) = w; } } }
        __syncthreads();
    }
}

__device__ __forceinline__ void prep_phase(const Ctx& p, LAS unsigned char* lds, int part) {
    const int tid = mk_tid(), nb = gridDim.x, bid = blockIdx.x;
    unsigned char* ws = p.ws;
    if (part != 2) { LAS float* tile = (LAS float*)lds; int rot = 0;
      for (int l = 0; l < 4; ++l) {
          tr_job(p.in[9] + (size_t)l * 1024 * 5632, (bf16_t*)(ws + WS_WFI) + (size_t)l * 5632 * 1024, 1024, 1024, 5632, 1, rot, tile);
          tr_job(p.in[10] + (size_t)l * 2816 * 1024, (bf16_t*)(ws + WS_WFO) + (size_t)l * 1024 * 2816, 2816, 2816, 1024, 0, rot, tile);
          tr_job(p.in[8] + (size_t)l * 1024 * 1024, (bf16_t*)(ws + WS_WO) + (size_t)l * 1024 * 1024, 1024, 1024, 1024, 0, rot, tile); }
      for (int e = 0; e < 2; ++e) {
          tr_job(p.in[11] + (size_t)e * 1024 * 3072, (bf16_t*)(ws + WS_WAB) + (size_t)e * 3072 * 1024, 1024, 1024, 3072, 0, rot, tile);
          tr_job(p.in[20] + (size_t)e * 512 * 512, (bf16_t*)(ws + WS_WGLU) + (size_t)e * 512 * 512, 512, 512, 512, 0, rot, tile);
          tr_job(p.in[24] + (size_t)e * 1024 * 2240, (bf16_t*)(ws + WS_WCD) + (size_t)e * 2304 * 1024, 1024, 1024, 2240, 0, rot, tile);
          tr_job(p.in[30] + (size_t)e * 384 * 768, (bf16_t*)(ws + WS_WU) + (size_t)e * 1792 * 640, 640, 384, 768, 0, rot, tile);
          tr_job(p.in[31] + (size_t)e * 256 * 1024, (bf16_t*)(ws + WS_WU) + (size_t)e * 1792 * 640 + 768 * 640 + 384, 640, 256, 1024, 0, rot, tile); } }
    if (part == 1) return;
    if (part != 3) {
        LAS float* red = (LAS float*)lds;
        LAS float* sc = (LAS float*)(lds + 73728);
        __syncthreads();
        for (int i = tid; i < 9 * 1024; i += 512) { const int r = i >> 10, k = i & 1023; const float v = r < 8 ? p.in[1][r * 1024 + k] : p.in[3][k]; sc[i] = siluf(v); }
        __syncthreads();
        for (int u = bid; u < 192; u += nb) {
            const int l = u / 48, n0 = (u % 48) * 128, cg4 = (tid & 31) * 4, ks = tid >> 5;
            const float* w = p.in[4] + (size_t)l * 1024 * 6144 + n0 + cg4;
            f32x4 a[9];
#pragma unroll
            for (int r = 0; r < 9; ++r) a[r] = (f32x4){0.f, 0.f, 0.f, 0.f};
#pragma unroll 1
            for (int k0 = ks * 64; k0 < ks * 64 + 64; k0 += 16) {
                f32x4 wv[16];
#pragma unroll
                for (int j = 0; j < 16; ++j) wv[j] = *(const f32x4*)(w + (size_t)(k0 + j) * 6144);
#pragma unroll
                for (int j = 0; j < 16; ++j)
#pragma unroll
                    for (int r = 0; r < 9; ++r) a[r] += wv[j] * sc[r * 1024 + k0 + j];
            }
#pragma unroll
            for (int r = 0; r < 9; ++r) *(LAS f32x4*)(red + (ks * 9 + r) * 128 + cg4) = a[r];
            __syncthreads();
            for (int i = tid; i < 9 * 128; i += 512) { const int r = i >> 7, c = i & 127; float v = p.in[5][l * 6144 + n0 + c];
#pragma unroll
                for (int q = 0; q < 16; ++q) v += red[(q * 9 + r) * 128 + c];
                ((float*)(ws + WS_MOD))[((size_t)l * 9 + r) * 6144 + n0 + c] = v; }
            __syncthreads();
        }
    }
    const int gt = bid * 512 + tid, gs = nb * 512;
    for (int i = gt; i < 2 * 73728; i += gs) {
        const int o = i / 73728, r = i % 73728; bf16_t* wb = (bf16_t*)(ws + WS_WU) + (size_t)o * 1792 * 640; u32x4 zz = {0u, 0u, 0u, 0u};
        if (r < 768 * 32) *(u32x4*)(wb + (size_t)(r >> 5) * 640 + 384 + (r & 31) * 8) = zz;
        else { const int r2 = r - 768 * 32; *(u32x4*)(wb + (size_t)(768 + r2 / 48) * 640 + (r2 % 48) * 8) = zz; } }
    for (int i = gt; i < 1024; i += gs) {
        const int pos = i >> 4, f = i & 15; const double inv = dexp(-(double)f * (9.210340371976182736 / 16.0)); double sn, cs; dsincos((double)pos * inv, sn, cs);
        ((float*)(ws + WS_ROPE))[i * 2] = (float)cs; ((float*)(ws + WS_ROPE))[i * 2 + 1] = (float)sn; }
    for (int i = gt; i < 1024; i += gs) {
        const int e = i >> 9, j = i & 511; float v = 0.f;
        if (e == 1) v = 1.0f / (1.0f + expf(p.in[22][j] - p.in[22][512 + j]));
        ((float*)(ws + WS_LB))[i] = v; }
    for (int i = gt; i < 2 * 2 * 32 * 64; i += gs) {
        const int pp = i & 63, idx = i >> 6;
        const double lr = (double)fminf(p.in[12][i], -1e-4f), li = (double)p.in[13][i], step = dexp((double)p.in[14][idx]);
        const double mag = dexp(lr * step); double sn, cs; dsincos(li * step, sn, cs);
        const double ar = mag * cs, ai = mag * sn, iden = 1.0 / (lr * lr + li * li);
        const double cr = ((ar - 1.0) * lr + ai * li) * iden, ci = (ai * lr - (ar - 1.0) * li) * iden;
        double pr = ar, pi = ai;
#pragma unroll
        for (int s = 0; s < 5; ++s) { const double nr = pr * pr - pi * pi, ni = 2.0 * pr * pi; pr = nr; pi = ni; }
        float4 o; o.x = (float)ar; o.y = (float)ai; o.z = (float)pr; o.w = (float)pi; ((float4*)(ws + WS_S5A))[i] = o;
        bf16_t* bbr = (bf16_t*)(ws + WS_S5BB) + ((size_t)idx * 2 + 0) * 1024 + pp * 16; bf16_t* bbi = bbr + 1024;
        const float* bre = p.in[15] + (size_t)i * 16; const float* bim = p.in[16] + (size_t)i * 16;
#pragma unroll
        for (int c = 0; c < 16; ++c) { const double br = bre[c], bi = bim[c]; bbr[c] = f2bf((float)(cr * br - ci * bi)); bbi[c] = f2bf((float)(cr * bi + ci * br)); } }
    for (int i = gt; i < 2 * 2 * 32 * 4 * 16 * 32; i += gs) {
        const int slot = i & 31, c = (i >> 5) & 15, kk = (i >> 9) & 3, idx = i >> 11;
        const int quad = slot >> 3, j8 = slot & 7, st = 16 * (2 * (kk & 1) + (j8 >> 2)) + quad * 4 + (j8 & 3);
        const float v = kk < 2 ? p.in[17][((size_t)idx * 16 + c) * 64 + st] : -p.in[18][((size_t)idx * 16 + c) * 64 + st];
        ((bf16_t*)(ws + WS_S5CC))[i] = f2bf(v); }
}

__device__ __forceinline__ void prep2_phase(const Ctx& p, LAS unsigned char* lds) {
    const int tid = mk_tid(), lane = tid & 63, w = tid >> 6, nb = gridDim.x, bid = blockIdx.x;
    unsigned char* ws = p.ws;
    LAS float* sh = (LAS float*)lds;
    {
        const int job = bid & 7, l = job >> 1, kind = job & 1;
        const int grp = bid >> 3, ngrp = (nb + 7 - job) >> 3;
        const float* mod = (const float*)(ws + WS_MOD) + (size_t)l * 9 * 6144 + (kind ? 3 : 0) * 1024;
        for (int i = tid; i < 9 * 1024; i += 512) sh[i] = mod[(i >> 10) * 6144 + (i & 1023)];
        __syncthreads();
        const bf16_t* W; int nrows;
        if (kind) { W = (const bf16_t*)(ws + WS_WFI) + (size_t)l * 5632 * 1024; nrows = 5632; }
        else if (l & 1) { W = (const bf16_t*)(ws + WS_WCD) + (size_t)(l >> 1) * 2304 * 1024; nrows = 2304; }
        else { W = (const bf16_t*)(ws + WS_WAB) + (size_t)(l >> 1) * 3072 * 1024; nrows = 3072; }
        float* bo = (float*)(ws + WS_BIAS) + (size_t)l * 9 * 8704 + (kind ? 3072 : 0);
        const int rstride = ngrp * 8;
        for (int rowq = grp * 8 + w; rowq < nrows; rowq += rstride * 4) {
          u32x2 wq[4][4];
#pragma unroll
          for (int q4 = 0; q4 < 4; ++q4) { const int rr = rowq + q4 * rstride < nrows ? rowq + q4 * rstride : rowq;
#pragma unroll
              for (int q = 0; q < 4; ++q) wq[q4][q] = *(const u32x2*)(W + (size_t)rr * 1024 + 256 * q + lane * 4); }
#pragma unroll
          for (int q4 = 0; q4 < 4; ++q4) { const int row = rowq + q4 * rstride; if (row >= nrows) break;
            float wv[16];
#pragma unroll
            for (int q = 0; q < 4; ++q) { wv[4 * q] = bflo(wq[q4][q].x); wv[4 * q + 1] = bfhi(wq[q4][q].x); wv[4 * q + 2] = bflo(wq[q4][q].y); wv[4 * q + 3] = bfhi(wq[q4][q].y); }
#pragma unroll
            for (int r = 0; r < 9; ++r) { float a = 0.f;
#pragma unroll
                for (int q = 0; q < 4; ++q) { const f32x4 s4 = *(const LAS f32x4*)(sh + r * 1024 + 256 * q + lane * 4); a += s4[0] * wv[4 * q] + s4[1] * wv[4 * q + 1] + s4[2] * wv[4 * q + 2] + s4[3] * wv[4 * q + 3]; }
                a = wsum(a); if (lane == 0) bo[r * 8704 + row] = a; }
          }
        }
    }
    { const int wg = bid * 8 + w, nw = nb * 8; float* H = (float*)(ws + WS_H); bf16_t* A = (bf16_t*)(ws + WS_A); float* ss = (float*)(ws + WS_SS);
      const float* gw = p.in[6]; const float* mod0 = (const float*)(ws + WS_MOD);
      float4 g[4];
#pragma unroll
      for (int i = 0; i < 4; ++i) g[i] = *(const float4*)(gw + 4 * (lane + 64 * i));
      for (int row = wg; row < MT; row += nw) {
          const float4* src = row < ML ? (const float4*)(p.in[0] + (size_t)row * 1024) : (const float4*)(p.in[2] + (size_t)(row - ML) * 1024);
          float4* dst = (float4*)(H + (size_t)row * 1024); const int r = row < ML ? (row >> 11) : 8; const float* sc = mod0 + r * 6144 + 1024;
          float4 h[4], c4[4]; float sq = 0.f;
#pragma unroll
          for (int i = 0; i < 4; ++i) { h[i] = src[lane + 64 * i]; c4[i] = *(const float4*)(sc + 4 * (lane + 64 * i)); }
#pragma unroll
          for (int i = 0; i < 4; ++i) sq += h[i].x * h[i].x + h[i].y * h[i].y + h[i].z * h[i].z + h[i].w * h[i].w;
          sq = wsum(sq); if (lane == 0) ss[row] = sq;
#pragma unroll
          for (int i = 0; i < 4; ++i) { const int c = 4 * (lane + 64 * i); dst[lane + 64 * i] = h[i];
              u32x2 wv2; wv2.x = pk2(h[i].x * g[i].x * (1.f + c4[i].x), h[i].y * g[i].y * (1.f + c4[i].y)); wv2.y = pk2(h[i].z * g[i].z * (1.f + c4[i].z), h[i].w * g[i].w * (1.f + c4[i].w));
              *(u32x2*)(A + (size_t)row * 1024 + c) = wv2; }
      } }
}

template <int pass> __device__ __forceinline__ void s5_unit(const Ctx& p, int e, int g, int sg, LAS unsigned char* lds) {
    const int tid = mk_tid(), lane = tid & 63, n = lane & 15, quad = lane >> 4;
    LAS bf16x8* ops = (LAS bf16x8*)lds + tid;
    const int seq = sg * 16 + n, b = seq / 72, tc = seq % 72;
    const int rowbase = tc < 8 ? ML + b * 256 + tc * 32 : b * 2048 + (tc - 8) * 32;
    const bf16_t* P = (const bf16_t*)(p.ws + WS_P); bf16_t* Z = (bf16_t*)(p.ws + WS_Z); float* E = p.out;
    const f32x4 dsk = *(const f32x4*)(p.in[19] + e * 512 + g * 16 + quad * 4);
    const f32x4 z4 = {0.f, 0.f, 0.f, 0.f};
    const int srcl = n + 16 * (quad >> 1);
#pragma unroll 1
    for (int dir = 0; dir < 2; ++dir) {
        const int idx = (e * 2 + dir) * 32 + g;
        const float4* A4 = (const float4*)(p.ws + WS_S5A) + (size_t)idx * 64;
        const bf16_t* BB = (const bf16_t*)(p.ws + WS_S5BB) + (size_t)idx * 2048;
        const bf16_t* CC = (const bf16_t*)(p.ws + WS_S5CC) + (size_t)idx * 2048;
        float ar[4][4], ai[4][4], hr[4][4], hi[4][4];
#pragma unroll
        for (int pt = 0; pt < 4; ++pt) {
            ops[pt * 512] = quad < 2 ? *(const bf16x8*)(BB + (16 * pt + n) * 16 + quad * 8) : zero8();
            ops[(4 + pt) * 512] = quad < 2 ? *(const bf16x8*)(BB + 1024 + (16 * pt + n) * 16 + quad * 8) : zero8();
            ops[(8 + pt) * 512] = *(const bf16x8*)(CC + (pt * 16 + n) * 32 + quad * 8); }
        const int pc = dir == 0 ? tc : (tc < 8 ? 7 - tc : 79 - tc);
        float* Eb = E + ((size_t)((b * 2 + dir) * 72 + pc) * 32 + g) * 128;
#pragma unroll
        for (int pt = 0; pt < 4; ++pt) {
            float4 e0 = {0.f, 0.f, 0.f, 0.f}, e1 = {0.f, 0.f, 0.f, 0.f};
            if (pass == 2) { const float4* ep = (const float4*)(Eb + (16 * pt + quad * 4) * 2); e0 = ep[0]; e1 = ep[1]; }
            hr[pt][0] = e0.x; hi[pt][0] = e0.y; hr[pt][1] = e0.z; hi[pt][1] = e0.w; hr[pt][2] = e1.x; hi[pt][2] = e1.y; hr[pt][3] = e1.z; hi[pt][3] = e1.w;
#pragma unroll
            for (int j = 0; j < 4; ++j) { const float4 a = A4[16 * pt + quad * 4 + j]; ar[pt][j] = a.x; ai[pt][j] = a.y; } }
        const char* Pg = (const char*)(P + g * 16); char* Zg = (char*)(Z + g * 16);
        const unsigned uoff0 = (unsigned)(rowbase * 3072 + (quad & 1) * 8) * 2u, zoff0 = (unsigned)(rowbase * 512 + quad * 4) * 2u;
        const char* Zr = dir ? (const char*)Zg : Pg;
        bf16x8 ub[8]; u32x2 yfb[8];
#pragma unroll
        for (int j = 0; j < 8; ++j) { const int tt = dir ? 31 - j : j; ub[j] = *(const bf16x8*)(Pg + (uoff0 + (unsigned)tt * 6144u));
            yfb[j] = (u32x2){0u, 0u}; if (pass == 2) yfb[j] = *(const u32x2*)(Zr + (zoff0 + (unsigned)tt * 1024u)); }
#pragma unroll 1
        for (int t8 = 0; t8 < 4; ++t8) {
#pragma unroll
            for (int j = 0; j < 8; ++j) {
                const int t = t8 * 8 + j, tt = dir ? 31 - t : t;
                const bf16x8 uc = ub[j]; const u32x2 yf = yfb[j];
                { const int t2 = t + 8 < 31 ? t + 8 : 31; const int tt2 = dir ? 31 - t2 : t2; ub[j] = *(const bf16x8*)(Pg + (uoff0 + (unsigned)tt2 * 6144u));
                    if (pass == 2) yfb[j] = *(const u32x2*)(Zr + (zoff0 + (unsigned)tt2 * 1024u)); }
#pragma unroll
                for (int pt = 0; pt < 4; ++pt) { const bf16x8 oa = ops[pt * 512], ob = ops[(4 + pt) * 512]; const f32x4 br = MFMA(oa, uc, z4), bi = MFMA(ob, uc, z4);
#pragma unroll
                    for (int jj = 0; jj < 4; ++jj) { const float nr = ar[pt][jj] * hr[pt][jj] - ai[pt][jj] * hi[pt][jj] + br[jj], ni = ar[pt][jj] * hi[pt][jj] + ai[pt][jj] * hr[pt][jj] + bi[jj]; hr[pt][jj] = nr; hi[pt][jj] = ni; }
                    if (pt & 1) asm volatile("" ::: "memory"); }
                if (pass == 2) {
                    f32x4 y = z4, y2 = z4;
#pragma unroll
                    for (int kk = 0; kk < 2; ++kk) {
                        const bf16x8 br = mk8(pk2(hr[2 * kk][0], hr[2 * kk][1]), pk2(hr[2 * kk][2], hr[2 * kk][3]), pk2(hr[2 * kk + 1][0], hr[2 * kk + 1][1]), pk2(hr[2 * kk + 1][2], hr[2 * kk + 1][3]));
                        const bf16x8 bi = mk8(pk2(hi[2 * kk][0], hi[2 * kk][1]), pk2(hi[2 * kk][2], hi[2 * kk][3]), pk2(hi[2 * kk + 1][0], hi[2 * kk + 1][1]), pk2(hi[2 * kk + 1][2], hi[2 * kk + 1][3]));
                        y = MFMA(ops[(8 + kk) * 512], br, y); y2 = MFMA(ops[(10 + kk) * 512], bi, y2); }
                    y += y2;
                    char* zp = Zg + (zoff0 + (unsigned)tt * 1024u);
                    if (dir == 0) { u32x2 w; w.x = pk2(y[0], y[1]); w.y = pk2(y[2], y[3]); *(u32x2*)zp = w; }
                    else { const u32x4 uw = __builtin_bit_cast(u32x4, uc);
                        const unsigned a0 = __shfl((int)uw.x, srcl), a1 = __shfl((int)uw.y, srcl), a2 = __shfl((int)uw.z, srcl), a3 = __shfl((int)uw.w, srcl);
                        const unsigned ux = (quad & 1) ? a2 : a0, uy = (quad & 1) ? a3 : a1;
                        float v[4] = {bflo(yf.x) + y[0] + dsk[0] * bflo(ux), bfhi(yf.x) + y[1] + dsk[1] * bfhi(ux), bflo(yf.y) + y[2] + dsk[2] * bflo(uy), bfhi(yf.y) + y[3] + dsk[3] * bfhi(uy)};
#pragma unroll
                        for (int jj = 0; jj < 4; ++jj) { const float x = v[jj], uarg = 1.5957691216f * (x + 0.044715f * x * x * x); v[jj] = x * rcpf_(1.0f + __expf(-uarg)); }
                        u32x2 w; w.x = pk2(v[0], v[1]); w.y = pk2(v[2], v[3]); *(u32x2*)zp = w; }
                }
                asm volatile("" ::: "memory");
            }
        }
        if (pass == 1) {
#pragma unroll
            for (int pt = 0; pt < 4; ++pt) { float4* ep = (float4*)(Eb + (16 * pt + quad * 4) * 2);
                float4 e0, e1; e0.x = hr[pt][0]; e0.y = hi[pt][0]; e0.z = hr[pt][1]; e0.w = hi[pt][1]; e1.x = hr[pt][2]; e1.y = hi[pt][2]; e1.z = hr[pt][3]; e1.w = hi[pt][3]; ep[0] = e0; ep[1] = e1; }
        }
    }
}
__device__ __forceinline__ void s5_carry(const Ctx& p, int e) {
    const int gt = blockIdx.x * 512 + mk_tid(), gs = gridDim.x * 512;
    float2* E = (float2*)p.out;
    for (int i = gt; i < 32768; i += gs) {
        const int pp = i & 63, g = (i >> 6) & 31, dir = (i >> 11) & 1, b = i >> 12;
        const float4 a = ((const float4*)(p.ws + WS_S5A))[(size_t)((e * 2 + dir) * 32 + g) * 64 + pp];
        float2* base = E + ((size_t)((b * 2 + dir) * 72) * 32 + g) * 64 + pp;
        float hr = 0.f, hi = 0.f;
#pragma unroll 1
        for (int q0 = 0; q0 < 72; q0 += 6) {
            float2 ev[6];
#pragma unroll
            for (int j = 0; j < 6; ++j) ev[j] = base[(size_t)(q0 + j) * 2048];
#pragma unroll
            for (int j = 0; j < 6; ++j) { float2 o; o.x = hr; o.y = hi; base[(size_t)(q0 + j) * 2048] = o; const float nr = a.z * hr - a.w * hi + ev[j].x, ni = a.z * hi + a.w * hr + ev[j].y; hr = nr; hi = ni; }
        }
    }
}

constexpr int HG_CUM = 0, HG_QT = 33792, HG_KT = HG_QT + 17408, HG_QI = HG_KT + 17408, HG_KET = HG_QI + 17408, HG_VT = HG_KET + 18432, HG_SC = HG_VT + 18432, HG_TOT = HG_SC + 9216, HG_C63 = HG_TOT + 2048, HG_END = HG_C63 + 512;
static_assert(HG_END <= LDS_BYTES, "hgrn lds");
__device__ __forceinline__ void hgrn_chain(const Ctx& p, int e, int chain, LAS unsigned char* lds) {
    const int tid = mk_tid(), w = tid >> 6, lane = tid & 63, n = lane & 15, quad = lane >> 4;
    const int b = chain >> 3, dir = (chain >> 2) & 1, head = chain & 3;
    const bf16_t* P = (const bf16_t*)(p.ws + WS_P);
    bf16_t* O = (bf16_t*)(p.ws + (dir ? WS_OB : WS_OF));
    LAS float* cum = (LAS float*)(lds + HG_CUM);
    LAS bf16_t* qt = (LAS bf16_t*)(lds + HG_QT);
    LAS bf16_t* kt = (LAS bf16_t*)(lds + HG_KT);
    LAS bf16_t* qi = (LAS bf16_t*)(lds + HG_QI);
    LAS bf16_t* keT = (LAS bf16_t*)(lds + HG_KET);
    LAS bf16_t* vT = (LAS bf16_t*)(lds + HG_VT);
    LAS bf16_t* sc = (LAS bf16_t*)(lds + HG_SC);
    LAS float* tot = (LAS float*)(lds + HG_TOT);
    LAS float* c63s = (LAS float*)(lds + HG_C63);
    const int t = lane, kc = w * 16;
    const int sk = tid & 127, sseg = tid >> 7;
    const float* lbp = (const float*)(p.ws + WS_LB) + e * 512 + head * 128 + kc;
    f32x4 S[8];
#pragma unroll
    for (int i = 0; i < 8; ++i) S[i] = (f32x4){0.f, 0.f, 0.f, 0.f};
    const int qcol = 512 + head * 128 + kc, fcol = (dir ? 1536 : 1024) + head * 128 + kc, vcol = 2048 + head * 128 + kc;
    u32x4 rq0, rq1, rf0, rf1, rv0, rv1;
    { const int rowb = dir == 0 ? ML + b * 256 : ML + b * 256 + 192; const bf16_t* pr = P + (size_t)(rowb + (dir ? 63 - t : t)) * 3072;
      rq0 = *(const u32x4*)(pr + qcol); rq1 = *(const u32x4*)(pr + qcol + 8); rf0 = *(const u32x4*)(pr + fcol); rf1 = *(const u32x4*)(pr + fcol + 8); rv0 = *(const u32x4*)(pr + vcol); rv1 = *(const u32x4*)(pr + vcol + 8); }
#pragma unroll 1
    for (int pc = 0; pc < 36; ++pc) {
        const int tc = dir == 0 ? pc : (pc < 4 ? 3 - pc : 39 - pc);
        const int rowb = tc < 4 ? ML + b * 256 + tc * 64 : b * 2048 + (tc - 4) * 64;
        float qv[16], kv[16];
        {
            const unsigned rq[8] = {rq0.x, rq0.y, rq0.z, rq0.w, rq1.x, rq1.y, rq1.z, rq1.w}, rf[8] = {rf0.x, rf0.y, rf0.z, rf0.w, rf1.x, rf1.y, rf1.z, rf1.w},
                           rv[8] = {rv0.x, rv0.y, rv0.z, rv0.w, rv1.x, rv1.y, rv1.z, rv1.w};
            float lf[16], lb[16];
#pragma unroll
            for (int i = 0; i < 4; ++i) { const f32x4 t4 = *(const f32x4*)(lbp + 4 * i); lb[4 * i] = t4[0]; lb[4 * i + 1] = t4[1]; lb[4 * i + 2] = t4[2]; lb[4 * i + 3] = t4[3]; }
#pragma unroll
            for (int i = 0; i < 16; ++i) {
                const float x = (i & 1) ? bfhi(rq[i >> 1]) : bflo(rq[i >> 1]); float fl = (i & 1) ? bfhi(rf[i >> 1]) : bflo(rf[i >> 1]);
                fl = fminf(fmaxf(fl, -30.f), 30.f);
                qv[i] = siluf(x);
                const float en = __expf(-fl), sg = rcpf_(1.0f + en);
                kv[i] = (1.f - lb[i]) * en * sg;
                lf[i] = __logf(lb[i] + (1.f - lb[i]) * sg);
                vT[(kc + i) * 72 + t] = (bf16_t)((i & 1) ? (rv[i >> 1] >> 16) : (rv[i >> 1] & 0xffffu));
            }
#pragma unroll
            for (int i = 0; i < 4; ++i) *(LAS f32x4*)(cum + t * 132 + kc + 4 * i) = (f32x4){lf[4 * i], lf[4 * i + 1], lf[4 * i + 2], lf[4 * i + 3]};
        }
        if (pc < 35) { const int pc2 = pc + 1; const int tc2 = dir == 0 ? pc2 : (pc2 < 4 ? 3 - pc2 : 39 - pc2); const int rowb2 = tc2 < 4 ? ML + b * 256 + tc2 * 64 : b * 2048 + (tc2 - 4) * 64;
            const bf16_t* pr = P + (size_t)(rowb2 + (dir ? 63 - t : t)) * 3072;
            rq0 = *(const u32x4*)(pr + qcol); rq1 = *(const u32x4*)(pr + qcol + 8); rf0 = *(const u32x4*)(pr + fcol); rf1 = *(const u32x4*)(pr + fcol + 8); rv0 = *(const u32x4*)(pr + vcol); rv1 = *(const u32x4*)(pr + vcol + 8); }
        __syncthreads();
        {
            float c[16];
#pragma unroll
            for (int i = 0; i < 16; ++i) c[i] = cum[(16 * sseg + i) * 132 + sk];
#pragma unroll
            for (int i = 1; i < 16; ++i) c[i] += c[i - 1];
#pragma unroll
            for (int i = 0; i < 16; ++i) cum[(16 * sseg + i) * 132 + sk] = c[i];
            tot[sseg * 128 + sk] = c[15];
        }
        __syncthreads();
        {
            const int seg = t >> 4;
            unsigned wq[8], wk[8], wi[8];
#pragma unroll
            for (int i4 = 0; i4 < 4; ++i4) {
                const f32x4 o0 = *(const LAS f32x4*)(tot + kc + 4 * i4), o1 = *(const LAS f32x4*)(tot + 128 + kc + 4 * i4), o2 = *(const LAS f32x4*)(tot + 256 + kc + 4 * i4);
                const f32x4 cl = *(const LAS f32x4*)(cum + t * 132 + kc + 4 * i4), l31 = *(const LAS f32x4*)(cum + 31 * 132 + kc + 4 * i4), l63 = *(const LAS f32x4*)(cum + 63 * 132 + kc + 4 * i4);
                float a[4], bq[4], cq[4];
#pragma unroll
                for (int j = 0; j < 4; ++j) { const int ii = 4 * i4 + j;
                    const float off = (seg > 0 ? o0[j] : 0.f) + (seg > 1 ? o1[j] : 0.f) + (seg > 2 ? o2[j] : 0.f);
                    const float ct = cl[j] + off, c31 = l31[j] + o0[j], c63 = l63[j] + o0[j] + o1[j] + o2[j];
                    a[j] = qv[ii] * __expf(fminf(ct - c31, 80.f)); bq[j] = kv[ii] * __expf(fminf(c31 - ct, 80.f)); cq[j] = qv[ii] * __expf(ct);
                    keT[(kc + ii) * 72 + t] = f2bf(kv[ii] * __expf(c63 - ct));
                    if (t == 63) c63s[kc + ii] = c63; }
                wq[2 * i4] = pk2(a[0], a[1]); wq[2 * i4 + 1] = pk2(a[2], a[3]); wk[2 * i4] = pk2(bq[0], bq[1]); wk[2 * i4 + 1] = pk2(bq[2], bq[3]); wi[2 * i4] = pk2(cq[0], cq[1]); wi[2 * i4 + 1] = pk2(cq[2], cq[3]);
            }
            *(LAS u32x4*)(qt + t * 136 + kc) = (u32x4){wq[0], wq[1], wq[2], wq[3]}; *(LAS u32x4*)(qt + t * 136 + kc + 8) = (u32x4){wq[4], wq[5], wq[6], wq[7]};
            *(LAS u32x4*)(kt + t * 136 + kc) = (u32x4){wk[0], wk[1], wk[2], wk[3]}; *(LAS u32x4*)(kt + t * 136 + kc + 8) = (u32x4){wk[4], wk[5], wk[6], wk[7]};
            *(LAS u32x4*)(qi + t * 136 + kc) = (u32x4){wi[0], wi[1], wi[2], wi[3]}; *(LAS u32x4*)(qi + t * 136 + kc + 8) = (u32x4){wi[4], wi[5], wi[6], wi[7]};
        }
        __syncthreads();
        {
            const int tt = w >> 1;
#pragma unroll
            for (int si = 0; si < 2; ++si) { const int st = (w & 1) * 2 + si; f32x4 acc = {0.f, 0.f, 0.f, 0.f};
                if (st <= tt) {
#pragma unroll
                    for (int kb = 0; kb < 4; ++kb) { const bf16x8 a = *(const LAS bf16x8*)(qt + (16 * tt + n) * 136 + 32 * kb + quad * 8), bb = *(const LAS bf16x8*)(kt + (16 * st + n) * 136 + 32 * kb + quad * 8);
                        acc = MFMA(a, bb, acc); } }
#pragma unroll
                for (int j = 0; j < 4; ++j) { const int ti = 16 * tt + quad * 4 + j, sidx = 16 * st + n; sc[ti * 72 + sidx] = (st <= tt && sidx <= ti) ? f2bf(acc[j]) : (bf16_t)0; } }
        }
        __syncthreads();
        {
            bf16x8 Sb[4], vB[2];
#pragma unroll
            for (int kb = 0; kb < 4; ++kb) Sb[kb] = mk8(pk2(S[2 * kb][0], S[2 * kb][1]), pk2(S[2 * kb][2], S[2 * kb][3]), pk2(S[2 * kb + 1][0], S[2 * kb + 1][1]), pk2(S[2 * kb + 1][2], S[2 * kb + 1][3]));
#pragma unroll
            for (int sb = 0; sb < 2; ++sb) vB[sb] = *(const LAS bf16x8*)(vT + (16 * w + n) * 72 + 32 * sb + quad * 8);
#pragma unroll
            for (int tt = 0; tt < 4; ++tt) { f32x4 acc = {0.f, 0.f, 0.f, 0.f};
#pragma unroll
                for (int kb = 0; kb < 4; ++kb) { const bf16x4 a0 = *(const LAS bf16x4*)(qi + (16 * tt + n) * 136 + 32 * kb + quad * 4), a1 = *(const LAS bf16x4*)(qi + (16 * tt + n) * 136 + 32 * kb + 16 + quad * 4);
                    acc = MFMA(__builtin_shufflevector(a0, a1, 0, 1, 2, 3, 4, 5, 6, 7), Sb[kb], acc); }
#pragma unroll
                for (int sb = 0; sb < 2; ++sb) if (32 * sb <= 16 * tt + 15) { const bf16x8 a = *(const LAS bf16x8*)(sc + (16 * tt + n) * 72 + 32 * sb + quad * 8); acc = MFMA(a, vB[sb], acc); }
#pragma unroll
                for (int j = 0; j < 4; ++j) { const int ti = 16 * tt + quad * 4 + j; O[(size_t)(rowb + (dir ? 63 - ti : ti)) * 512 + head * 128 + 16 * w + n] = f2bf(acc[j]); } }
#pragma unroll
            for (int k8 = 0; k8 < 8; ++k8) { const f32x4 c4 = *(const LAS f32x4*)(c63s + 16 * k8 + quad * 4);
                f32x4 s = S[k8]; s[0] *= __expf(c4[0]); s[1] *= __expf(c4[1]); s[2] *= __expf(c4[2]); s[3] *= __expf(c4[3]);
#pragma unroll
                for (int sb = 0; sb < 2; ++sb) { const bf16x8 a = *(const LAS bf16x8*)(keT + (16 * k8 + n) * 72 + 32 * sb + quad * 8); s = MFMA(a, vB[sb], s); }
                S[k8] = s; }
        }
        __syncthreads();
    }
}

__device__ __forceinline__ void hg_pre_unit(const Ctx& p, int e, int u, LAS unsigned char* lds, bool dry) {
    const int tid = mk_tid(), w = __builtin_amdgcn_readfirstlane(tid >> 6), lane = tid & 63, n = lane & 15, quad = lane >> 4;
    const int head = u & 3, ch = u >> 2, b = ch / 36, tc = ch % 36;
    const int rowb = tc < 4 ? ML + b * 256 + tc * 64 : b * 2048 + (tc - 4) * 64;
    bf16_t* P = (bf16_t*)(p.ws + WS_P);
    LAS float* cum = (LAS float*)(lds + HG_CUM);
    LAS bf16_t* qt = (LAS bf16_t*)(lds + HG_QT); LAS bf16_t* kt = (LAS bf16_t*)(lds + HG_KT); LAS bf16_t* qi = (LAS bf16_t*)(lds + HG_QI);
    LAS bf16_t* keT = (LAS bf16_t*)(lds + HG_KET); LAS bf16_t* vT = (LAS bf16_t*)(lds + HG_VT); LAS bf16_t* sc = (LAS bf16_t*)(lds + HG_SC);
    LAS float* tot = (LAS float*)(lds + HG_TOT);
    const int t = lane, kc = w * 16;
    const int sk = tid & 127, sseg = tid >> 7;
    const float* lbp = (const float*)(p.ws + WS_LB) + e * 512 + head * 128 + kc;
    u32x4 rq0, rq1, rfa0, rfa1, rfb0, rfb1, rv0, rv1;
    { const bf16_t* pr = P + (size_t)(rowb + t) * 3072 + head * 128 + kc;
      rq0 = *(const u32x4*)(pr + 512); rq1 = *(const u32x4*)(pr + 520); rfa0 = *(const u32x4*)(pr + 1024); rfa1 = *(const u32x4*)(pr + 1032);
      rfb0 = *(const u32x4*)(pr + 1536); rfb1 = *(const u32x4*)(pr + 1544); rv0 = *(const u32x4*)(pr + 2048); rv1 = *(const u32x4*)(pr + 2056); }
    float lb[16];
#pragma unroll
    for (int i = 0; i < 4; ++i) { const f32x4 t4 = *(const f32x4*)(lbp + 4 * i); lb[4 * i] = t4[0]; lb[4 * i + 1] = t4[1]; lb[4 * i + 2] = t4[2]; lb[4 * i + 3] = t4[3]; }
    float qv[16];
    { const unsigned rq[8] = {rq0.x, rq0.y, rq0.z, rq0.w, rq1.x, rq1.y, rq1.z, rq1.w};
#pragma unroll
      for (int i = 0; i < 16; ++i) qv[i] = siluf((i & 1) ? bfhi(rq[i >> 1]) : bflo(rq[i >> 1])); }
#pragma unroll 1
    for (int dir = 0; dir < 2; ++dir) {
        const int s = dir ? 63 - t : t;
        bf16_t* O = (bf16_t*)(p.ws + (dir ? WS_OB : WS_OF));
        float kv[16];
        {
            const unsigned rv[8] = {rv0.x, rv0.y, rv0.z, rv0.w, rv1.x, rv1.y, rv1.z, rv1.w};
            const u32x4 f0 = dir ? rfb0 : rfa0, f1 = dir ? rfb1 : rfa1;
            const unsigned rf[8] = {f0.x, f0.y, f0.z, f0.w, f1.x, f1.y, f1.z, f1.w};
            float lf[16];
#pragma unroll
            for (int i = 0; i < 16; ++i) {
                float fl = (i & 1) ? bfhi(rf[i >> 1]) : bflo(rf[i >> 1]);
                fl = fminf(fmaxf(fl, -30.f), 30.f);
                const float en = __expf(-fl), sg = rcpf_(1.0f + en);
                kv[i] = (1.f - lb[i]) * en * sg;
                lf[i] = __logf(lb[i] + (1.f - lb[i]) * sg);
                vT[(kc + i) * 72 + s] = (bf16_t)((i & 1) ? (rv[i >> 1] >> 16) : (rv[i >> 1] & 0xffffu));
            }
#pragma unroll
            for (int i = 0; i < 4; ++i) *(LAS f32x4*)(cum + s * 132 + kc + 4 * i) = (f32x4){lf[4 * i], lf[4 * i + 1], lf[4 * i + 2], lf[4 * i + 3]};
        }
        __syncthreads();
        {
            float c[16];
#pragma unroll
            for (int i = 0; i < 16; ++i) c[i] = cum[(16 * sseg + i) * 132 + sk];
#pragma unroll
            for (int i = 1; i < 16; ++i) c[i] += c[i - 1];
#pragma unroll
            for (int i = 0; i < 16; ++i) cum[(16 * sseg + i) * 132 + sk] = c[i];
            tot[sseg * 128 + sk] = c[15];
        }
        __syncthreads();
        {
            const int seg = s >> 4;
            unsigned wq[8], wk[8], wi[8];
#pragma unroll
            for (int i4 = 0; i4 < 4; ++i4) {
                const f32x4 o0 = *(const LAS f32x4*)(tot + kc + 4 * i4), o1 = *(const LAS f32x4*)(tot + 128 + kc + 4 * i4), o2 = *(const LAS f32x4*)(tot + 256 + kc + 4 * i4);
                const f32x4 cl = *(const LAS f32x4*)(cum + s * 132 + kc + 4 * i4), l31 = *(const LAS f32x4*)(cum + 31 * 132 + kc + 4 * i4), l63 = *(const LAS f32x4*)(cum + 63 * 132 + kc + 4 * i4);
                float a[4], bq[4], cq[4], e63[4];
#pragma unroll
                for (int j = 0; j < 4; ++j) { const int ii = 4 * i4 + j;
                    const float off = (seg > 0 ? o0[j] : 0.f) + (seg > 1 ? o1[j] : 0.f) + (seg > 2 ? o2[j] : 0.f);
                    const float ct = cl[j] + off, c31 = l31[j] + o0[j], c63 = l63[j] + o0[j] + o1[j] + o2[j];
                    a[j] = qv[ii] * __expf(fminf(ct - c31, 80.f)); bq[j] = kv[ii] * __expf(fminf(c31 - ct, 80.f)); cq[j] = qv[ii] * __expf(ct);
                    keT[(kc + ii) * 72 + s] = f2bf(kv[ii] * __expf(c63 - ct)); e63[j] = __expf(c63); }
                if (s == 63 && !dry) { u32x2 ev; ev.x = pk2(e63[0], e63[1]); ev.y = pk2(e63[2], e63[3]);
                    *(u32x2*)((bf16_t*)(p.ws + WS_E63) + ((size_t)(dir * 288 + ch) * 4 + head) * 128 + kc + 4 * i4) = ev; }
                wq[2 * i4] = pk2(a[0], a[1]); wq[2 * i4 + 1] = pk2(a[2], a[3]); wk[2 * i4] = pk2(bq[0], bq[1]); wk[2 * i4 + 1] = pk2(bq[2], bq[3]); wi[2 * i4] = pk2(cq[0], cq[1]); wi[2 * i4 + 1] = pk2(cq[2], cq[3]);
            }
            *(LAS u32x4*)(qt + s * 136 + kc) = (u32x4){wq[0], wq[1], wq[2], wq[3]}; *(LAS u32x4*)(qt + s * 136 + kc + 8) = (u32x4){wq[4], wq[5], wq[6], wq[7]};
            *(LAS u32x4*)(kt + s * 136 + kc) = (u32x4){wk[0], wk[1], wk[2], wk[3]}; *(LAS u32x4*)(kt + s * 136 + kc + 8) = (u32x4){wk[4], wk[5], wk[6], wk[7]};
            *(LAS u32x4*)(qi + s * 136 + kc) = (u32x4){wi[0], wi[1], wi[2], wi[3]}; *(LAS u32x4*)(qi + s * 136 + kc + 8) = (u32x4){wi[4], wi[5], wi[6], wi[7]};
        }
        __syncthreads();
        {
            const int tt = w >> 1;
#pragma unroll
            for (int si = 0; si < 2; ++si) { const int st = (w & 1) * 2 + si; f32x4 acc = {0.f, 0.f, 0.f, 0.f};
                if (st <= tt) {
#pragma unroll
                    for (int kb = 0; kb < 4; ++kb) { const bf16x8 a = *(const LAS bf16x8*)(qt + (16 * tt + n) * 136 + 32 * kb + quad * 8), bb = *(const LAS bf16x8*)(kt + (16 * st + n) * 136 + 32 * kb + quad * 8);
                        acc = MFMA(a, bb, acc); } }
#pragma unroll
                for (int j = 0; j < 4; ++j) { const int ti = 16 * tt + quad * 4 + j, sidx = 16 * st + n; sc[ti * 72 + sidx] = (st <= tt && sidx <= ti) ? f2bf(acc[j]) : (bf16_t)0; } }
        }
        __syncthreads();
        {
            bf16x8 vB[2];
#pragma unroll
            for (int sb = 0; sb < 2; ++sb) vB[sb] = *(const LAS bf16x8*)(vT + (16 * w + n) * 72 + 32 * sb + quad * 8);
#pragma unroll
            for (int tt = 0; tt < 4; ++tt) { f32x4 acc = {0.f, 0.f, 0.f, 0.f};
#pragma unroll
                for (int sb = 0; sb < 2; ++sb) if (32 * sb <= 16 * tt + 15) { const bf16x8 a = *(const LAS bf16x8*)(sc + (16 * tt + n) * 72 + 32 * sb + quad * 8); acc = MFMA(a, vB[sb], acc); }
#pragma unroll
                for (int j = 0; j < 4; ++j) { const int ti = 16 * tt + quad * 4 + j; if (!dry) O[(size_t)(rowb + (dir ? 63 - ti : ti)) * 512 + head * 128 + 16 * w + n] = f2bf(acc[j]); } }
            if (!dry) { const int r = tid >> 3, c16 = (tid & 7) * 16; const u32x4 x0 = *(const LAS u32x4*)(qi + r * 136 + c16), x1 = *(const LAS u32x4*)(qi + r * 136 + c16 + 8);
              bf16_t* dq = dir ? (bf16_t*)(p.ws + WS_Q1) + (size_t)(rowb + r) * 512 + head * 128 + c16 : P + (size_t)(rowb + r) * 3072 + 512 + head * 128 + c16;
              *(u32x4*)dq = x0; *(u32x4*)(dq + 8) = x1; }
            if (!dry) { const int r = tid >> 3, c16 = (tid & 7) * 16, k = 2 * r + (c16 >> 6), s0 = c16 & 63;
              const u32x4 x0 = *(const LAS u32x4*)(keT + k * 72 + s0), x1 = *(const LAS u32x4*)(keT + k * 72 + s0 + 8), y0 = *(const LAS u32x4*)(vT + k * 72 + s0), y1 = *(const LAS u32x4*)(vT + k * 72 + s0 + 8);
              bf16_t* dk = P + (size_t)(rowb + r) * 3072 + (dir ? 1536 : 1024) + head * 128 + c16; *(u32x4*)dk = x0; *(u32x4*)(dk + 8) = x1;
              bf16_t* dv = dir ? (bf16_t*)(p.ws + WS_VT1) + (size_t)(rowb + r) * 512 + head * 128 + c16 : P + (size_t)(rowb + r) * 3072 + 2048 + head * 128 + c16; *(u32x4*)dv = y0; *(u32x4*)(dv + 8) = y1; }
        }
        __syncthreads();
    }
}

constexpr int HC_BUF = 17408 + 18432 + 18432 + 512;
static_assert(2 * HC_BUF <= LDS_BYTES - 256, "chain lds");
__device__ __forceinline__ void hgrn_chain2(const Ctx& p, int chain, LAS unsigned char* lds, bool dry) {
    const int tid = mk_tid(), w = __builtin_amdgcn_readfirstlane(tid >> 6), lane = tid & 63, n = lane & 15, quad = lane >> 4;
    const int b = chain >> 3, dir = (chain >> 2) & 1, head = chain & 3;
    const bf16_t* P = (const bf16_t*)(p.ws + WS_P);
    bf16_t* O = (bf16_t*)(p.ws + (dir ? WS_OB : WS_OF));
    const bf16_t* srcQ = dir ? (const bf16_t*)(p.ws + WS_Q1) + head * 128 : P + 512 + head * 128; const int ldq = dir ? 512 : 3072;
    const bf16_t* srcK = P + (dir ? 1536 : 1024) + head * 128;
    const bf16_t* srcV = dir ? (const bf16_t*)(p.ws + WS_VT1) + head * 128 : P + 2048 + head * 128; const int ldv = dir ? 512 : 3072;
    const bf16_t* E63 = (const bf16_t*)(p.ws + WS_E63);
    const int r = tid >> 3, c16 = (tid & 7) * 16, kk2 = 2 * r + (c16 >> 6), s0 = c16 & 63;
    f32x4 S[8];
#pragma unroll
    for (int i = 0; i < 8; ++i) S[i] = (f32x4){0.f, 0.f, 0.f, 0.f};
    u32x4 pq0, pq1, pk0, pk1, pv0, pv1; unsigned pe = 0u;
    auto fetch = [&](int pc) { const int tc = dir == 0 ? pc : (pc < 4 ? 3 - pc : 39 - pc); const int rowb = tc < 4 ? ML + b * 256 + tc * 64 : b * 2048 + (tc - 4) * 64;
        const bf16_t* q = srcQ + (size_t)(rowb + r) * ldq + c16; pq0 = *(const u32x4*)q; pq1 = *(const u32x4*)(q + 8);
        const bf16_t* k = srcK + (size_t)(rowb + r) * 3072 + c16; pk0 = *(const u32x4*)k; pk1 = *(const u32x4*)(k + 8);
        const bf16_t* v = srcV + (size_t)(rowb + r) * ldv + c16; pv0 = *(const u32x4*)v; pv1 = *(const u32x4*)(v + 8);
        if (tid < 64) pe = *(const unsigned*)(E63 + ((size_t)(dir * 288 + b * 36 + tc) * 4 + head) * 128 + tid * 2); };
    fetch(0);
#pragma unroll 1
    for (int pc = 0; pc < 36; ++pc) {
        LAS unsigned char* buf = lds + (pc & 1) * HC_BUF;
        LAS bf16_t* qi = (LAS bf16_t*)buf; LAS bf16_t* keT = (LAS bf16_t*)(buf + 17408); LAS bf16_t* vT = (LAS bf16_t*)(buf + 17408 + 18432); LAS float* e63 = (LAS float*)(buf + 17408 + 2 * 18432);
        *(LAS u32x4*)(qi + r * 136 + c16) = pq0; *(LAS u32x4*)(qi + r * 136 + c16 + 8) = pq1;
        *(LAS u32x4*)(keT + kk2 * 72 + s0) = pk0; *(LAS u32x4*)(keT + kk2 * 72 + s0 + 8) = pk1;
        *(LAS u32x4*)(vT + kk2 * 72 + s0) = pv0; *(LAS u32x4*)(vT + kk2 * 72 + s0 + 8) = pv1;
        if (tid < 64) { e63[tid * 2] = bflo(pe); e63[tid * 2 + 1] = bfhi(pe); }
        __syncthreads();
        const int tc = dir == 0 ? pc : (pc < 4 ? 3 - pc : 39 - pc); const int rowb = tc < 4 ? ML + b * 256 + tc * 64 : b * 2048 + (tc - 4) * 64;
        if (pc < 35) fetch(pc + 1);
        unsigned short oin[4][4];
#pragma unroll
        for (int tt = 0; tt < 4; ++tt)
#pragma unroll
            for (int j = 0; j < 4; ++j) { const int ti = 16 * tt + quad * 4 + j; oin[tt][j] = O[(size_t)(rowb + (dir ? 63 - ti : ti)) * 512 + head * 128 + 16 * w + n]; }
        bf16x8 Sb[4], vB[2];
#pragma unroll
        for (int kb = 0; kb < 4; ++kb) Sb[kb] = mk8(pk2(S[2 * kb][0], S[2 * kb][1]), pk2(S[2 * kb][2], S[2 * kb][3]), pk2(S[2 * kb + 1][0], S[2 * kb + 1][1]), pk2(S[2 * kb + 1][2], S[2 * kb + 1][3]));
#pragma unroll
        for (int sb = 0; sb < 2; ++sb) vB[sb] = *(const LAS bf16x8*)(vT + (16 * w + n) * 72 + 32 * sb + quad * 8);
        f32x4 acc[4];
#pragma unroll
        for (int tt = 0; tt < 4; ++tt) { acc[tt] = (f32x4){0.f, 0.f, 0.f, 0.f};
#pragma unroll
            for (int kb = 0; kb < 4; ++kb) { const bf16x4 a0 = *(const LAS bf16x4*)(qi + (16 * tt + n) * 136 + 32 * kb + quad * 4), a1 = *(const LAS bf16x4*)(qi + (16 * tt + n) * 136 + 32 * kb + 16 + quad * 4);
                acc[tt] = MFMA(__builtin_shufflevector(a0, a1, 0, 1, 2, 3, 4, 5, 6, 7), Sb[kb], acc[tt]); } }
#pragma unroll
        for (int k8 = 0; k8 < 8; ++k8) { const f32x4 c4 = *(const LAS f32x4*)(e63 + 16 * k8 + quad * 4);
            f32x4 sv = S[k8] * c4;
#pragma unroll
            for (int sb = 0; sb < 2; ++sb) { const bf16x8 a = *(const LAS bf16x8*)(keT + (16 * k8 + n) * 72 + 32 * sb + quad * 8); sv = MFMA(a, vB[sb], sv); }
            S[k8] = sv; }
#pragma unroll
        for (int tt = 0; tt < 4; ++tt)
#pragma unroll
            for (int j = 0; j < 4; ++j) { const int ti = 16 * tt + quad * 4 + j; if (!dry) O[(size_t)(rowb + (dir ? 63 - ti : ti)) * 512 + head * 128 + 16 * w + n] = f2bf(acc[tt][j] + bf2f(oin[tt][j])); }
    }
    __syncthreads();
}

__device__ __forceinline__ void hgrn_combine(const Ctx& p, int e) {
    const int lane = mk_tid() & 63, wg = blockIdx.x * 8 + (mk_tid() >> 6), nw = gridDim.x * 8;
    const bf16_t* P = (const bf16_t*)(p.ws + WS_P); const unsigned* OF = (const unsigned*)(p.ws + WS_OF); const unsigned* OB = (const unsigned*)(p.ws + WS_OB);
    unsigned* MX = (unsigned*)(p.ws + WS_A); const float* on = p.in[23] + e * 128;
    const float g0 = on[lane * 2], g1 = on[lane * 2 + 1];
    for (int row = wg; row < MT; row += nw) {
        unsigned a[4], bq[4], gg[4];
#pragma unroll
        for (int h = 0; h < 4; ++h) { a[h] = OF[(size_t)row * 256 + h * 64 + lane]; bq[h] = OB[(size_t)row * 256 + h * 64 + lane]; gg[h] = *(const unsigned*)(P + (size_t)row * 3072 + 2560 + h * 128 + lane * 2); }
#pragma unroll
        for (int h = 0; h < 4; ++h) {
            const float v0 = bflo(a[h]) + bflo(bq[h]), v1 = bfhi(a[h]) + bfhi(bq[h]); const float ss = wsum(v0 * v0 + v1 * v1); const float rs = rsqrtf(ss * (1.0f / 128.0f) + 1e-6f);
            MX[(size_t)row * 512 + 256 + h * 64 + lane] = pk2(v0 * rs * g0 * siluf(bflo(gg[h])), v1 * rs * g1 * siluf(bfhi(gg[h]))); }
    }
}

__device__ __forceinline__ void odd_post1(const Ctx& p, int o) {
    const int lane = mk_tid() & 63, wg = blockIdx.x * 8 + (mk_tid() >> 6), nw = gridDim.x * 8;
    bf16_t* P = (bf16_t*)(p.ws + WS_P); bf16_t* A23 = (bf16_t*)(p.ws + WS_A);
    const float* rope = (const float*)(p.ws + WS_ROPE);
    const float nq = p.in[26][o * 128 + lane], nk = p.in[26][o * 128 + 64 + lane], nr = p.in[33][o * 128 + 64 + lane];
    float gq[6], gk[4];
#pragma unroll
    for (int i = 0; i < 6; ++i) gq[i] = p.in[28][o * 384 + lane + 64 * i];
#pragma unroll
    for (int i = 0; i < 4; ++i) gk[i] = p.in[29][o * 256 + lane + 64 * i];
    const int ax = lane >> 5, f = lane & 15, hh = (lane >> 4) & 1;
    for (int row = wg; row < MT; row += nw) {
        bf16_t* pr = P + (size_t)row * 2304; const bool lat = row < ML; const int tk = row & 2047; const int pos = ax ? (tk & 63) : (tk >> 6);
        const float cs = rope[(pos * 16 + f) * 2], sn = rope[(pos * 16 + f) * 2 + 1];
        float x[17], xq[6], xk[4];
#pragma unroll
        for (int v = 0; v < 17; ++v) x[v] = bf2f(pr[(v < 16 ? v * 64 : 2176) + lane]);
#pragma unroll
        for (int i = 0; i < 6; ++i) xq[i] = bf2f(pr[1536 + lane + 64 * i]);
#pragma unroll
        for (int i = 0; i < 4; ++i) xk[i] = bf2f(pr[1920 + lane + 64 * i]);
#pragma unroll
        for (int v = 0; v < 17; ++v) { const float gn = v < 8 ? nq : (v < 16 ? nk : nr);
            const float ss = wsum(x[v] * x[v]); float y = x[v] * rsqrtf(ss * (1.0f / 64.0f) + 1e-6f) * gn;
            if (lat) { const float pt = __shfl_xor(y, 16); y = y * cs + (hh ? pt : -pt) * sn; }
            if (v < 8) y *= 0.125f * 1.4426950408889634f;
            pr[(v < 16 ? v * 64 : 2176) + lane] = f2bf(y); }
        { float ss = 0.f;
#pragma unroll
          for (int i = 0; i < 6; ++i) ss += xq[i] * xq[i];
          ss = wsum(ss); const float rs = rsqrtf(ss * (1.0f / 384.0f) + 1e-6f);
#pragma unroll
          for (int i = 0; i < 6; ++i) A23[(size_t)row * 640 + lane + 64 * i] = f2bf(xq[i] * rs * gq[i]); }
        { float ss = 0.f;
#pragma unroll
          for (int i = 0; i < 4; ++i) ss += xk[i] * xk[i];
          ss = wsum(ss); const float rs = rsqrtf(ss * (1.0f / 256.0f) + 1e-6f);
#pragma unroll
          for (int i = 0; i < 4; ++i) A23[(size_t)row * 640 + 384 + lane + 64 * i] = f2bf(xk[i] * rs * gk[i]); }
    }
}
__device__ __forceinline__ void odd_post2(const Ctx& p, int o) {
    const int lane = mk_tid() & 63, wg = blockIdx.x * 8 + (mk_tid() >> 6), nw = gridDim.x * 8;
    bf16_t* UQ = (bf16_t*)(p.ws + WS_U); bf16_t* UKV = UQ + 768;
    const float* rope = (const float*)(p.ws + WS_ROPE);
    const float qn0 = p.in[32][o * 256 + lane], qn1 = p.in[32][o * 256 + 64 + lane], kn0 = p.in[32][o * 256 + 128 + lane], kn1 = p.in[32][o * 256 + 192 + lane], rn = p.in[33][o * 128 + lane];
    const int ax = lane >> 5, f = lane & 15, hh = (lane >> 4) & 1; const float scl = 0.07216878364870322f * 1.4426950408889634f;
    for (int row = wg; row < MT; row += nw) {
        const bool lat = row < ML; const int tk = row & 2047; const int pos = ax ? (tk & 63) : (tk >> 6);
        const float cs = rope[(pos * 16 + f) * 2], sn = rope[(pos * 16 + f) * 2 + 1];
        bf16_t* uq = UQ + (size_t)row * 1792; bf16_t* ukv = UKV + (size_t)row * 1792;
        float a0[4], a1[4], ar[4], k0[4], k1[4];
#pragma unroll
        for (int h = 0; h < 4; ++h) { a0[h] = bf2f(uq[h * 192 + lane]); a1[h] = bf2f(uq[h * 192 + 64 + lane]); ar[h] = bf2f(uq[h * 192 + 128 + lane]); k0[h] = bf2f(ukv[h * 256 + lane]); k1[h] = bf2f(ukv[h * 256 + 64 + lane]); }
#pragma unroll
        for (int h = 0; h < 4; ++h) {
            { const float ss = wsum(a0[h] * a0[h] + a1[h] * a1[h]); const float rs = rsqrtf(ss * (1.0f / 128.0f) + 1e-6f) * scl;
              uq[h * 192 + lane] = f2bf(a0[h] * rs * qn0); uq[h * 192 + 64 + lane] = f2bf(a1[h] * rs * qn1); }
            { const float ss = wsum(ar[h] * ar[h]); float y = ar[h] * rsqrtf(ss * (1.0f / 64.0f) + 1e-6f) * rn;
              if (lat) { const float pt = __shfl_xor(y, 16); y = y * cs + (hh ? pt : -pt) * sn; }
              uq[h * 192 + 128 + lane] = f2bf(y * scl); }
            { const float ss = wsum(k0[h] * k0[h] + k1[h] * k1[h]); const float rs = rsqrtf(ss * (1.0f / 128.0f) + 1e-6f);
              ukv[h * 256 + lane] = f2bf(k0[h] * rs * kn0); ukv[h * 256 + 64 + lane] = f2bf(k1[h] * rs * kn1); }
        }
    }
}

constexpr int AT_VT = 25600, AT_VRS = 288;
typedef short s16x4 __attribute__((ext_vector_type(4)));
template <int OFF> __device__ __forceinline__ s16x4 tr_read(unsigned vb) { s16x4 r; asm volatile("ds_read_b64_tr_b16 %0, %1 offset:%2" : "=&v"(r) : "v"(vb), "i"(OFF) : "memory"); return r; }
template <int DT> __device__ __forceinline__ void pv_pair(f32x4 (&O)[8][2], unsigned vb, const bf16x8 (&Pf)[2][2]) {
    const s16x4 a00 = tr_read<(0) * AT_VRS + DT * 32>(vb), a01 = tr_read<(16) * AT_VRS + DT * 32>(vb), a10 = tr_read<(32) * AT_VRS + DT * 32>(vb), a11 = tr_read<(48) * AT_VRS + DT * 32>(vb);
    const s16x4 b00 = tr_read<(0) * AT_VRS + (DT + 1) * 32>(vb), b01 = tr_read<(16) * AT_VRS + (DT + 1) * 32>(vb), b10 = tr_read<(32) * AT_VRS + (DT + 1) * 32>(vb), b11 = tr_read<(48) * AT_VRS + (DT + 1) * 32>(vb);
    asm volatile("s_waitcnt lgkmcnt(0)" ::: "memory"); __builtin_amdgcn_sched_barrier(0);
#define PK8(L, H) (bf16x8){L[0], L[1], L[2], L[3], H[0], H[1], H[2], H[3]}
    const bf16x8 va0 = PK8(a00, a01), va1 = PK8(a10, a11), vb0 = PK8(b00, b01), vb1 = PK8(b10, b11);
#undef PK8
    O[DT][0] = MFMA(va0, Pf[0][0], O[DT][0]); O[DT][1] = MFMA(va0, Pf[1][0], O[DT][1]); O[DT + 1][0] = MFMA(vb0, Pf[0][0], O[DT + 1][0]); O[DT + 1][1] = MFMA(vb0, Pf[1][0], O[DT + 1][1]);
    O[DT][0] = MFMA(va1, Pf[0][1], O[DT][0]); O[DT][1] = MFMA(va1, Pf[1][1], O[DT][1]); O[DT + 1][0] = MFMA(vb1, Pf[0][1], O[DT + 1][0]); O[DT + 1][1] = MFMA(vb1, Pf[1][1], O[DT + 1][1]);
}
constexpr int AT_BUF = 45056;
template <int DQ, int K1W>
__device__ __forceinline__ void attn_core(LAS unsigned char* lds, const bf16_t* __restrict__ Q, int qld, int qrow0, const bf16_t* __restrict__ K1, int k1ld,
                                          const bf16_t* __restrict__ K2, int k2ld, const bf16_t* __restrict__ V, int vld, int b, int ntiles, float mref, f32x4 (&O)[8][2]) {
    constexpr int NDK = DQ / 32, KP = DQ + 8, NKL = DQ / 64, C8 = DQ / 8;
    const int tid = mk_tid(), w = __builtin_amdgcn_readfirstlane(tid >> 6), lane = tid & 63, n = lane & 15, quad = lane >> 4;
    const unsigned vb0 = (unsigned)(size_t)(lds + AT_VT) + (unsigned)((quad * 4 + (n >> 2)) * AT_VRS + (n & 3) * 8);
    bf16x8 Qf[2][NDK];
#pragma unroll
    for (int qt = 0; qt < 2; ++qt)
#pragma unroll
        for (int dk = 0; dk < NDK; ++dk) Qf[qt][dk] = *(const bf16x8*)(Q + (size_t)(qrow0 + w * 32 + qt * 16 + n) * qld + dk * 32 + quad * 8);
    float lrun[2] = {0.f, 0.f}, mrun[2] = {-1e30f, -1e30f};
#pragma unroll
    for (int dt = 0; dt < 8; ++dt) { O[dt][0] = (f32x4){0.f, 0.f, 0.f, 0.f}; O[dt][1] = (f32x4){0.f, 0.f, 0.f, 0.f}; }
    u32x4 kr[NKL], vr[2];
    auto issue = [&](int ktile) {
        const int rowb = ktile < 4 ? ML + b * 256 + ktile * 64 : b * 2048 + (ktile - 4) * 64;
#pragma unroll
        for (int i = 0; i < NKL; ++i) { const int idx = tid + i * 512, key = idx / C8, d0 = (idx % C8) * 8;
            const bf16_t* src = d0 < K1W ? K1 + (size_t)(rowb + key) * k1ld + d0 : K2 + (size_t)(rowb + key) * k2ld + (d0 - K1W);
            kr[i] = *(const u32x4*)src; }
#pragma unroll
        for (int i = 0; i < 2; ++i) { const int idx = tid + i * 512, key = idx >> 4, d0 = (idx & 15) * 8; vr[i] = *(const u32x4*)(V + (size_t)(rowb + key) * vld + d0); }
    };
    auto stage = [&](int bufi) { LAS bf16_t* Ks = (LAS bf16_t*)(lds + bufi * AT_BUF); LAS bf16_t* Vs = (LAS bf16_t*)(lds + bufi * AT_BUF + AT_VT);
#pragma unroll
        for (int i = 0; i < NKL; ++i) { const int idx = tid + i * 512, key = idx / C8, d0 = (idx % C8) * 8; *(LAS u32x4*)(Ks + key * KP + d0) = kr[i]; }
#pragma unroll
        for (int i = 0; i < 2; ++i) { const int idx = tid + i * 512, key = idx >> 4, d0 = (idx & 15) * 8; *(LAS u32x4*)(Vs + key * (AT_VRS / 2) + d0) = vr[i]; } };
    issue(0);
    __syncthreads();
    stage(0);
    if (ntiles > 1) issue(1);
    __syncthreads();
#pragma unroll 1
    for (int ktile = 0; ktile < ntiles; ++ktile) {
        const int bufi = ktile & 1;
        LAS bf16_t* Ks = (LAS bf16_t*)(lds + bufi * AT_BUF);
        const unsigned vb = vb0 + (unsigned)(bufi * AT_BUF);
        f32x4 s[4][2];
#pragma unroll
        for (int st = 0; st < 4; ++st) { s[st][0] = (f32x4){0.f, 0.f, 0.f, 0.f}; s[st][1] = (f32x4){0.f, 0.f, 0.f, 0.f};
#pragma unroll
            for (int dk = 0; dk < NDK; ++dk) { const bf16x8 a = *(const LAS bf16x8*)(Ks + (16 * st + n) * KP + 32 * dk + quad * 8);
                s[st][0] = MFMA(a, Qf[0][dk], s[st][0]); s[st][1] = MFMA(a, Qf[1][dk], s[st][1]); }
            asm volatile("" ::: "memory"); }
        bf16x8 Pf[2][2];
#pragma unroll
        for (int qt = 0; qt < 2; ++qt) {
            float mx = s[0][qt][0];
#pragma unroll
            for (int st = 0; st < 4; ++st)
#pragma unroll
                for (int j = 0; j < 4; ++j) mx = fmaxf(mx, s[st][qt][j]);
            mx = fmaxf(mx, __shfl_xor(mx, 16)); mx = fmaxf(mx, __shfl_xor(mx, 32));
            if (__any(mx > mrun[qt])) {
                const float mnew = fmaxf(mrun[qt], mx); const float alpha = __builtin_amdgcn_exp2f(mrun[qt] - mnew); mrun[qt] = mnew; lrun[qt] *= alpha;
#pragma unroll
                for (int dt = 0; dt < 8; ++dt) O[dt][qt] *= alpha; }
            const float mcur = mrun[qt]; float ls = 0.f;
#pragma unroll
            for (int st = 0; st < 4; ++st)
#pragma unroll
                for (int j = 0; j < 4; ++j) { const float pv = __builtin_amdgcn_exp2f(s[st][qt][j] - mcur); s[st][qt][j] = pv; ls += pv; }
            lrun[qt] += ls;
#pragma unroll
            for (int kb = 0; kb < 2; ++kb) Pf[qt][kb] = mk8(pk2(s[2 * kb][qt][0], s[2 * kb][qt][1]), pk2(s[2 * kb][qt][2], s[2 * kb][qt][3]), pk2(s[2 * kb + 1][qt][0], s[2 * kb + 1][qt][1]), pk2(s[2 * kb + 1][qt][2], s[2 * kb + 1][qt][3]));
        }
        pv_pair<0>(O, vb, Pf); pv_pair<2>(O, vb, Pf); pv_pair<4>(O, vb, Pf); pv_pair<6>(O, vb, Pf);
        if (ktile + 1 < ntiles) { stage(bufi ^ 1); if (ktile + 2 < ntiles) issue(ktile + 2); }
        __syncthreads();
    }
#pragma unroll
    for (int qt = 0; qt < 2; ++qt) { float l = lrun[qt]; l += __shfl_xor(l, 16); l += __shfl_xor(l, 32); const float inv = rcpf_(l);
#pragma unroll
        for (int dt = 0; dt < 8; ++dt) O[dt][qt] *= inv; }
}

__device__ __forceinline__ void attn_phase(const Ctx& p, int o, int l, bool need_ctx, LAS unsigned char* lds) {
    const int lane = mk_tid() & 63;
    const bf16_t* P = (const bf16_t*)(p.ws + WS_P); const bf16_t* UQ = (const bf16_t*)(p.ws + WS_U); const bf16_t* UKV = UQ + 768;
    bf16_t* MX = (bf16_t*)(p.ws + WS_A);
    const float lam_init = l == 1 ? 0.35550906759f : 0.55605820416f;
    float lam;
    { const float* lv = p.in[25] + o * 256; const float d1 = wsum(lv[lane] * lv[64 + lane]), d2 = wsum(lv[128 + lane] * lv[192 + lane]);
      lam = __uint_as_float(__builtin_amdgcn_readfirstlane(__float_as_uint(expf(d1) - expf(d2) + lam_init))); }
    float mref_d, mref_m;
    { const float L2E = 1.4426950408889634f;
      float gq = fabsf(p.in[26][o * 128 + lane]), gk = fabsf(p.in[26][o * 128 + 64 + lane]);
      float n0a = fmaxf(fabsf(p.in[32][o * 256 + lane]), fabsf(p.in[32][o * 256 + 64 + lane])), n1a = fmaxf(fabsf(p.in[32][o * 256 + 128 + lane]), fabsf(p.in[32][o * 256 + 192 + lane]));
      float r0 = fabsf(p.in[33][o * 128 + lane]), r1 = fabsf(p.in[33][o * 128 + 64 + lane]);
#pragma unroll
      for (int off = 32; off >= 1; off >>= 1) { gq = fmaxf(gq, __shfl_xor(gq, off)); gk = fmaxf(gk, __shfl_xor(gk, off)); n0a = fmaxf(n0a, __shfl_xor(n0a, off)); n1a = fmaxf(n1a, __shfl_xor(n1a, off)); r0 = fmaxf(r0, __shfl_xor(r0, off)); r1 = fmaxf(r1, __shfl_xor(r1, off)); }
      mref_d = __uint_as_float(__builtin_amdgcn_readfirstlane(__float_as_uint(64.0f * gq * gk * 0.125f * L2E * 1.01f + 0.5f)));
      mref_m = __uint_as_float(__builtin_amdgcn_readfirstlane(__float_as_uint(sqrtf((128.f * n0a * n0a + 64.f * r0 * r0) * (128.f * n1a * n1a + 64.f * r1 * r1)) * 0.07216878364870322f * L2E * 1.01f + 0.5f))); }
    const int nunits = need_ctx ? 576 : 512;
#pragma unroll 1
    for (int u = blockIdx.x; u < nunits; u += gridDim.x) {
        const bool isctx = u >= 512; const int uu = isctx ? u - 512 : u;
        const bool mla = isctx ? (uu < 32) : (uu < 256); const int v = isctx ? (uu & 31) : (uu & 255);
        int b, head, qb;
        if (isctx) { b = v >> 2; head = v & 3; qb = 0; } else { b = v >> 5; head = (v >> 3) & 3; qb = v & 7; }
        const int qrow0 = isctx ? ML + b * 256 : b * 2048 + qb * 256; const int ntiles = isctx ? 4 : 36;
        f32x4 O[8][2];
        if (mla) {
            attn_core<192, 128>(lds, UQ + head * 192, 1792, qrow0, UKV + head * 256, 1792, P + 2176, 2304, UKV + head * 256 + 128, 1792, b, ntiles, mref_m, O);
            const int t3 = mk_tid(), w = t3 >> 6, n = t3 & 15, quad = (t3 & 63) >> 4;
#pragma unroll
            for (int qt = 0; qt < 2; ++qt) { const size_t row = (size_t)(qrow0 + w * 32 + qt * 16 + n);
#pragma unroll
                for (int dt = 0; dt < 8; ++dt) { u32x2 ww; ww.x = pk2(O[dt][qt][0], O[dt][qt][1]); ww.y = pk2(O[dt][qt][2], O[dt][qt][3]); *(u32x2*)(MX + row * 1024 + 512 + head * 128 + 16 * dt + quad * 4) = ww; } }
        } else {
            LAS u32x2* O1s = (LAS u32x2*)(lds + 2 * AT_BUF) + mk_tid();
            attn_core<64, 64>(lds, P + head * 128, 2304, qrow0, P + 512 + head * 128, 2304, P, 2304, P + 1024 + head * 128, 2304, b, ntiles, mref_d, O);
#pragma unroll
            for (int dt = 0; dt < 8; ++dt)
#pragma unroll
                for (int qt = 0; qt < 2; ++qt) { u32x2 t2; t2.x = pk2(O[dt][qt][0], O[dt][qt][1]); t2.y = pk2(O[dt][qt][2], O[dt][qt][3]); O1s[(dt * 2 + qt) * 512] = t2; }
            attn_core<64, 64>(lds, P + head * 128 + 64, 2304, qrow0, P + 512 + head * 128 + 64, 2304, P, 2304, P + 1024 + head * 128, 2304, b, ntiles, mref_d, O);
            const float* sl = p.in[27] + o * 128; const int t3 = mk_tid(), w = t3 >> 6, n = t3 & 15, quad = (t3 & 63) >> 4, quad2 = quad;
#pragma unroll
            for (int qt = 0; qt < 2; ++qt) { const size_t row = (size_t)(qrow0 + w * 32 + qt * 16 + n); float ss = 0.f;
#pragma unroll
                for (int dt = 0; dt < 8; ++dt) { { const u32x2 t2 = O1s[(dt * 2 + qt) * 512]; O[dt][qt] = (f32x4){bflo(t2.x), bfhi(t2.x), bflo(t2.y), bfhi(t2.y)} - lam * O[dt][qt]; } ss += O[dt][qt][0] * O[dt][qt][0] + O[dt][qt][1] * O[dt][qt][1] + O[dt][qt][2] * O[dt][qt][2] + O[dt][qt][3] * O[dt][qt][3]; }
                ss += __shfl_xor(ss, 16); ss += __shfl_xor(ss, 32); const float rs = rsqrtf(ss * (1.0f / 128.0f) + 1e-6f) * (1.0f - lam_init);
#pragma unroll
                for (int dt = 0; dt < 8; ++dt) { const f32x4 g = *(const f32x4*)(sl + 16 * dt + quad2 * 4); u32x2 ww; ww.x = pk2(O[dt][qt][0] * rs * g[0], O[dt][qt][1] * rs * g[1]); ww.y = pk2(O[dt][qt][2] * rs * g[2], O[dt][qt][3] * rs * g[3]);
                    *(u32x2*)(MX + row * 1024 + head * 128 + 16 * dt + quad * 4) = ww; } }
        }
    }
}

#ifdef REP_PH
#define HG_DRY (reps == 0 && ph == REP_PH)
#else
#define HG_DRY false
#endif
#ifdef GONLY
#define GSEL(k) && (GONLY == k)
#else
#define GSEL(k)
#endif
__global__ void __launch_bounds__(512) mega(Params kp) {
    extern __shared__ __attribute__((aligned(16))) unsigned char shm[];
    LAS unsigned char* lds = (LAS unsigned char*)shm;
    cg::grid_group grid = cg::this_grid();
    { const float** tabw = (const float**)(kp.ws + WS_TAB); const int t = threadIdx.x; if (t < 34) tabw[t] = kp.in[t]; }
    volatile LAS unsigned* bst = (volatile LAS unsigned*)(lds + LDS_BYTES - 256);
    if (threadIdx.x < 2) bst[threadIdx.x] = 0u;
    __syncthreads();
    const XcdBarrier xbar = xcd_barrier_post((unsigned*)(kp.ws + WS_BAR), bst);
    const int ph_hi = kp.ph_hi;
#ifdef REP_PH
    int reps = 0;
#endif
#pragma unroll 1
    for (int ph = kp.ph_lo; ph < ph_hi; ++ph) {
        unsigned char* ws = kp.ws; asm volatile("" : "+s"(ws));
        Ctx p; p.ws = ws; p.in = (const float* const*)(ws + WS_TAB); p.out = kp.out;
        const int bid = blockIdx.x, nb = gridDim.x, w = __builtin_amdgcn_readfirstlane(mk_tid() >> 6);
        if (ph == 0) {
#if !defined(ONLY) || ONLY==0

#if defined(REP_PH) && defined(REP_PART)
 prep_phase(p, lds, reps ? REP_PART : 0);
#else
 prep_phase(p, lds, 0);
#endif
#endif
 }
        else if (ph == 1) prep2_phase(p, lds);
        else {
            const int l = (ph - 2) / 10, s = (ph - 2) % 10, eo = l >> 1;
            if (s == 0 || s == 7) continue;
            float* SS = (float*)(ws + WS_SS); const float* BIAS = (const float*)(ws + WS_BIAS) + (size_t)l * 9 * 8704; const bool odd = l & 1; const bool need_ctx = l < 3; const int Mres = need_ctx ? MT : ML;
            const float* mod = (const float*)(ws + WS_MOD) + (size_t)l * 9 * 6144;
            const bf16_t* Abuf = (const bf16_t*)(ws + WS_A);
            if (s == 1) {
#if !defined(ONLY) || ONLY==4
                EpiStore<true> E; E.O = (bf16_t*)(ws + WS_P); E.ss = SS + (size_t)(2 * l) * MT; E.bias = BIAS;
                if (!odd) { E.ldc = 3072; run_gemm(lds, Abuf, (const bf16_t*)(ws + WS_WAB) + (size_t)eo * 3072 * 1024, MT, 3072, 1024, E); }
                else { E.ldc = 2304; run_gemm(lds, Abuf, (const bf16_t*)(ws + WS_WCD) + (size_t)eo * 2304 * 1024, MT, 2304, 1024, E); }
#endif
            }
            else if (s == 2) {
                if (!odd) {
#if !defined(ONLY) || ONLY==1
                    for (int u = bid; u < 1152; u += nb) hg_pre_unit(p, eo, u, lds, HG_DRY);
                    if (!HG_DRY)
#endif
#if !defined(ONLY) || ONLY==2
                    for (int u = w * nb + bid; u < 1152; u += 8 * nb) s5_unit<1>(p, eo, u / 36, u % 36, lds);
#endif
                } else odd_post1(p, eo);
            }
            else if (s == 3) {
                if (!odd) s5_carry(p, eo);
                else {
#if !defined(ONLY) || ONLY==4
                    EpiStore<false> E; E.O = (bf16_t*)(ws + WS_U); E.ldc = 1792; E.ss = nullptr; E.bias = nullptr; run_gemm(lds, Abuf, (const bf16_t*)(ws + WS_WU) + (size_t)eo * 1792 * 640, MT, 1792, 640, E);
#endif
                }
            }
            else if (s == 4) {
                if (!odd) {
                    const bool split = nb >= 128;
#if !defined(ONLY) || ONLY==1
                    for (int chn = bid; chn < 64; chn += nb) hgrn_chain2(p, chn, lds, HG_DRY);
                    if (!HG_DRY)
#endif
#if !defined(ONLY) || ONLY==2
                    if (!split || bid >= 64) { const int nbb = split ? nb - 64 : nb, bb = split ? bid - 64 : bid;
                        for (int u = w * nbb + bb; u < 1152; u += 8 * nbb) s5_unit<2>(p, eo, u / 36, u % 36, lds); }
#endif
                } else odd_post2(p, eo);
            }
            else if (s == 5) {
                if (!odd) {
#if !defined(ONLY) || ONLY==4
                    EpiGLU E; E.MX = (bf16_t*)(ws + WS_A); E.Z = (const bf16_t*)(ws + WS_Z); E.bias = p.in[21] + eo * 512;
                    run_gemm(lds, (const bf16_t*)(ws + WS_Z), (const bf16_t*)(ws + WS_WGLU) + (size_t)eo * 512 * 512, MT, 512, 512, E);
                    __syncthreads();
#endif
                    hgrn_combine(p, eo);
                } else {
#if !defined(ONLY) || ONLY==3
                    attn_phase(p, eo, l, need_ctx, lds);
#endif
                }
            }
            else if (s == 6 || s == 9) {
#if !defined(ONLY) || ONLY==4
                EpiRes E; E.H = (float*)(ws + WS_H); E.gate = mod + (s == 6 ? 2 : 5) * 1024; E.out = (l == 3 && s == 9) ? p.out : nullptr;
                if (s == 6) { E.Hb = (bf16_t*)(ws + WS_HB1); E.gn = p.in[7] + l * 1024; E.scn = mod + 4 * 1024; E.ss = SS + (size_t)(2 * l + 1) * MT; }
                else if (l < 3) { E.Hb = (bf16_t*)(ws + WS_A); E.gn = p.in[6] + (l + 1) * 1024; E.scn = mod + 9 * 6144 + 1024; E.ss = SS + (size_t)(2 * l + 2) * MT; }
                else { E.Hb = nullptr; E.gn = nullptr; E.scn = nullptr; E.ss = nullptr; }
                if (s == 6) run_gemm(lds, Abuf, (const bf16_t*)(ws + WS_WO) + (size_t)l * 1024 * 1024, Mres, 1024, 1024, E);
                else run_gemm(lds, (const bf16_t*)(ws + WS_P), (const bf16_t*)(ws + WS_WFO) + (size_t)l * 1024 * 2816, Mres, 1024, 2816, E);
#endif
            }
            else if (s == 8) {
#if !defined(ONLY) || ONLY==4
                EpiSwiGLU E; E.G = (bf16_t*)(ws + WS_P); E.ss = SS + (size_t)(2 * l + 1) * MT; E.bias = BIAS + 3072;
                run_gemm(lds, (const bf16_t*)(ws + WS_HB1), (const bf16_t*)(ws + WS_WFI) + (size_t)l * 5632 * 1024, Mres, 5632, 1024, E);
#endif
            }
        }
        if (ph + 1 < ph_hi) { if (ph_hi > 1000) grid.sync(); else xcd_barrier(xbar); }
#ifdef EXTRA_SYNC
        if (ph == 0) { for (int q = 0; q < 32; ++q) xcd_barrier(xbar); }
#endif
#ifdef REP_PH
        if (ph == REP_PH && reps < 1) { ++reps; --ph; }
#endif
    }
}

extern "C" void kernel_launch(void* const* d_in, const int* in_sizes, int n_in, void* d_out, int out_size, void* d_ws, size_t ws_size, hipStream_t stream) {
    static int grid = 0;
    if (grid == 0) {
        if (n_in != 34 || ws_size < WS_NEED) { fprintf(stderr, "kernel_launch: unexpected n_in %d / ws_size %zu (need %zu)\n", n_in, ws_size, (size_t)WS_NEED); }
        int dev = 0, cus = 0, per_cu = 0;
        hipGetDevice(&dev); hipDeviceGetAttribute(&cus, hipDeviceAttributeMultiprocessorCount, dev);
        hipFuncSetAttribute((const void*)mega, hipFuncAttributeMaxDynamicSharedMemorySize, LDS_BYTES);
        hipOccupancyMaxActiveBlocksPerMultiprocessor(&per_cu, (const void*)mega, 512, LDS_BYTES);
        (void)hipGetLastError();
        if (per_cu < 1) fprintf(stderr, "kernel_launch: occupancy query says %d blocks per CU\n", per_cu);
        grid = cus > 0 ? cus : 256;
    }
    hipMemsetAsync((char*)d_ws + WS_SS, 0, 8ull * MT * 4 + XCD_BAR_WORDS * 4, stream);
    Params p{};
    for (int i = 0; i < 34; ++i) p.in[i] = (const float*)d_in[i];
    p.out = (float*)d_out; p.ws = (unsigned char*)d_ws;
#if MK_MODE == 0
    p.ph_lo = 0; p.ph_hi = NPH;
    void* args[] = {&p};
    hipError_t e = hipLaunchCooperativeKernel((const void*)mega, dim3(grid), dim3(512), args, LDS_BYTES, stream);
    if (e != hipSuccess) fprintf(stderr, "cooperative launch failed: %s (grid %d)\n", hipGetErrorString(e), grid);
#else
    for (int ph = 0; ph < NPH; ++ph) { p.ph_lo = ph; p.ph_hi = ph + 1; hipLaunchKernelGGL(mega, dim3(grid), dim3(512), LDS_BYTES, stream, p); }
#endif
}
```

```cpp
#include <hip/hip_runtime.h>
#include <hip/hip_cooperative_groups.h>
#include <cstdio>
namespace cg = cooperative_groups;
#ifndef MK_MODE
#define MK_MODE 0
#endif
__device__ __forceinline__ int mk_tid() { int t = threadIdx.x; asm volatile("" : "+v"(t)); return t; }
namespace pg8 {
#define PG8_LAS __attribute__((address_space(3)))
typedef unsigned short bf16_t;
typedef short bf16x8 __attribute__((ext_vector_type(8)));
typedef float f32x4 __attribute__((ext_vector_type(4)));
typedef unsigned u32x4 __attribute__((ext_vector_type(4)));
constexpr int BM = 256, BK = 64, HALF = 128, HTB = HALF * BK * 2  , STAGE_BYTES = 8 * HTB, NXCD = 8, WGM = 8;

__host__ __device__ __forceinline__ int lds_byte(int r, int c) { const int st = (r >> 4) * 2 + (c >> 5), rr = r & 15, cc = c & 31, ob = rr * 64 + cc * 2; return st * 1024 + (ob ^ (((ob >> 9) & 1) << 5)); }
__host__ __device__ __forceinline__ void stage_rc(int b, int& R, int& C) { const int st = b / 1024, sb = b % 1024, swz = sb ^ (((sb >> 9) & 1) << 5); R = (st >> 1) * 16 + swz / 64; C = (st & 1) * 32 + (swz % 64) / 2; }
__host__ __device__ __forceinline__ int perm32(int rho) { const int n = rho >> 4, i = rho & 15; return 8 * (i >> 2) + 4 * n + (i & 3); }

struct Unit { int pm, pn, ks; };
struct Gemm { const bf16_t* A; const bf16_t* Bt; int M, N, K, ld; };

struct StaticOrder {
    int nM, nN, nwg, G, c;
    __host__ __device__ void init(int M, int N, int G_, int c_) { nM = M / BM; nN = N / BM; nwg = nM * nN; G = G_; c = c_; }
    __host__ __device__ bool next(int i, Unit& u) const {
        const long L = (long)i * G + c; if (L >= nwg) return false;
        int wgid = (int)L; { const int q = nwg / NXCD, r = nwg % NXCD, xcd = wgid % NXCD, off = wgid / NXCD; wgid = (xcd < r ? xcd * (q + 1) : r * (q + 1) + (xcd - r) * q) + off; }
        const int nig = WGM * nN, gid = wgid / nig, fm = gid * WGM, gsz = (nM - fm) < WGM ? (nM - fm) : WGM;
        u.pm = fm + ((wgid % nig) % gsz); u.pn = (wgid % nig) / gsz; u.ks = 0; return true;
    }
    __device__ __forceinline__ void a_ready(const Unit&) const {}
    __device__ __forceinline__ void done(const Unit&) const {}
};
struct SliceOrder {
    int pm0, nN, nsplit, total, G, c;
    __host__ __device__ void init(int pm0_, int ntm, int N, int nsplit_, int G_, int c_) { pm0 = pm0_; nN = N / BM; nsplit = nsplit_; total = ntm * nN * nsplit_; G = G_; c = c_; }
    __host__ __device__ bool next(int i, Unit& u) const { const int L = i * G + c; if (L >= total) return false; const int tile = L / nsplit; u.ks = L - tile * nsplit; u.pm = pm0 + tile / nN; u.pn = tile % nN; return true; }
    __device__ __forceinline__ void a_ready(const Unit&) const {}
    __device__ __forceinline__ void done(const Unit&) const {}
};
typedef __bf16 bf16x2_native __attribute__((ext_vector_type(2)));
typedef float f32x2_native __attribute__((ext_vector_type(2)));
__device__ __forceinline__ unsigned cvt_pk_bf16(float lo, float hi) { const f32x2_native v = {lo, hi}; const bf16x2_native r = __builtin_convertvector(v, bf16x2_native); return __builtin_bit_cast(unsigned, r); }
typedef float f32x2 __attribute__((ext_vector_type(2)));
template <class Epi, class Sched, bool STAMP = false>
__device__ __forceinline__ void gemm_phase(PG8_LAS unsigned char* lds, const Gemm g, const Sched& S, const Epi& E, unsigned long long* stamps) {
    const int tid = mk_tid(), wid = __builtin_amdgcn_readfirstlane(tid >> 6), lane = tid & 63, wr = wid >> 2, wc = wid & 3, fr = lane & 15, fq = lane >> 4;
    const int K = g.K, nt = K / BK;
    int ts_lo = 0, ts_hi = 0, nts = 0; const unsigned long long rt_entry = STAMP ? (unsigned long long)wall_clock64() : 0ull;
#define PG8_STAMP() do { if (STAMP && wid == 0 && nts < 64) { const unsigned long long _c = (unsigned long long)clock64(); \
        ts_lo = (lane == nts) ? (int)(unsigned)_c : ts_lo; ts_hi = (lane == nts) ? (int)(unsigned)(_c >> 32) : ts_hi; ++nts; } } while (0)
    PG8_STAMP();
    unsigned voffA[2], voffB[2];
#pragma unroll
    for (int i = 0; i < 2; ++i) { int R, C; stage_rc(tid * 16 + i * 8192, R, C); const int Rb = Epi::PERM ? ((R & ~31) + perm32(R & 31)) : R;
        voffA[i] = (unsigned)(R * g.ld + C) * 2u; voffB[i] = (unsigned)(Rb * g.ld + C) * 2u; }
    const size_t kstep = (size_t)(BK * 2);
    const size_t hstep = (size_t)HALF * g.ld * 2;
    const size_t tstep = 2 * hstep;
    const unsigned ldsw = (unsigned)wid * 1024u;
    const int aoff = lds_byte(wr * 64 + fr, fq * 8), boff = lds_byte(wc * 32 + fr, fq * 8);
#define PG8_SA(b, h) (((b) * 2 + (h)) * HTB)
#define PG8_SB(b, h) ((4 + (b) * 2 + (h)) * HTB)
#define PG8_STAGE(bufoff, gbase, voff) do { _Pragma("unroll") for (int _i = 0; _i < 2; ++_i) \
        __builtin_amdgcn_global_load_lds((const unsigned*)((const char*)(gbase) + (voff)[_i]), (PG8_LAS unsigned*)(lds + (bufoff) + ldsw + _i * 8192), 16, 0, 0); } while (0)
#define PG8_LDA(dst, b, h) do { _Pragma("unroll") for (int m = 0; m < 4; ++m) _Pragma("unroll") for (int k = 0; k < 2; ++k) dst[m][k] = *(const PG8_LAS bf16x8*)(lds + PG8_SA(b, h) + aoff + m * 2048 + k * 1024); } while (0)
#define PG8_LDB(dst, b, h) do { _Pragma("unroll") for (int n = 0; n < 2; ++n) _Pragma("unroll") for (int k = 0; k < 2; ++k) dst[n][k] = *(const PG8_LAS bf16x8*)(lds + PG8_SB(b, h) + boff + n * 2048 + k * 1024); } while (0)
#define PG8_MMA(ai, bj, At, Bt) do { __builtin_amdgcn_s_setprio(1); _Pragma("unroll") for (int m = 0; m < 4; ++m) _Pragma("unroll") for (int n = 0; n < 2; ++n) _Pragma("unroll") for (int k = 0; k < 2; ++k) \
        acc[ai][bj][m][n] = __builtin_amdgcn_mfma_f32_16x16x32_bf16(Bt[n][k], At[m][k], acc[ai][bj][m][n], 0, 0, 0); __builtin_amdgcn_s_setprio(0); } while (0)
#define PG8_WAIT_V(n) asm volatile("s_waitcnt vmcnt(" #n ")" ::: "memory")
#define PG8_WAIT_L(n) asm volatile("s_waitcnt lgkmcnt(" #n ")" ::: "memory")
#define PG8_BAR __builtin_amdgcn_s_barrier()
#define PG8_SCHED __builtin_amdgcn_sched_barrier(0)
    Unit cur, nxt; int ui = 0;
    if (!S.next(0, cur)) return;
    f32x4 acc[2][2][4][2];
#pragma unroll
    for (int a = 0; a < 2; ++a)
#pragma unroll
        for (int b = 0; b < 2; ++b)
#pragma unroll
            for (int m = 0; m < 4; ++m)
#pragma unroll
                for (int n = 0; n < 2; ++n) acc[a][b][m][n] = (f32x4){0.f, 0.f, 0.f, 0.f};
    bf16x8 At[4][2], B0[2][2], B1[2][2];
    const char* cA = (const char*)g.A + (size_t)cur.pm * tstep + (size_t)cur.ks * K * 2; const char* cB = (const char*)g.Bt + (size_t)cur.pn * tstep + (size_t)cur.ks * K * 2;
    S.a_ready(cur);
    PG8_STAGE(PG8_SB(0, 0), cB, voffB); PG8_STAGE(PG8_SA(0, 0), cA, voffA); PG8_STAGE(PG8_SB(0, 1), cB + hstep, voffB); PG8_STAGE(PG8_SA(0, 1), cA + hstep, voffA);
    if (wr == 1) PG8_BAR;
    PG8_WAIT_V(4); PG8_BAR;
    PG8_STAGE(PG8_SB(1, 0), cB + kstep, voffB); PG8_STAGE(PG8_SA(1, 0), cA + kstep, voffA); PG8_STAGE(PG8_SB(1, 1), cB + hstep + kstep, voffB);
    PG8_WAIT_V(6); PG8_BAR;
    PG8_STAMP();
    for (;;) {
        const bool has_next = S.next(ui + 1, nxt);
        const char* nA = has_next ? (const char*)g.A + (size_t)nxt.pm * tstep + (size_t)nxt.ks * K * 2 : cA; const char* nB = has_next ? (const char*)g.Bt + (size_t)nxt.pn * tstep + (size_t)nxt.ks * K * 2 : cB;
        for (int t = 0; t < nt; t += 2) {
            const bool last = (t == nt - 2);
            const char* a1 = cA + (size_t)(t + 1) * kstep;
            const char* a2 = last ? nA : cA + (size_t)(t + 2) * kstep; const char* b2 = last ? nB : cB + (size_t)(t + 2) * kstep;
            const char* a3 = a2 + kstep; const char* b3 = b2 + kstep;
            if (last && has_next) S.a_ready(nxt);
            PG8_LDB(B0, 0, 0); PG8_SCHED; PG8_LDA(At, 0, 0); PG8_STAGE(PG8_SA(1, 1), a1 + hstep, voffA);
            PG8_WAIT_L(8); PG8_BAR; PG8_WAIT_L(0); PG8_MMA(0, 0, At, B0); PG8_BAR; PG8_SCHED;
            PG8_LDB(B1, 0, 1); PG8_STAGE(PG8_SB(0, 0), b2, voffB);
            PG8_BAR; PG8_WAIT_L(0); PG8_MMA(0, 1, At, B1); PG8_BAR;
            PG8_LDA(At, 0, 1); PG8_STAGE(PG8_SA(0, 0), a2, voffA);
            PG8_BAR; PG8_WAIT_L(0); PG8_MMA(1, 0, At, B0); PG8_BAR; PG8_SCHED;
            PG8_STAGE(PG8_SB(0, 1), b2 + hstep, voffB);
            PG8_WAIT_V(6); PG8_BAR; PG8_MMA(1, 1, At, B1); PG8_BAR;
            PG8_LDB(B0, 1, 0); PG8_SCHED; PG8_LDA(At, 1, 0); PG8_STAGE(PG8_SA(0, 1), a2 + hstep, voffA);
            PG8_WAIT_L(8); PG8_BAR; PG8_WAIT_L(0); PG8_MMA(0, 0, At, B0); PG8_BAR; PG8_SCHED;
            PG8_LDB(B1, 1, 1); PG8_STAGE(PG8_SB(1, 0), b3, voffB);
            PG8_BAR; PG8_WAIT_L(0); PG8_MMA(0, 1, At, B1); PG8_BAR;
            PG8_LDA(At, 1, 1); PG8_STAGE(PG8_SA(1, 0), a3, voffA);
            PG8_BAR; PG8_WAIT_L(0); PG8_MMA(1, 0, At, B0); PG8_BAR; PG8_SCHED;
            PG8_STAGE(PG8_SB(1, 1), b3 + hstep, voffB);
            PG8_WAIT_V(6); PG8_BAR; PG8_MMA(1, 1, At, B1); PG8_BAR;
        }
        PG8_STAMP();
        if constexpr (!Epi::AFTER_DRAIN) { E(acc, cur, wr, wc, fr, fq); S.done(cur); }
        PG8_STAMP();
        if (!has_next) break;
#pragma unroll
        for (int a = 0; a < 2; ++a)
#pragma unroll
            for (int b = 0; b < 2; ++b)
#pragma unroll
                for (int m = 0; m < 4; ++m)
#pragma unroll
                    for (int n = 0; n < 2; ++n) acc[a][b][m][n] = (f32x4){0.f, 0.f, 0.f, 0.f};
        cur = nxt; cA = nA; cB = nB; ++ui;
    }
    PG8_WAIT_V(0);
    if (wr == 0) PG8_BAR;
    PG8_BAR;
    if constexpr (Epi::AFTER_DRAIN) { E.fused(acc, cur, wr, wc, fr, fq, lds, wid, lane); S.done(cur); }
    PG8_STAMP();
    if (STAMP && wid == 0) { stamps[lane] = lane < nts ? (((unsigned long long)(unsigned)ts_hi << 32) | (unsigned)ts_lo) : 0ull;
        if (lane == 62) stamps[62] = rt_entry; if (lane == 63) stamps[63] = (unsigned long long)wall_clock64(); }
#undef PG8_STAMP
#undef PG8_SA
#undef PG8_SB
#undef PG8_STAGE
#undef PG8_LDA
#undef PG8_LDB
#undef PG8_MMA
#undef PG8_WAIT_V
#undef PG8_WAIT_L
#undef PG8_BAR
#undef PG8_SCHED
}
}

using pg8::bf16_t; using pg8::bf16x8; using pg8::f32x4; using pg8::u32x4;
#define LAS __attribute__((address_space(3)))
typedef unsigned u32x2 __attribute__((ext_vector_type(2)));
typedef short bf16x4 __attribute__((ext_vector_type(4)));

#define XB_TMO      128
#define XB_XCNT(j)  (256  + 64 * (j))
#define XB_XSUB(j)  (1280 + 64 * (j))
#define XB_XGEN(j)  (2304 + 64 * (j))
#define XB_TOP      3328
#define XB_TOPGEN   3392
#define XCD_BAR_WORDS 3456
#define XB_SPIN_CAP (1u << 18)

__device__ __forceinline__ unsigned xb_ld(unsigned* p)              { return __hip_atomic_load(p, __ATOMIC_RELAXED, __HIP_MEMORY_SCOPE_AGENT); }
__device__ __forceinline__ unsigned xb_add(unsigned* p, unsigned v) { return __hip_atomic_fetch_add(p, v, __ATOMIC_RELAXED, __HIP_MEMORY_SCOPE_AGENT); }
__device__ __forceinline__ unsigned xb_xcc_id() { return (unsigned)__builtin_amdgcn_s_getreg((3 << 11) | 20) & 0xFu; }
#define XB_SPIN(cond, bar) do { unsigned _sp = 0; while (cond) { __builtin_amdgcn_s_sleep(1); \
    if ((++_sp & 255u) == 0u) { if (xb_ld(&(bar)[XB_TMO])) break; if (_sp > XB_SPIN_CAP) { atomicAdd(&(bar)[XB_TMO], 1u); break; } } } } while (0)

struct XcdBarrier {
    unsigned* bar; unsigned x;
    volatile LAS unsigned* st;
};

__device__ __forceinline__ XcdBarrier xcd_barrier_post(unsigned* bar, volatile LAS unsigned* st) {
    XcdBarrier b; b.bar = bar; b.x = xb_xcc_id(); b.st = st;
    if (threadIdx.x == 0) (void)xb_add(&bar[XB_XCNT(b.x)], 1u);
    return b;
}
__device__ __forceinline__ void xcd_barrier_complete(unsigned* bar, unsigned x, unsigned& nloc, unsigned& nx) {
    const unsigned G = gridDim.x * gridDim.y * gridDim.z;
    unsigned sum, cnt, mine, sp = 0u;
    for (;;) {
        sum = 0u; cnt = 0u; mine = 0u;
#pragma unroll
        for (unsigned j = 0; j < 16; ++j) { const unsigned c = xb_ld(&bar[XB_XCNT(j)]); sum += c; cnt += (c > 0u) ? 1u : 0u; mine = (j == x) ? c : mine; }
        if (sum == G) break;
        __builtin_amdgcn_s_sleep(1);
        if ((++sp & 255u) == 0u) { if (xb_ld(&bar[XB_TMO])) break; if (sp > XB_SPIN_CAP) { atomicAdd(&bar[XB_TMO], 1u); break; } }
    }
    nloc = mine > 0u ? mine : 1u; nx = cnt > 0u ? cnt : 1u;
}

__device__ __forceinline__ void xcd_barrier(const XcdBarrier& b) {
    asm volatile("s_waitcnt vmcnt(0)" ::: "memory");
    __syncthreads();
    if (threadIdx.x == 0) {
        unsigned* bar = b.bar;
        __builtin_amdgcn_s_waitcnt(0);
        unsigned nloc = b.st[0], nx = b.st[1];
        if (nloc == 0u) { xcd_barrier_complete(bar, b.x, nloc, nx); b.st[0] = nloc; b.st[1] = nx; }
        const unsigned old = xb_add(&bar[XB_XSUB(b.x)], 1u);
        const unsigned gen = old / nloc;
        if (old + 1u == (gen + 1u) * nloc) {
            __builtin_amdgcn_fence(__ATOMIC_RELEASE, "agent");
            asm volatile("s_waitcnt vmcnt(0)" ::: "memory");
            const unsigned og = xb_add(&bar[XB_TOP], 1u);
            const unsigned tg = og / nx;
            if (og + 1u == (tg + 1u) * nx) xb_add(&bar[XB_TOPGEN], 1u);
            else XB_SPIN(xb_ld(&bar[XB_TOPGEN]) == tg, bar);
            __builtin_amdgcn_fence(__ATOMIC_ACQUIRE, "agent");
            xb_add(&bar[XB_XGEN(b.x)], 1u);
            asm volatile("s_waitcnt vmcnt(0)" ::: "memory");
        } else {
            XB_SPIN(xb_ld(&bar[XB_XGEN(b.x)]) == gen, bar);
            __builtin_amdgcn_fence(__ATOMIC_ACQUIRE, "agent");
            asm volatile("s_waitcnt vmcnt(0)" ::: "memory");
        }
    }
    __syncthreads();
}

constexpr int DM = 1024, ML = 16384, MC = 2048, MT = 18432, FH = 2816;
constexpr int LDS_BYTES = 152 * 1024 + 256;
constexpr int NPH = 42;

constexpr size_t WS_H    = 0;
constexpr size_t WS_A    = WS_H + (size_t)MT * DM * 4;
constexpr size_t WS_P    = WS_A + (size_t)MT * DM * 2;
constexpr size_t WS_WFI  = WS_P + (size_t)MT * 3072 * 2;
constexpr size_t WS_WFO  = WS_WFI + 4ull * 5632 * 1024 * 2;
constexpr size_t WS_WO   = WS_WFO + 4ull * 1024 * 2816 * 2;
constexpr size_t WS_WAB  = WS_WO + 4ull * 1024 * 1024 * 2;
constexpr size_t WS_WCD  = WS_WAB + 2ull * 3072 * 1024 * 2;
constexpr size_t WS_WGLU = WS_WCD + 2ull * 2304 * 1024 * 2;
constexpr size_t WS_WU   = WS_WGLU + 2ull * 512 * 512 * 2;
constexpr size_t WS_MOD  = WS_WU + 2ull * 1792 * 640 * 2;
constexpr size_t WS_ROPE = WS_MOD + 4ull * 9 * 6144 * 4;
constexpr size_t WS_S5A  = WS_ROPE + 64 * 16 * 2 * 4;
constexpr size_t WS_S5BB = WS_S5A + 2ull * 2 * 32 * 64 * 4 * 4;
constexpr size_t WS_S5CC = WS_S5BB + 2ull * 2 * 32 * 2 * 64 * 16 * 2;
constexpr size_t WS_LB   = WS_S5CC + 2ull * 2 * 32 * 4 * 16 * 32 * 2;
constexpr size_t WS_TAB  = WS_LB + 2 * 512 * 4;
constexpr size_t WS_SS   = (WS_TAB + 64 * 8 + 255) & ~(size_t)255;
constexpr size_t WS_BAR  = WS_SS + 8ull * MT * 4;
constexpr size_t WS_BIAS = WS_BAR + XCD_BAR_WORDS * 4;
constexpr size_t WS_X    = WS_BIAS + 4ull * 9 * 8704 * 4;
constexpr size_t WS_HB1  = WS_X;
constexpr size_t WS_OF   = WS_X;
constexpr size_t WS_OB   = WS_OF + (size_t)MT * 512 * 2;
constexpr size_t WS_Z    = WS_OB + (size_t)MT * 512 * 2;
constexpr size_t WS_E    = WS_Z + (size_t)MT * 512 * 2;
constexpr size_t WS_E63  = WS_E + 8ull * 2 * 36 * 32 * 128 * 4;
constexpr size_t WS_END_EVEN = WS_E63 + 2ull * 288 * 4 * 128 * 2;
constexpr size_t WS_Q1   = WS_A;
constexpr size_t WS_VT1  = WS_A + (size_t)MT * 512 * 2;
constexpr size_t WS_U    = WS_X;
constexpr size_t WS_END_ODD = WS_U + (size_t)MT * 1792 * 2;
constexpr size_t WS_NEED = WS_END_EVEN > WS_END_ODD ? WS_END_EVEN : WS_END_ODD;
static_assert(WS_NEED <= 402653184ull, "workspace too large");

struct Params { const float* in[34]; float* out; unsigned char* ws; int ph_lo, ph_hi; };
struct Ctx { unsigned char* ws; const float* const* in; float* out; };

__device__ __forceinline__ float bf2f(unsigned v) { return __uint_as_float(v << 16); }
__device__ __forceinline__ float bflo(unsigned w) { return __uint_as_float(w << 16); }
__device__ __forceinline__ float bfhi(unsigned w) { return __uint_as_float(w & 0xffff0000u); }
__device__ __forceinline__ unsigned pk2(float lo, float hi) { return pg8::cvt_pk_bf16(lo, hi); }
__device__ __forceinline__ bf16_t f2bf(float f) { unsigned u = __float_as_uint(f); u += 0x7FFFu + ((u >> 16) & 1u); return (bf16_t)(u >> 16); }
__device__ __forceinline__ float wsum(float v) {
#pragma unroll
    for (int o = 32; o >= 1; o >>= 1) v += __shfl_xor(v, o);
    return v; }
__device__ __forceinline__ float rcpf_(float x) { return __builtin_amdgcn_rcpf(x); }
__device__ __forceinline__ float siluf(float x) { return x * rcpf_(1.0f + __expf(-x)); }
__device__ __forceinline__ bf16x8 mk8(unsigned a, unsigned b, unsigned c, unsigned d) { u32x4 w = {a, b, c, d}; return __builtin_bit_cast(bf16x8, w); }
__device__ __forceinline__ bf16x8 zero8() { return mk8(0u, 0u, 0u, 0u); }
#define MFMA(a, b, c) __builtin_amdgcn_mfma_f32_16x16x32_bf16((a), (b), (c), 0, 0, 0)

__device__ __forceinline__ double dexp(double x) {
    const double y = x * (1.0 / 64.0); double s = 1.0, t = 1.0;
#pragma unroll
    for (int i = 1; i <= 13; ++i) { t *= y * (1.0 / (double)i); s += t; }
#pragma unroll
    for (int i = 0; i < 6; ++i) s *= s;
    return s; }
__device__ __forceinline__ void dsincos(double x, double& sn, double& cs) {
    const double TWO_PI = 6.283185307179586476925287; const double k = rint(x * (1.0 / TWO_PI)); const double r = (x - k * TWO_PI) * 0.125;
    const double r2 = r * r; double s = r, t = r, c = 1.0, u = 1.0;
#pragma unroll
    for (int i = 1; i <= 7; ++i) { t *= -r2 * (1.0 / (double)((2 * i) * (2 * i + 1))); s += t; u *= -r2 * (1.0 / (double)((2 * i - 1) * (2 * i))); c += u; }
#pragma unroll
    for (int i = 0; i < 3; ++i) { const double s2 = 2.0 * s * c, c2 = c * c - s * s; s = s2; c = c2; }
    sn = s; cs = c; }

struct EpiRes {
    static constexpr bool PERM = false, AFTER_DRAIN = false;
    float* H; const float* gate; float* out;
    bf16_t* Hb; const float* gn; const float* scn; float* ss;
    __device__ __forceinline__ void operator()(const f32x4 (&acc)[2][2][4][2], const pg8::Unit& u, int wr, int wc, int fr, int fq) const {
        const int r = u.pm < 64 ? (u.pm >> 3) : 8;
        const int row0 = u.pm * 256 + wr * 64 + fr, col0 = u.pn * 256 + wc * 32 + 4 * fq;
        const float* gp = gate + r * 6144 + col0;
        f32x4 gv[2][2], gs[2][2];
#pragma unroll
        for (int bj = 0; bj < 2; ++bj)
#pragma unroll
            for (int n = 0; n < 2; ++n) { const int co = bj * 128 + n * 16; gv[bj][n] = *(const f32x4*)(gp + co); gs[bj][n] = (f32x4){0.f, 0.f, 0.f, 0.f};
                if (Hb != nullptr) gs[bj][n] = *(const f32x4*)(gn + col0 + co) * (*(const f32x4*)(scn + r * 6144 + col0 + co) + 1.0f); }
#pragma unroll
        for (int am = 0; am < 4; ++am) { const int ai = am >> 1, m0 = (am & 1) * 2;
            f32x4 hv[2][2][2];
#pragma unroll
            for (int mm = 0; mm < 2; ++mm)
#pragma unroll
                for (int bj = 0; bj < 2; ++bj)
#pragma unroll
                    for (int n = 0; n < 2; ++n) hv[mm][bj][n] = *(const f32x4*)(H + (size_t)(row0 + ai * 128 + (m0 + mm) * 16) * 1024 + col0 + bj * 128 + n * 16);
            asm volatile("" ::: "memory");
#pragma unroll
            for (int mm = 0; mm < 2; ++mm) { const int m = m0 + mm; const int row = row0 + ai * 128 + m * 16; float sq = 0.f;
#pragma unroll
                for (int bj = 0; bj < 2; ++bj)
#pragma unroll
                    for (int n = 0; n < 2; ++n) { const size_t off = (size_t)row * 1024 + col0 + bj * 128 + n * 16;
                        const f32x4 v = hv[mm][bj][n] + gv[bj][n] * acc[ai][bj][m][n];
                        if (out == nullptr) *(f32x4*)(H + off) = v; else if (u.pm < 64) *(f32x4*)(out + off) = v;
                        if (Hb != nullptr) { sq += v[0] * v[0] + v[1] * v[1] + v[2] * v[2] + v[3] * v[3]; const f32x4 hb = v * gs[bj][n];
                            u32x2 w; w.x = pk2(hb[0], hb[1]); w.y = pk2(hb[2], hb[3]); *(u32x2*)(Hb + off) = w; } }
                if (Hb != nullptr) { sq += __shfl_xor(sq, 16); sq += __shfl_xor(sq, 32); if (fq == 0) (void)__hip_atomic_fetch_add(ss + row, sq, __ATOMIC_RELAXED, __HIP_MEMORY_SCOPE_AGENT); } }
            asm volatile("" ::: "memory");
        }
    }
};
template <bool NORM> struct EpiStore {
    static constexpr bool PERM = true, AFTER_DRAIN = false;
    bf16_t* O; int ldc; const float* ss; const float* bias;
    __device__ __forceinline__ void operator()(const f32x4 (&acc)[2][2][4][2], const pg8::Unit& u, int wr, int wc, int fr, int fq) const {
        const int row0 = u.pm * 256 + wr * 64 + fr, col0 = u.pn * 256 + wc * 32 + 8 * fq;
        const int r = u.pm < 64 ? (u.pm >> 3) : 8;
        f32x4 bv[2][2];
#pragma unroll
        for (int bj = 0; bj < 2; ++bj)
#pragma unroll
            for (int n = 0; n < 2; ++n) bv[bj][n] = NORM ? *(const f32x4*)(bias + r * 8704 + col0 + bj * 128 + 4 * n) : (f32x4){0.f, 0.f, 0.f, 0.f};
        float rsv[2][4];
#pragma unroll
        for (int ai = 0; ai < 2; ++ai)
#pragma unroll
            for (int m = 0; m < 4; ++m) rsv[ai][m] = NORM ? ss[row0 + ai * 128 + m * 16] : 1.0f;
        asm volatile("" ::: "memory");
#pragma unroll
        for (int ai = 0; ai < 2; ++ai)
#pragma unroll
            for (int m = 0; m < 4; ++m) { const int row = row0 + ai * 128 + m * 16; bf16_t* rowp = O + (size_t)row * ldc + col0;
                const float rs = NORM ? rsqrtf(rsv[ai][m] * (1.0f / 1024.0f) + 1e-6f) : 1.0f;
#pragma unroll
                for (int bj = 0; bj < 2; ++bj) { const f32x4 v0 = acc[ai][bj][m][0] * rs + bv[bj][0], v1 = acc[ai][bj][m][1] * rs + bv[bj][1];
                    u32x4 w; w.x = pk2(v0[0], v0[1]); w.y = pk2(v0[2], v0[3]); w.z = pk2(v1[0], v1[1]); w.w = pk2(v1[2], v1[3]);
                    *(u32x4*)(rowp + bj * 128) = w; } }
    }
};
struct EpiSwiGLU {
    static constexpr bool PERM = true, AFTER_DRAIN = false;
    bf16_t* G; const float* ss; const float* bias;
    __device__ __forceinline__ void operator()(const f32x4 (&acc)[2][2][4][2], const pg8::Unit& u, int wr, int wc, int fr, int fq) const {
        const int row0 = u.pm * 256 + wr * 64 + fr, col0 = u.pn * 128 + wc * 32 + 8 * fq;
        const int r = u.pm < 64 ? (u.pm >> 3) : 8;
        const float* bp = bias + r * 8704 + u.pn * 256 + wc * 32 + 8 * fq;
        const f32x4 bg0 = *(const f32x4*)bp, bg1 = *(const f32x4*)(bp + 4), bu0 = *(const f32x4*)(bp + 128), bu1 = *(const f32x4*)(bp + 132);
        float rsv[2][4];
#pragma unroll
        for (int ai = 0; ai < 2; ++ai)
#pragma unroll
            for (int m = 0; m < 4; ++m) rsv[ai][m] = ss[row0 + ai * 128 + m * 16];
        asm volatile("" ::: "memory");
#pragma unroll
        for (int ai = 0; ai < 2; ++ai)
#pragma unroll
            for (int m = 0; m < 4; ++m) { const int row = row0 + ai * 128 + m * 16; bf16_t* rowp = G + (size_t)row * FH + col0;
                const float rs = rsqrtf(rsv[ai][m] * (1.0f / 1024.0f) + 1e-6f);
                const f32x4 g0 = acc[ai][0][m][0] * rs + bg0, g1 = acc[ai][0][m][1] * rs + bg1, u0 = acc[ai][1][m][0] * rs + bu0, u1 = acc[ai][1][m][1] * rs + bu1;
                u32x4 w; w.x = pk2(siluf(g0[0]) * u0[0], siluf(g0[1]) * u0[1]); w.y = pk2(siluf(g0[2]) * u0[2], siluf(g0[3]) * u0[3]);
                w.z = pk2(siluf(g1[0]) * u1[0], siluf(g1[1]) * u1[1]); w.w = pk2(siluf(g1[2]) * u1[2], siluf(g1[3]) * u1[3]);
                *(u32x4*)rowp = w; }
    }
};
struct EpiGLU {
    static constexpr bool PERM = true, AFTER_DRAIN = false;
    bf16_t* MX; const bf16_t* Z; const float* bias;
    __device__ __forceinline__ void operator()(const f32x4 (&acc)[2][2][4][2], const pg8::Unit& u, int wr, int wc, int fr, int fq) const {
        const int row0 = u.pm * 256 + wr * 64 + fr, col0 = u.pn * 256 + wc * 32 + 8 * fq;
        f32x4 b0[2], b1[2];
#pragma unroll
        for (int bj = 0; bj < 2; ++bj) { b0[bj] = *(const f32x4*)(bias + col0 + bj * 128); b1[bj] = *(const f32x4*)(bias + col0 + bj * 128 + 4); }
#pragma unroll
        for (int ai = 0; ai < 2; ++ai) {
            u32x4 zz[4][2];
#pragma unroll
            for (int m = 0; m < 4; ++m)
#pragma unroll
                for (int bj = 0; bj < 2; ++bj) zz[m][bj] = *(const u32x4*)(Z + (size_t)(row0 + ai * 128 + m * 16) * 512 + col0 + bj * 128);
            asm volatile("" ::: "memory");
#pragma unroll
            for (int m = 0; m < 4; ++m) { const int row = row0 + ai * 128 + m * 16;
#pragma unroll
                for (int bj = 0; bj < 2; ++bj) { const int col = col0 + bj * 128; const u32x4 z = zz[m][bj];
                    const f32x4 v0 = acc[ai][bj][m][0] + b0[bj], v1 = acc[ai][bj][m][1] + b1[bj];
                    u32x4 w;
                    w.x = pk2(bflo(z.x) * rcpf_(1.f + __expf(-v0[0])), bfhi(z.x) * rcpf_(1.f + __expf(-v0[1])));
                    w.y = pk2(bflo(z.y) * rcpf_(1.f + __expf(-v0[2])), bfhi(z.y) * rcpf_(1.f + __expf(-v0[3])));
                    w.z = pk2(bflo(z.z) * rcpf_(1.f + __expf(-v1[0])), bfhi(z.z) * rcpf_(1.f + __expf(-v1[1])));
                    w.w = pk2(bflo(z.w) * rcpf_(1.f + __expf(-v1[2])), bfhi(z.w) * rcpf_(1.f + __expf(-v1[3])));
                    *(u32x4*)(MX + (size_t)row * 1024 + col) = w; } }
            asm volatile("" ::: "memory");
        }
    }
};

template <class Epi> __device__ __forceinline__ void run_gemm(LAS unsigned char* lds, const bf16_t* A, const bf16_t* Bt, int M, int N, int K, const Epi& E) {
    pg8::Gemm g; g.A = A; g.Bt = Bt; g.M = M; g.N = N; g.K = K; g.ld = K;
    pg8::StaticOrder S; S.init(M, N, (int)gridDim.x, (int)blockIdx.x);
    pg8::gemm_phase<Epi, pg8::StaticOrder, false>(lds, g, S, E, nullptr);
}

struct EpiResAtomic {
    static constexpr bool PERM = false, AFTER_DRAIN = false;
    float* H; const float* gate;
    __device__ __forceinline__ void operator()(const f32x4 (&acc)[2][2][4][2], const pg8::Unit& u, int wr, int wc, int fr, int fq) const {
        const int r = u.pm < 64 ? (u.pm >> 3) : 8;
        const int row0 = u.pm * 256 + wr * 64 + fr, col0 = u.pn * 256 + wc * 32 + 4 * fq;
        const float* gp = gate + r * 6144 + col0;
        f32x4 gv[2][2];
#pragma unroll
        for (int bj = 0; bj < 2; ++bj)
#pragma unroll
            for (int n = 0; n < 2; ++n) gv[bj][n] = *(const f32x4*)(gp + bj * 128 + n * 16);
#pragma unroll
        for (int ai = 0; ai < 2; ++ai)
#pragma unroll
            for (int m = 0; m < 4; ++m) { const size_t off = (size_t)(row0 + ai * 128 + m * 16) * 1024 + col0;
#pragma unroll
                for (int bj = 0; bj < 2; ++bj)
#pragma unroll
                    for (int n = 0; n < 2; ++n) { float* pp = H + off + bj * 128 + n * 16; const f32x4 v = gv[bj][n] * acc[ai][bj][m][n];
#pragma unroll
                        for (int q = 0; q < 4; ++q) (void)__hip_atomic_fetch_add(pp + q, v[q], __ATOMIC_RELAXED, __HIP_MEMORY_SCOPE_AGENT); } }
    }
};
template <class Epi> __device__ __forceinline__ void run_gemm_slices(LAS unsigned char* lds, const bf16_t* A, const bf16_t* Bt, int Kfull, int nsplit, const Epi& E) {
    pg8::Gemm g; g.A = A; g.Bt = Bt; g.M = MT; g.N = 1024; g.K = Kfull / nsplit; g.ld = Kfull;
    pg8::SliceOrder S; S.init(64, 8, 1024, nsplit, (int)gridDim.x, (int)blockIdx.x);
    pg8::gemm_phase<Epi, pg8::SliceOrder, false>(lds, g, S, E, nullptr);
}

__device__ __forceinline__ void tr_job(const float* __restrict__ src, bf16_t* __restrict__ dst, int ldd, int K, int N, int mode, int& rot, LAS float* tile) {
    const int tid = mk_tid(), nb = gridDim.x, tn = (N + 255) / 256, nt = (K / 64) * tn;
    const int start = (int)((blockIdx.x + nb - (rot % nb)) % nb); rot += nt;
    const int c4 = (tid & 15) * 4, r0 = tid >> 4;
    float4 v[8], vn[8];
    auto ld = [&](int t, float4 (&x)[8]) { const int k0 = (t / tn) * 64, n0 = (t % tn) * 256;
#pragma unroll
        for (int i = 0; i < 2; ++i)
#pragma unroll
            for (int j = 0; j < 4; ++j) { const int nn = n0 + c4 + 64 * j; x[i * 4 + j] = nn < N ? *(const float4*)(src + (size_t)(k0 + r0 + 32 * i) * N + nn) : (float4){0.f, 0.f, 0.f, 0.f}; } };
#pragma unroll
    for (int q = 0; q < 8; ++q) { v[q] = (float4){0.f, 0.f, 0.f, 0.f}; vn[q] = (float4){0.f, 0.f, 0.f, 0.f}; }
    if (start < nt) ld(start, v);
    if (start + nb < nt) ld(start + nb, vn);
    for (int t = start; t < nt; t += nb) {
        const int k0 = (t / tn) * 64, n0 = (t % tn) * 256;
#pragma unroll
        for (int i = 0; i < 2; ++i)
#pragma unroll
            for (int j = 0; j < 4; ++j) { LAS float* tp = tile + (r0 + 32 * i) * 257 + c4 + 64 * j; tp[0] = v[i * 4 + j].x; tp[1] = v[i * 4 + j].y; tp[2] = v[i * 4 + j].z; tp[3] = v[i * 4 + j].w; }
        __syncthreads();
#pragma unroll
        for (int q = 0; q < 8; ++q) v[q] = vn[q];
        if (t + 2 * nb < nt) ld(t + 2 * nb, vn);
        { const int n = tid >> 1, kh = (tid & 1) * 32; const int nn = n0 + n;
          if (nn < N) {
              const int drow = mode == 0 ? nn : (nn < FH ? (nn / 128) * 256 + (nn % 128) : ((nn - FH) / 128) * 256 + 128 + ((nn - FH) % 128));
#pragma unroll
              for (int q = 0; q < 4; ++q) { const int k8 = kh + q * 8;
                  u32x4 w; w.x = pk2(tile[(k8 + 0) * 257 + n], tile[(k8 + 1) * 257 + n]); w.y = pk2(tile[(k8 + 2) * 257 + n], tile[(k8 + 3) * 257 + n]);
                  w.z = pk2(tile[(k8 + 4) * 257 + n], tile[(k8 + 5) * 257 + n]); w.w = pk2(tile[(k8 + 6) * 257 + n], tile[(k8 + 7) * 257 + n]);
                  *(u32x4*)(dst + (size_t)drow * ldd + k0 + k8) = w; } } }
        __syncthreads();
    }
}

__device__ __forceinline__ void prep_phase(const Ctx& p, LAS unsigned char* lds, int part) {
    const int tid = mk_tid(), nb = gridDim.x, bid = blockIdx.x;
    unsigned char* ws = p.ws;
    if (part != 2) { LAS float* tile = (LAS float*)lds; int rot = 0;
      for (int l = 0; l < 4; ++l) {
          tr_job(p.in[9] + (size_t)l * 1024 * 5632, (bf16_t*)(ws + WS_WFI) + (size_t)l * 5632 * 1024, 1024, 1024, 5632, 1, rot, tile);
          tr_job(p.in[10] + (size_t)l * 2816 * 1024, (bf16_t*)(ws + WS_WFO) + (size_t)l * 1024 * 2816, 2816, 2816, 1024, 0, rot, tile);
          tr_job(p.in[8] + (size_t)l * 1024 * 1024, (bf16_t*)(ws + WS_WO) + (size_t)l * 1024 * 1024, 1024, 1024, 1024, 0, rot, tile); }
      for (int e = 0; e < 2; ++e) {
          tr_job(p.in[11] + (size_t)e * 1024 * 3072, (bf16_t*)(ws + WS_WAB) + (size_t)e * 3072 * 1024, 1024, 1024, 3072, 0, rot, tile);
          tr_job(p.in[20] + (size_t)e * 512 * 512, (bf16_t*)(ws + WS_WGLU) + (size_t)e * 512 * 512, 512, 512, 512, 0, rot, tile);
          tr_job(p.in[24] + (size_t)e * 1024 * 2240, (bf16_t*)(ws + WS_WCD) + (size_t)e * 2304 * 1024, 1024, 1024, 2240, 0, rot, tile);
          tr_job(p.in[30] + (size_t)e * 384 * 768, (bf16_t*)(ws + WS_WU) + (size_t)e * 1792 * 640, 640, 384, 768, 0, rot, tile);
          tr_job(p.in[31] + (size_t)e * 256 * 1024, (bf16_t*)(ws + WS_WU) + (size_t)e * 1792 * 640 + 768 * 640 + 384, 640, 256, 1024, 0, rot, tile); } }
    if (part == 1) return;
    if (part != 3) {
        LAS float* red = (LAS float*)lds;
        LAS float* sc = (LAS float*)(lds + 73728);
        __syncthreads();
        for (int i = tid; i < 9 * 1024; i += 512) { const int r = i >> 10, k = i & 1023; const float v = r < 8 ? p.in[1][r * 1024 + k] : p.in[3][k]; sc[i] = siluf(v); }
        __syncthreads();
        for (int u = bid; u < 192; u += nb) {
            const int l = u / 48, n0 = (u % 48) * 128, cg4 = (tid & 31) * 4, ks = tid >> 5;
            const float* w = p.in[4] + (size_t)l * 1024 * 6144 + n0 + cg4;
            f32x4 a[9];
#pragma unroll
            for (int r = 0; r < 9; ++r) a[r] = (f32x4){0.f, 0.f, 0.f, 0.f};
#pragma unroll 1
            for (int k0 = ks * 64; k0 < ks * 64 + 64; k0 += 16) {
                f32x4 wv[16];
#pragma unroll
                for (int j = 0; j < 16; ++j) wv[j] = *(const f32x4*)(w + (size_t)(k0 + j) * 6144);
#pragma unroll
                for (int j = 0; j < 16; ++j)
#pragma unroll
                    for (int r = 0; r < 9; ++r) a[r] += wv[j] * sc[r * 1024 + k0 + j];
            }
#pragma unroll
            for (int r = 0; r < 9; ++r) *(LAS f32x4*)(red + (ks * 9 + r) * 128 + cg4) = a[r];
            __syncthreads();
            for (int i = tid; i < 9 * 128; i += 512) { const int r = i >> 7, c = i & 127; float v = p.in[5][l * 6144 + n0 + c];
#pragma unroll
                for (int q = 0; q < 16; ++q) v += red[(q * 9 + r) * 128 + c];
                ((float*)(ws + WS_MOD))[((size_t)l * 9 + r) * 6144 + n0 + c] = v; }
            __syncthreads();
        }
    }
    const int gt = bid * 512 + tid, gs = nb * 512;
    for (int i = gt; i < 2 * 73728; i += gs) {
        const int o = i / 73728, r = i % 73728; bf16_t* wb = (bf16_t*)(ws + WS_WU) + (size_t)o * 1792 * 640; u32x4 zz = {0u, 0u, 0u, 0u};
        if (r < 768 * 32) *(u32x4*)(wb + (size_t)(r >> 5) * 640 + 384 + (r & 31) * 8) = zz;
        else { const int r2 = r - 768 * 32; *(u32x4*)(wb + (size_t)(768 + r2 / 48) * 640 + (r2 % 48) * 8) = zz; } }
    for (int i = gt; i < 1024; i += gs) {
        const int pos = i >> 4, f = i & 15; const double inv = dexp(-(double)f * (9.210340371976182736 / 16.0)); double sn, cs; dsincos((double)pos * inv, sn, cs);
        ((float*)(ws + WS_ROPE))[i * 2] = (float)cs; ((float*)(ws + WS_ROPE))[i * 2 + 1] = (float)sn; }
    for (int i = gt; i < 1024; i += gs) {
        const int e = i >> 9, j = i & 511; float v = 0.f;
        if (e == 1) v = 1.0f / (1.0f + expf(p.in[22][j] - p.in[22][512 + j]));
        ((float*)(ws + WS_LB))[i] = v; }
    for (int i = gt; i < 2 * 2 * 32 * 64; i += gs) {
        const int pp = i & 63, idx = i >> 6;
        const double lr = (double)fminf(p.in[12][i], -1e-4f), li = (double)p.in[13][i], step = dexp((double)p.in[14][idx]);
        const double mag = dexp(lr * step); double sn, cs; dsincos(li * step, sn, cs);
        const double ar = mag * cs, ai = mag * sn, iden = 1.0 / (lr * lr + li * li);
        const double cr = ((ar - 1.0) * lr + ai * li) * iden, ci = (ai * lr - (ar - 1.0) * li) * iden;
        double pr = ar, pi = ai;
#pragma unroll
        for (int s = 0; s < 5; ++s) { const double nr = pr * pr - pi * pi, ni = 2.0 * pr * pi; pr = nr; pi = ni; }
        float4 o; o.x = (float)ar; o.y = (float)ai; o.z = (float)pr; o.w = (float)pi; ((float4*)(ws + WS_S5A))[i] = o;
        bf16_t* bbr = (bf16_t*)(ws + WS_S5BB) + ((size_t)idx * 2 + 0) * 1024 + pp * 16; bf16_t* bbi = bbr + 1024;
        const float* bre = p.in[15] + (size_t)i * 16; const float* bim = p.in[16] + (size_t)i * 16;
#pragma unroll
        for (int c = 0; c < 16; ++c) { const double br = bre[c], bi = bim[c]; bbr[c] = f2bf((float)(cr * br - ci * bi)); bbi[c] = f2bf((float)(cr * bi + ci * br)); } }
    for (int i = gt; i < 2 * 2 * 32 * 4 * 16 * 32; i += gs) {
        const int slot = i & 31, c = (i >> 5) & 15, kk = (i >> 9) & 3, idx = i >> 11;
        const int quad = slot >> 3, j8 = slot & 7, st = 16 * (2 * (kk & 1) + (j8 >> 2)) + quad * 4 + (j8 & 3);
        const float v = kk < 2 ? p.in[17][((size_t)idx * 16 + c) * 64 + st] : -p.in[18][((size_t)idx * 16 + c) * 64 + st];
        ((bf16_t*)(ws + WS_S5CC))[i] = f2bf(v); }
}

__device__ __forceinline__ void prep2_phase(const Ctx& p, LAS unsigned char* lds) {
    const int tid = mk_tid(), lane = tid & 63, w = tid >> 6, nb = gridDim.x, bid = blockIdx.x;
    unsigned char* ws = p.ws;
    LAS float* sh = (LAS float*)lds;
    {
        const int job = bid & 7, l = job >> 1, kind = job & 1;
        const int grp = bid >> 3, ngrp = (nb + 7 - job) >> 3;
        const float* mod = (const float*)(ws + WS_MOD) + (size_t)l * 9 * 6144 + (kind ? 3 : 0) * 1024;
        for (int i = tid; i < 9 * 1024; i += 512) sh[i] = mod[(i >> 10) * 6144 + (i & 1023)];
        __syncthreads();
        const bf16_t* W; int nrows;
        if (kind) { W = (const bf16_t*)(ws + WS_WFI) + (size_t)l * 5632 * 1024; nrows = 5632; }
        else if (l & 1) { W = (const bf16_t*)(ws + WS_WCD) + (size_t)(l >> 1) * 2304 * 1024; nrows = 2304; }
        else { W = (const bf16_t*)(ws + WS_WAB) + (size_t)(l >> 1) * 3072 * 1024; nrows = 3072; }
        float* bo = (float*)(ws + WS_BIAS) + (size_t)l * 9 * 8704 + (kind ? 3072 : 0);
        const int rstride = ngrp * 8;
        for (int rowq = grp * 8 + w; rowq < nrows; rowq += rstride * 4) {
          u32x2 wq[4][4];
#pragma unroll
          for (int q4 = 0; q4 < 4; ++q4) { const int rr = rowq + q4 * rstride < nrows ? rowq + q4 * rstride : rowq;
#pragma unroll
              for (int q = 0; q < 4; ++q) wq[q4][q] = *(const u32x2*)(W + (size_t)rr * 1024 + 256 * q + lane * 4); }
#pragma unroll
          for (int q4 = 0; q4 < 4; ++q4) { const int row = rowq + q4 * rstride; if (row >= nrows) break;
            float wv[16];
#pragma unroll
            for (int q = 0; q < 4; ++q) { wv[4 * q] = bflo(wq[q4][q].x); wv[4 * q + 1] = bfhi(wq[q4][q].x); wv[4 * q + 2] = bflo(wq[q4][q].y); wv[4 * q + 3] = bfhi(wq[q4][q].y); }
#pragma unroll
            for (int r = 0; r < 9; ++r) { float a = 0.f;
#pragma unroll
                for (int q = 0; q < 4; ++q) { const f32x4 s4 = *(const LAS f32x4*)(sh + r * 1024 + 256 * q + lane * 4); a += s4[0] * wv[4 * q] + s4[1] * wv[4 * q + 1] + s4[2] * wv[4 * q + 2] + s4[3] * wv[4 * q + 3]; }
                a = wsum(a); if (lane == 0) bo[r * 8704 + row] = a; }
          }
        }
    }
    { const int wg = bid * 8 + w, nw = nb * 8; float* H = (float*)(ws + WS_H); bf16_t* A = (bf16_t*)(ws + WS_A); float* ss = (float*)(ws + WS_SS);
      const float* gw = p.in[6]; const float* mod0 = (const float*)(ws + WS_MOD);
      float4 g[4];
#pragma unroll
      for (int i = 0; i < 4; ++i) g[i] = *(const float4*)(gw + 4 * (lane + 64 * i));
      for (int row = wg; row < MT; row += nw) {
          const float4* src = row < ML ? (const float4*)(p.in[0] + (size_t)row * 1024) : (const float4*)(p.in[2] + (size_t)(row - ML) * 1024);
          float4* dst = (float4*)(H + (size_t)row * 1024); const int r = row < ML ? (row >> 11) : 8; const float* sc = mod0 + r * 6144 + 1024;
          float4 h[4], c4[4]; float sq = 0.f;
#pragma unroll
          for (int i = 0; i < 4; ++i) { h[i] = src[lane + 64 * i]; c4[i] = *(const float4*)(sc + 4 * (lane + 64 * i)); }
#pragma unroll
          for (int i = 0; i < 4; ++i) sq += h[i].x * h[i].x + h[i].y * h[i].y + h[i].z * h[i].z + h[i].w * h[i].w;
          sq = wsum(sq); if (lane == 0) ss[row] = sq;
#pragma unroll
          for (int i = 0; i < 4; ++i) { const int c = 4 * (lane + 64 * i); dst[lane + 64 * i] = h[i];
              u32x2 wv2; wv2.x = pk2(h[i].x * g[i].x * (1.f + c4[i].x), h[i].y * g[i].y * (1.f + c4[i].y)); wv2.y = pk2(h[i].z * g[i].z * (1.f + c4[i].z), h[i].w * g[i].w * (1.f + c4[i].w));
              *(u32x2*)(A + (size_t)row * 1024 + c) = wv2; }
      } }
}

template <int pass> __device__ __forceinline__ void s5_unit(const Ctx& p, int e, int g, int sg, LAS unsigned char* lds) {
    const int tid = mk_tid(), lane = tid & 63, n = lane & 15, quad = lane >> 4;
    LAS bf16x8* ops = (LAS bf16x8*)lds + tid;
    const int seq = sg * 16 + n, b = seq / 72, tc = seq % 72;
    const int rowbase = tc < 8 ? ML + b * 256 + tc * 32 : b * 2048 + (tc - 8) * 32;
    const bf16_t* P = (const bf16_t*)(p.ws + WS_P); bf16_t* Z = (bf16_t*)(p.ws + WS_Z); float* E = p.out;
    const f32x4 dsk = *(const f32x4*)(p.in[19] + e * 512 + g * 16 + quad * 4);
    const f32x4 z4 = {0.f, 0.f, 0.f, 0.f};
    const int srcl = n + 16 * (quad >> 1);
#pragma unroll 1
    for (int dir = 0; dir < 2; ++dir) {
        const int idx = (e * 2 + dir) * 32 + g;
        const float4* A4 = (const float4*)(p.ws + WS_S5A) + (size_t)idx * 64;
        const bf16_t* BB = (const bf16_t*)(p.ws + WS_S5BB) + (size_t)idx * 2048;
        const bf16_t* CC = (const bf16_t*)(p.ws + WS_S5CC) + (size_t)idx * 2048;
        float ar[4][4], ai[4][4], hr[4][4], hi[4][4];
#pragma unroll
        for (int pt = 0; pt < 4; ++pt) {
            ops[pt * 512] = quad < 2 ? *(const bf16x8*)(BB + (16 * pt + n) * 16 + quad * 8) : zero8();
            ops[(4 + pt) * 512] = quad < 2 ? *(const bf16x8*)(BB + 1024 + (16 * pt + n) * 16 + quad * 8) : zero8();
            ops[(8 + pt) * 512] = *(const bf16x8*)(CC + (pt * 16 + n) * 32 + quad * 8); }
        const int pc = dir == 0 ? tc : (tc < 8 ? 7 - tc : 79 - tc);
        float* Eb = E + ((size_t)((b * 2 + dir) * 72 + pc) * 32 + g) * 128;
#pragma unroll
        for (int pt = 0; pt < 4; ++pt) {
            float4 e0 = {0.f, 0.f, 0.f, 0.f}, e1 = {0.f, 0.f, 0.f, 0.f};
            if (pass == 2) { const float4* ep = (const float4*)(Eb + (16 * pt + quad * 4) * 2); e0 = ep[0]; e1 = ep[1]; }
            hr[pt][0] = e0.x; hi[pt][0] = e0.y; hr[pt][1] = e0.z; hi[pt][1] = e0.w; hr[pt][2] = e1.x; hi[pt][2] = e1.y; hr[pt][3] = e1.z; hi[pt][3] = e1.w;
#pragma unroll
            for (int j = 0; j < 4; ++j) { const float4 a = A4[16 * pt + quad * 4 + j]; ar[pt][j] = a.x; ai[pt][j] = a.y; } }
        const char* Pg = (const char*)(P + g * 16); char* Zg = (char*)(Z + g * 16);
        const unsigned uoff0 = (unsigned)(rowbase * 3072 + (quad & 1) * 8) * 2u, zoff0 = (unsigned)(rowbase * 512 + quad * 4) * 2u;
        const char* Zr = dir ? (const char*)Zg : Pg;
        bf16x8 ub[8]; u32x2 yfb[8];
#pragma unroll
        for (int j = 0; j < 8; ++j) { const int tt = dir ? 31 - j : j; ub[j] = *(const bf16x8*)(Pg + (uoff0 + (unsigned)tt * 6144u));
            yfb[j] = (u32x2){0u, 0u}; if (pass == 2) yfb[j] = *(const u32x2*)(Zr + (zoff0 + (unsigned)tt * 1024u)); }
#pragma unroll 1
        for (int t8 = 0; t8 < 4; ++t8) {
#pragma unroll
            for (int j = 0; j < 8; ++j) {
                const int t = t8 * 8 + j, tt = dir ? 31 - t : t;
                const bf16x8 uc = ub[j]; const u32x2 yf = yfb[j];
                { const int t2 = t + 8 < 31 ? t + 8 : 31; const int tt2 = dir ? 31 - t2 : t2; ub[j] = *(const bf16x8*)(Pg + (uoff0 + (unsigned)tt2 * 6144u));
                    if (pass == 2) yfb[j] = *(const u32x2*)(Zr + (zoff0 + (unsigned)tt2 * 1024u)); }
#pragma unroll
                for (int pt = 0; pt < 4; ++pt) { const bf16x8 oa = ops[pt * 512], ob = ops[(4 + pt) * 512]; const f32x4 br = MFMA(oa, uc, z4), bi = MFMA(ob, uc, z4);
#pragma unroll
                    for (int jj = 0; jj < 4; ++jj) { const float nr = ar[pt][jj] * hr[pt][jj] - ai[pt][jj] * hi[pt][jj] + br[jj], ni = ar[pt][jj] * hi[pt][jj] + ai[pt][jj] * hr[pt][jj] + bi[jj]; hr[pt][jj] = nr; hi[pt][jj] = ni; }
                    if (pt & 1) asm volatile("" ::: "memory"); }
                if (pass == 2) {
                    f32x4 y = z4, y2 = z4;
#pragma unroll
                    for (int kk = 0; kk < 2; ++kk) {
                        const bf16x8 br = mk8(pk2(hr[2 * kk][0], hr[2 * kk][1]), pk2(hr[2 * kk][2], hr[2 * kk][3]), pk2(hr[2 * kk + 1][0], hr[2 * kk + 1][1]), pk2(hr[2 * kk + 1][2], hr[2 * kk + 1][3]));
                        const bf16x8 bi = mk8(pk2(hi[2 * kk][0], hi[2 * kk][1]), pk2(hi[2 * kk][2], hi[2 * kk][3]), pk2(hi[2 * kk + 1][0], hi[2 * kk + 1][1]), pk2(hi[2 * kk + 1][2], hi[2 * kk + 1][3]));
                        y = MFMA(ops[(8 + kk) * 512], br, y); y2 = MFMA(ops[(10 + kk) * 512], bi, y2); }
                    y += y2;
                    char* zp = Zg + (zoff0 + (unsigned)tt * 1024u);
                    if (dir == 0) { u32x2 w; w.x = pk2(y[0], y[1]); w.y = pk2(y[2], y[3]); *(u32x2*)zp = w; }
                    else { const u32x4 uw = __builtin_bit_cast(u32x4, uc);
                        const unsigned a0 = __shfl((int)uw.x, srcl), a1 = __shfl((int)uw.y, srcl), a2 = __shfl((int)uw.z, srcl), a3 = __shfl((int)uw.w, srcl);
                        const unsigned ux = (quad & 1) ? a2 : a0, uy = (quad & 1) ? a3 : a1;
                        float v[4] = {bflo(yf.x) + y[0] + dsk[0] * bflo(ux), bfhi(yf.x) + y[1] + dsk[1] * bfhi(ux), bflo(yf.y) + y[2] + dsk[2] * bflo(uy), bfhi(yf.y) + y[3] + dsk[3] * bfhi(uy)};
#pragma unroll
                        for (int jj = 0; jj < 4; ++jj) { const float x = v[jj], uarg = 1.5957691216f * (x + 0.044715f * x * x * x); v[jj] = x * rcpf_(1.0f + __expf(-uarg)); }
                        u32x2 w; w.x = pk2(v[0], v[1]); w.y = pk2(v[2], v[3]); *(u32x2*)zp = w; }
                }
                asm volatile("" ::: "memory");
            }
        }
        if (pass == 1) {
#pragma unroll
            for (int pt = 0; pt < 4; ++pt) { float4* ep = (float4*)(Eb + (16 * pt + quad * 4) * 2);
                float4 e0, e1; e0.x = hr[pt][0]; e0.y = hi[pt][0]; e0.z = hr[pt][1]; e0.w = hi[pt][1]; e1.x = hr[pt][2]; e1.y = hi[pt][2]; e1.z = hr[pt][3]; e1.w = hi[pt][3]; ep[0] = e0; ep[1] = e1; }
        }
    }
}
__device__ __forceinline__ void s5_carry(const Ctx& p, int e) {
    const int gt = blockIdx.x * 512 + mk_tid(), gs = gridDim.x * 512;
    float2* E = (float2*)p.out;
    for (int i = gt; i < 32768; i += gs) {
        const int pp = i & 63, g = (i >> 6) & 31, dir = (i >> 11) & 1, b = i >> 12;
        const float4 a = ((const float4*)(p.ws + WS_S5A))[(size_t)((e * 2 + dir) * 32 + g) * 64 + pp];
        float2* base = E + ((size_t)((b * 2 + dir) * 72) * 32 + g) * 64 + pp;
        float hr = 0.f, hi = 0.f;
#pragma unroll 1
        for (int q0 = 0; q0 < 72; q0 += 6) {
            float2 ev[6];
#pragma unroll
            for (int j = 0; j < 6; ++j) ev[j] = base[(size_t)(q0 + j) * 2048];
#pragma unroll
            for (int j = 0; j < 6; ++j) { float2 o; o.x = hr; o.y = hi; base[(size_t)(q0 + j) * 2048] = o; const float nr = a.z * hr - a.w * hi + ev[j].x, ni = a.z * hi + a.w * hr + ev[j].y; hr = nr; hi = ni; }
        }
    }
}

constexpr int HG_CUM = 0, HG_QT = 33792, HG_KT = HG_QT + 17408, HG_QI = HG_KT + 17408, HG_KET = HG_QI + 17408, HG_VT = HG_KET + 18432, HG_SC = HG_VT + 18432, HG_TOT = HG_SC + 9216, HG_C63 = HG_TOT + 2048, HG_END = HG_C63 + 512;
static_assert(HG_END <= LDS_BYTES, "hgrn lds");
__device__ __forceinline__ void hgrn_chain(const Ctx& p, int e, int chain, LAS unsigned char* lds) {
    const int tid = mk_tid(), w = tid >> 6, lane = tid & 63, n = lane & 15, quad = lane >> 4;
    const int b = chain >> 3, dir = (chain >> 2) & 1, head = chain & 3;
    const bf16_t* P = (const bf16_t*)(p.ws + WS_P);
    bf16_t* O = (bf16_t*)(p.ws + (dir ? WS_OB : WS_OF));
    LAS float* cum = (LAS float*)(lds + HG_CUM);
    LAS bf16_t* qt = (LAS bf16_t*)(lds + HG_QT);
    LAS bf16_t* kt = (LAS bf16_t*)(lds + HG_KT);
    LAS bf16_t* qi = (LAS bf16_t*)(lds + HG_QI);
    LAS bf16_t* keT = (LAS bf16_t*)(lds + HG_KET);
    LAS bf16_t* vT = (LAS bf16_t*)(lds + HG_VT);
    LAS bf16_t* sc = (LAS bf16_t*)(lds + HG_SC);
    LAS float* tot = (LAS float*)(lds + HG_TOT);
    LAS float* c63s = (LAS float*)(lds + HG_C63);
    const int t = lane, kc = w * 16;
    const int sk = tid & 127, sseg = tid >> 7;
    const float* lbp = (const float*)(p.ws + WS_LB) + e * 512 + head * 128 + kc;
    f32x4 S[8];
#pragma unroll
    for (int i = 0; i < 8; ++i) S[i] = (f32x4){0.f, 0.f, 0.f, 0.f};
    const int qcol = 512 + head * 128 + kc, fcol = (dir ? 1536 : 1024) + head * 128 + kc, vcol = 2048 + head * 128 + kc;
    u32x4 rq0, rq1, rf0, rf1, rv0, rv1;
    { const int rowb = dir == 0 ? ML + b * 256 : ML + b * 256 + 192; const bf16_t* pr = P + (size_t)(rowb + (dir ? 63 - t : t)) * 3072;
      rq0 = *(const u32x4*)(pr + qcol); rq1 = *(const u32x4*)(pr + qcol + 8); rf0 = *(const u32x4*)(pr + fcol); rf1 = *(const u32x4*)(pr + fcol + 8); rv0 = *(const u32x4*)(pr + vcol); rv1 = *(const u32x4*)(pr + vcol + 8); }
#pragma unroll 1
    for (int pc = 0; pc < 36; ++pc) {
        const int tc = dir == 0 ? pc : (pc < 4 ? 3 - pc : 39 - pc);
        const int rowb = tc < 4 ? ML + b * 256 + tc * 64 : b * 2048 + (tc - 4) * 64;
        float qv[16], kv[16];
        {
            const unsigned rq[8] = {rq0.x, rq0.y, rq0.z, rq0.w, rq1.x, rq1.y, rq1.z, rq1.w}, rf[8] = {rf0.x, rf0.y, rf0.z, rf0.w, rf1.x, rf1.y, rf1.z, rf1.w},
                           rv[8] = {rv0.x, rv0.y, rv0.z, rv0.w, rv1.x, rv1.y, rv1.z, rv1.w};
            float lf[16], lb[16];
#pragma unroll
            for (int i = 0; i < 4; ++i) { const f32x4 t4 = *(const f32x4*)(lbp + 4 * i); lb[4 * i] = t4[0]; lb[4 * i + 1] = t4[1]; lb[4 * i + 2] = t4[2]; lb[4 * i + 3] = t4[3]; }
#pragma unroll
            for (int i = 0; i < 16; ++i) {
                const float x = (i & 1) ? bfhi(rq[i >> 1]) : bflo(rq[i >> 1]); float fl = (i & 1) ? bfhi(rf[i >> 1]) : bflo(rf[i >> 1]);
                fl = fminf(fmaxf(fl, -30.f), 30.f);
                qv[i] = siluf(x);
                const float en = __expf(-fl), sg = rcpf_(1.0f + en);
                kv[i] = (1.f - lb[i]) * en * sg;
                lf[i] = __logf(lb[i] + (1.f - lb[i]) * sg);
                vT[(kc + i) * 72 + t] = (bf16_t)((i & 1) ? (rv[i >> 1] >> 16) : (rv[i >> 1] & 0xffffu));
            }
#pragma unroll
            for (int i = 0; i < 4; ++i) *(LAS f32x4*)(cum + t * 132 + kc + 4 * i) = (f32x4){lf[4 * i], lf[4 * i + 1], lf[4 * i + 2], lf[4 * i + 3]};
        }
        if (pc < 35) { const int pc2 = pc + 1; const int tc2 = dir == 0 ? pc2 : (pc2 < 4 ? 3 - pc2 : 39 - pc2); const int rowb2 = tc2 < 4 ? ML + b * 256 + tc2 * 64 : b * 2048 + (tc2 - 4) * 64;
            const bf16_t* pr = P + (size_t)(rowb2 + (dir ? 63 - t : t)) * 3072;
            rq0 = *(const u32x4*)(pr + qcol); rq1 = *(const u32x4*)(pr + qcol + 8); rf0 = *(const u32x4*)(pr + fcol); rf1 = *(const u32x4*)(pr + fcol + 8); rv0 = *(const u32x4*)(pr + vcol); rv1 = *(const u32x4*)(pr + vcol + 8); }
        __syncthreads();
        {
            float c[16];
#pragma unroll
            for (int i = 0; i < 16; ++i) c[i] = cum[(16 * sseg + i) * 132 + sk];
#pragma unroll
            for (int i = 1; i < 16; ++i) c[i] += c[i - 1];
#pragma unroll
            for (int i = 0; i < 16; ++i) cum[(16 * sseg + i) * 132 + sk] = c[i];
            tot[sseg * 128 + sk] = c[15];
        }
        __syncthreads();
        {
            const int seg = t >> 4;
            unsigned wq[8], wk[8], wi[8];
#pragma unroll
            for (int i4 = 0; i4 < 4; ++i4) {
                const f32x4 o0 = *(const LAS f32x4*)(tot + kc + 4 * i4), o1 = *(const LAS f32x4*)(tot + 128 + kc + 4 * i4), o2 = *(const LAS f32x4*)(tot + 256 + kc + 4 * i4);
                const f32x4 cl = *(const LAS f32x4*)(cum + t * 132 + kc + 4 * i4), l31 = *(const LAS f32x4*)(cum + 31 * 132 + kc + 4 * i4), l63 = *(const LAS f32x4*)(cum + 63 * 132 + kc + 4 * i4);
                float a[4], bq[4], cq[4];
#pragma unroll
                for (int j = 0; j < 4; ++j) { const int ii = 4 * i4 + j;
                    const float off = (seg > 0 ? o0[j] : 0.f) + (seg > 1 ? o1[j] : 0.f) + (seg > 2 ? o2[j] : 0.f);
                    const float ct = cl[j] + off, c31 = l31[j] + o0[j], c63 = l63[j] + o0[j] + o1[j] + o2[j];
                    a[j] = qv[ii] * __expf(fminf(ct - c31, 80.f)); bq[j] = kv[ii] * __expf(fminf(c31 - ct, 80.f)); cq[j] = qv[ii] * __expf(ct);
                    keT[(kc + ii) * 72 + t] = f2bf(kv[ii] * __expf(c63 - ct));
                    if (t == 63) c63s[kc + ii] = c63; }
                wq[2 * i4] = pk2(a[0], a[1]); wq[2 * i4 + 1] = pk2(a[2], a[3]); wk[2 * i4] = pk2(bq[0], bq[1]); wk[2 * i4 + 1] = pk2(bq[2], bq[3]); wi[2 * i4] = pk2(cq[0], cq[1]); wi[2 * i4 + 1] = pk2(cq[2], cq[3]);
            }
            *(LAS u32x4*)(qt + t * 136 + kc) = (u32x4){wq[0], wq[1], wq[2], wq[3]}; *(LAS u32x4*)(qt + t * 136 + kc + 8) = (u32x4){wq[4], wq[5], wq[6], wq[7]};
            *(LAS u32x4*)(kt + t * 136 + kc) = (u32x4){wk[0], wk[1], wk[2], wk[3]}; *(LAS u32x4*)(kt + t * 136 + kc + 8) = (u32x4){wk[4], wk[5], wk[6], wk[7]};
            *(LAS u32x4*)(qi + t * 136 + kc) = (u32x4){wi[0], wi[1], wi[2], wi[3]}; *(LAS u32x4*)(qi + t * 136 + kc + 8) = (u32x4){wi[4], wi[5], wi[6], wi[7]};
        }
        __syncthreads();
        {
            const int tt = w >> 1;
#pragma unroll
            for (int si = 0; si < 2; ++si) { const int st = (w & 1) * 2 + si; f32x4 acc = {0.f, 0.f, 0.f, 0.f};
                if (st <= tt) {
#pragma unroll
                    for (int kb = 0; kb < 4; ++kb) { const bf16x8 a = *(const LAS bf16x8*)(qt + (16 * tt + n) * 136 + 32 * kb + quad * 8), bb = *(const LAS bf16x8*)(kt + (16 * st + n) * 136 + 32 * kb + quad * 8);
                        acc = MFMA(a, bb, acc); } }
#pragma unroll
                for (int j = 0; j < 4; ++j) { const int ti = 16 * tt + quad * 4 + j, sidx = 16 * st + n; sc[ti * 72 + sidx] = (st <= tt && sidx <= ti) ? f2bf(acc[j]) : (bf16_t)0; } }
        }
        __syncthreads();
        {
            bf16x8 Sb[4], vB[2];
#pragma unroll
            for (int kb = 0; kb < 4; ++kb) Sb[kb] = mk8(pk2(S[2 * kb][0], S[2 * kb][1]), pk2(S[2 * kb][2], S[2 * kb][3]), pk2(S[2 * kb + 1][0], S[2 * kb + 1][1]), pk2(S[2 * kb + 1][2], S[2 * kb + 1][3]));
#pragma unroll
            for (int sb = 0; sb < 2; ++sb) vB[sb] = *(const LAS bf16x8*)(vT + (16 * w + n) * 72 + 32 * sb + quad * 8);
#pragma unroll
            for (int tt = 0; tt < 4; ++tt) { f32x4 acc = {0.f, 0.f, 0.f, 0.f};
#pragma unroll
                for (int kb = 0; kb < 4; ++kb) { const bf16x4 a0 = *(const LAS bf16x4*)(qi + (16 * tt + n) * 136 + 32 * kb + quad * 4), a1 = *(const LAS bf16x4*)(qi + (16 * tt + n) * 136 + 32 * kb + 16 + quad * 4);
                    acc = MFMA(__builtin_shufflevector(a0, a1, 0, 1, 2, 3, 4, 5, 6, 7), Sb[kb], acc); }
#pragma unroll
                for (int sb = 0; sb < 2; ++sb) if (32 * sb <= 16 * tt + 15) { const bf16x8 a = *(const LAS bf16x8*)(sc + (16 * tt + n) * 72 + 32 * sb + quad * 8); acc = MFMA(a, vB[sb], acc); }
#pragma unroll
                for (int j = 0; j < 4; ++j) { const int ti = 16 * tt + quad * 4 + j; O[(size_t)(rowb + (dir ? 63 - ti : ti)) * 512 + head * 128 + 16 * w + n] = f2bf(acc[j]); } }
#pragma unroll
            for (int k8 = 0; k8 < 8; ++k8) { const f32x4 c4 = *(const LAS f32x4*)(c63s + 16 * k8 + quad * 4);
                f32x4 s = S[k8]; s[0] *= __expf(c4[0]); s[1] *= __expf(c4[1]); s[2] *= __expf(c4[2]); s[3] *= __expf(c4[3]);
#pragma unroll
                for (int sb = 0; sb < 2; ++sb) { const bf16x8 a = *(const LAS bf16x8*)(keT + (16 * k8 + n) * 72 + 32 * sb + quad * 8); s = MFMA(a, vB[sb], s); }
                S[k8] = s; }
        }
        __syncthreads();
    }
}

__device__ __forceinline__ void hg_pre_unit(const Ctx& p, int e, int u, LAS unsigned char* lds, bool dry) {
    const int tid = mk_tid(), w = __builtin_amdgcn_readfirstlane(tid >> 6), lane = tid & 63, n = lane & 15, quad = lane >> 4;
    const int head = u & 3, ch = u >> 2, b = ch / 36, tc = ch % 36;
    const int rowb = tc < 4 ? ML + b * 256 + tc * 64 : b * 2048 + (tc - 4) * 64;
    bf16_t* P = (bf16_t*)(p.ws + WS_P);
    LAS float* cum = (LAS float*)(lds + HG_CUM);
    LAS bf16_t* qt = (LAS bf16_t*)(lds + HG_QT); LAS bf16_t* kt = (LAS bf16_t*)(lds + HG_KT); LAS bf16_t* qi = (LAS bf16_t*)(lds + HG_QI);
    LAS bf16_t* keT = (LAS bf16_t*)(lds + HG_KET); LAS bf16_t* vT = (LAS bf16_t*)(lds + HG_VT); LAS bf16_t* sc = (LAS bf16_t*)(lds + HG_SC);
    LAS float* tot = (LAS float*)(lds + HG_TOT);
    const int t = lane, kc = w * 16;
    const int sk = tid & 127, sseg = tid >> 7;
    const float* lbp = (const float*)(p.ws + WS_LB) + e * 512 + head * 128 + kc;
    u32x4 rq0, rq1, rfa0, rfa1, rfb0, rfb1, rv0, rv1;
    { const bf16_t* pr = P + (size_t)(rowb + t) * 3072 + head * 128 + kc;
      rq0 = *(const u32x4*)(pr + 512); rq1 = *(const u32x4*)(pr + 520); rfa0 = *(const u32x4*)(pr + 1024); rfa1 = *(const u32x4*)(pr + 1032);
      rfb0 = *(const u32x4*)(pr + 1536); rfb1 = *(const u32x4*)(pr + 1544); rv0 = *(const u32x4*)(pr + 2048); rv1 = *(const u32x4*)(pr + 2056); }
    float lb[16];
#pragma unroll
    for (int i = 0; i < 4; ++i) { const f32x4 t4 = *(const f32x4*)(lbp + 4 * i); lb[4 * i] = t4[0]; lb[4 * i + 1] = t4[1]; lb[4 * i + 2] = t4[2]; lb[4 * i + 3] = t4[3]; }
    float qv[16];
    { const unsigned rq[8] = {rq0.x, rq0.y, rq0.z, rq0.w, rq1.x, rq1.y, rq1.z, rq1.w};
#pragma unroll
      for (int i = 0; i < 16; ++i) qv[i] = siluf((i & 1) ? bfhi(rq[i >> 1]) : bflo(rq[i >> 1])); }
#pragma unroll 1
    for (int dir = 0; dir < 2; ++dir) {
        const int s = dir ? 63 - t : t;
        bf16_t* O = (bf16_t*)(p.ws + (dir ? WS_OB : WS_OF));
        float kv[16];
        {
            const unsigned rv[8] = {rv0.x, rv0.y, rv0.z, rv0.w, rv1.x, rv1.y, rv1.z, rv1.w};
            const u32x4 f0 = dir ? rfb0 : rfa0, f1 = dir ? rfb1 : rfa1;
            const unsigned rf[8] = {f0.x, f0.y, f0.z, f0.w, f1.x, f1.y, f1.z, f1.w};
            float lf[16];
#pragma unroll
            for (int i = 0; i < 16; ++i) {
                float fl = (i & 1) ? bfhi(rf[i >> 1]) : bflo(rf[i >> 1]);
                fl = fminf(fmaxf(fl, -30.f), 30.f);
                const float en = __expf(-fl), sg = rcpf_(1.0f + en);
                kv[i] = (1.f - lb[i]) * en * sg;
                lf[i] = __logf(lb[i] + (1.f - lb[i]) * sg);
                vT[(kc + i) * 72 + s] = (bf16_t)((i & 1) ? (rv[i >> 1] >> 16) : (rv[i >> 1] & 0xffffu));
            }
#pragma unroll
            for (int i = 0; i < 4; ++i) *(LAS f32x4*)(cum + s * 132 + kc + 4 * i) = (f32x4){lf[4 * i], lf[4 * i + 1], lf[4 * i + 2], lf[4 * i + 3]};
        }
        __syncthreads();
        {
            float c[16];
#pragma unroll
            for (int i = 0; i < 16; ++i) c[i] = cum[(16 * sseg + i) * 132 + sk];
#pragma unroll
            for (int i = 1; i < 16; ++i) c[i] += c[i - 1];
#pragma unroll
            for (int i = 0; i < 16; ++i) cum[(16 * sseg + i) * 132 + sk] = c[i];
            tot[sseg * 128 + sk] = c[15];
        }
        __syncthreads();
        {
            const int seg = s >> 4;
            unsigned wq[8], wk[8], wi[8];
#pragma unroll
            for (int i4 = 0; i4 < 4; ++i4) {
                const f32x4 o0 = *(const LAS f32x4*)(tot + kc + 4 * i4), o1 = *(const LAS f32x4*)(tot + 128 + kc + 4 * i4), o2 = *(const LAS f32x4*)(tot + 256 + kc + 4 * i4);
                const f32x4 cl = *(const LAS f32x4*)(cum + s * 132 + kc + 4 * i4), l31 = *(const LAS f32x4*)(cum + 31 * 132 + kc + 4 * i4), l63 = *(const LAS f32x4*)(cum + 63 * 132 + kc + 4 * i4);
                float a[4], bq[4], cq[4], e63[4];
#pragma unroll
                for (int j = 0; j < 4; ++j) { const int ii = 4 * i4 + j;
                    const float off = (seg > 0 ? o0[j] : 0.f) + (seg > 1 ? o1[j] : 0.f) + (seg > 2 ? o2[j] : 0.f);
                    const float ct = cl[j] + off, c31 = l31[j] + o0[j], c63 = l63[j] + o0[j] + o1[j] + o2[j];
                    a[j] = qv[ii] * __expf(fminf(ct - c31, 80.f)); bq[j] = kv[ii] * __expf(fminf(c31 - ct, 80.f)); cq[j] = qv[ii] * __expf(ct);
                    keT[(kc + ii) * 72 + s] = f2bf(kv[ii] * __expf(c63 - ct)); e63[j] = __expf(c63); }
                if (s == 63 && !dry) { u32x2 ev; ev.x = pk2(e63[0], e63[1]); ev.y = pk2(e63[2], e63[3]);
                    *(u32x2*)((bf16_t*)(p.ws + WS_E63) + ((size_t)(dir * 288 + ch) * 4 + head) * 128 + kc + 4 * i4) = ev; }
                wq[2 * i4] = pk2(a[0], a[1]); wq[2 * i4 + 1] = pk2(a[2], a[3]); wk[2 * i4] = pk2(bq[0], bq[1]); wk[2 * i4 + 1] = pk2(bq[2], bq[3]); wi[2 * i4] = pk2(cq[0], cq[1]); wi[2 * i4 + 1] = pk2(cq[2], cq[3]);
            }
            *(LAS u32x4*)(qt + s * 136 + kc) = (u32x4){wq[0], wq[1], wq[2], wq[3]}; *(LAS u32x4*)(qt + s * 136 + kc + 8) = (u32x4){wq[4], wq[5], wq[6], wq[7]};
            *(LAS u32x4*)(kt + s * 136 + kc) = (u32x4){wk[0], wk[1], wk[2], wk[3]}; *(LAS u32x4*)(kt + s * 136 + kc + 8) = (u32x4){wk[4], wk[5], wk[6], wk[7]};
            *(LAS u32x4*)(qi + s * 136 + kc) = (u32x4){wi[0], wi[1], wi[2], wi[3]}; *(LAS u32x4*)(qi + s * 136 + kc + 8) = (u32x4){wi[4], wi[5], wi[6], wi[7]};
        }
        __syncthreads();
        {
            const int tt = w >> 1;
#pragma unroll
            for (int si = 0; si < 2; ++si) { const int st = (w & 1) * 2 + si; f32x4 acc = {0.f, 0.f, 0.f, 0.f};
                if (st <= tt) {
#pragma unroll
                    for (int kb = 0; kb < 4; ++kb) { const bf16x8 a = *(const LAS bf16x8*)(qt + (16 * tt + n) * 136 + 32 * kb + quad * 8), bb = *(const LAS bf16x8*)(kt + (16 * st + n) * 136 + 32 * kb + quad * 8);
                        acc = MFMA(a, bb, acc); } }
#pragma unroll
                for (int j = 0; j < 4; ++j) { const int ti = 16 * tt + quad * 4 + j, sidx = 16 * st + n; sc[ti * 72 + sidx] = (st <= tt && sidx <= ti) ? f2bf(acc[j]) : (bf16_t)0; } }
        }
        __syncthreads();
        {
            bf16x8 vB[2];
#pragma unroll
            for (int sb = 0; sb < 2; ++sb) vB[sb] = *(const LAS bf16x8*)(vT + (16 * w + n) * 72 + 32 * sb + quad * 8);
#pragma unroll
            for (int tt = 0; tt < 4; ++tt) { f32x4 acc = {0.f, 0.f, 0.f, 0.f};
#pragma unroll
                for (int sb = 0; sb < 2; ++sb) if (32 * sb <= 16 * tt + 15) { const bf16x8 a = *(const LAS bf16x8*)(sc + (16 * tt + n) * 72 + 32 * sb + quad * 8); acc = MFMA(a, vB[sb], acc); }
#pragma unroll
                for (int j = 0; j < 4; ++j) { const int ti = 16 * tt + quad * 4 + j; if (!dry) O[(size_t)(rowb + (dir ? 63 - ti : ti)) * 512 + head * 128 + 16 * w + n] = f2bf(acc[j]); } }
            if (!dry) { const int r = tid >> 3, c16 = (tid & 7) * 16; const u32x4 x0 = *(const LAS u32x4*)(qi + r * 136 + c16), x1 = *(const LAS u32x4*)(qi + r * 136 + c16 + 8);
              bf16_t* dq = dir ? (bf16_t*)(p.ws + WS_Q1) + (size_t)(rowb + r) * 512 + head * 128 + c16 : P + (size_t)(rowb + r) * 3072 + 512 + head * 128 + c16;
              *(u32x4*)dq = x0; *(u32x4*)(dq + 8) = x1; }
            if (!dry) { const int r = tid >> 3, c16 = (tid & 7) * 16, k = 2 * r + (c16 >> 6), s0 = c16 & 63;
              const u32x4 x0 = *(const LAS u32x4*)(keT + k * 72 + s0), x1 = *(const LAS u32x4*)(keT + k * 72 + s0 + 8), y0 = *(const LAS u32x4*)(vT + k * 72 + s0), y1 = *(const LAS u32x4*)(vT + k * 72 + s0 + 8);
              bf16_t* dk = P + (size_t)(rowb + r) * 3072 + (dir ? 1536 : 1024) + head * 128 + c16; *(u32x4*)dk = x0; *(u32x4*)(dk + 8) = x1;
              bf16_t* dv = dir ? (bf16_t*)(p.ws + WS_VT1) + (size_t)(rowb + r) * 512 + head * 128 + c16 : P + (size_t)(rowb + r) * 3072 + 2048 + head * 128 + c16; *(u32x4*)dv = y0; *(u32x4*)(dv + 8) = y1; }
        }
        __syncthreads();
    }
}

constexpr int HC_BUF = 17408 + 18432 + 18432 + 512;
static_assert(2 * HC_BUF <= LDS_BYTES - 256, "chain lds");
__device__ __forceinline__ void hgrn_chain2(const Ctx& p, int chain, LAS unsigned char* lds, bool dry) {
    const int tid = mk_tid(), w = __builtin_amdgcn_readfirstlane(tid >> 6), lane = tid & 63, n = lane & 15, quad = lane >> 4;
    const int b = chain >> 3, dir = (chain >> 2) & 1, head = chain & 3;
    const bf16_t* P = (const bf16_t*)(p.ws + WS_P);
    bf16_t* O = (bf16_t*)(p.ws + (dir ? WS_OB : WS_OF));
    const bf16_t* srcQ = dir ? (const bf16_t*)(p.ws + WS_Q1) + head * 128 : P + 512 + head * 128; const int ldq = dir ? 512 : 3072;
    const bf16_t* srcK = P + (dir ? 1536 : 1024) + head * 128;
    const bf16_t* srcV = dir ? (const bf16_t*)(p.ws + WS_VT1) + head * 128 : P + 2048 + head * 128; const int ldv = dir ? 512 : 3072;
    const bf16_t* E63 = (const bf16_t*)(p.ws + WS_E63);
    const int r = tid >> 3, c16 = (tid & 7) * 16, kk2 = 2 * r + (c16 >> 6), s0 = c16 & 63;
    f32x4 S[8];
#pragma unroll
    for (int i = 0; i < 8; ++i) S[i] = (f32x4){0.f, 0.f, 0.f, 0.f};
    u32x4 pq0, pq1, pk0, pk1, pv0, pv1; unsigned pe = 0u;
    auto fetch = [&](int pc) { const int tc = dir == 0 ? pc : (pc < 4 ? 3 - pc : 39 - pc); const int rowb = tc < 4 ? ML + b * 256 + tc * 64 : b * 2048 + (tc - 4) * 64;
        const bf16_t* q = srcQ + (size_t)(rowb + r) * ldq + c16; pq0 = *(const u32x4*)q; pq1 = *(const u32x4*)(q + 8);
        const bf16_t* k = srcK + (size_t)(rowb + r) * 3072 + c16; pk0 = *(const u32x4*)k; pk1 = *(const u32x4*)(k + 8);
        const bf16_t* v = srcV + (size_t)(rowb + r) * ldv + c16; pv0 = *(const u32x4*)v; pv1 = *(const u32x4*)(v + 8);
        if (tid < 64) pe = *(const unsigned*)(E63 + ((size_t)(dir * 288 + b * 36 + tc) * 4 + head) * 128 + tid * 2); };
    fetch(0);
#pragma unroll 1
    for (int pc = 0; pc < 36; ++pc) {
        LAS unsigned char* buf = lds + (pc & 1) * HC_BUF;
        LAS bf16_t* qi = (LAS bf16_t*)buf; LAS bf16_t* keT = (LAS bf16_t*)(buf + 17408); LAS bf16_t* vT = (LAS bf16_t*)(buf + 17408 + 18432); LAS float* e63 = (LAS float*)(buf + 17408 + 2 * 18432);
        *(LAS u32x4*)(qi + r * 136 + c16) = pq0; *(LAS u32x4*)(qi + r * 136 + c16 + 8) = pq1;
        *(LAS u32x4*)(keT + kk2 * 72 + s0) = pk0; *(LAS u32x4*)(keT + kk2 * 72 + s0 + 8) = pk1;
        *(LAS u32x4*)(vT + kk2 * 72 + s0) = pv0; *(LAS u32x4*)(vT + kk2 * 72 + s0 + 8) = pv1;
        if (tid < 64) { e63[tid * 2] = bflo(pe); e63[tid * 2 + 1] = bfhi(pe); }
        __syncthreads();
        const int tc = dir == 0 ? pc : (pc < 4 ? 3 - pc : 39 - pc); const int rowb = tc < 4 ? ML + b * 256 + tc * 64 : b * 2048 + (tc - 4) * 64;
        if (pc < 35) fetch(pc + 1);
        unsigned short oin[4][4];
#pragma unroll
        for (int tt = 0; tt < 4; ++tt)
#pragma unroll
            for (int j = 0; j < 4; ++j) { const int ti = 16 * tt + quad * 4 + j; oin[tt][j] = O[(size_t)(rowb + (dir ? 63 - ti : ti)) * 512 + head * 128 + 16 * w + n]; }
        bf16x8 Sb[4], vB[2];
#pragma unroll
        for (int kb = 0; kb < 4; ++kb) Sb[kb] = mk8(pk2(S[2 * kb][0], S[2 * kb][1]), pk2(S[2 * kb][2], S[2 * kb][3]), pk2(S[2 * kb + 1][0], S[2 * kb + 1][1]), pk2(S[2 * kb + 1][2], S[2 * kb + 1][3]));
#pragma unroll
        for (int sb = 0; sb < 2; ++sb) vB[sb] = *(const LAS bf16x8*)(vT + (16 * w + n) * 72 + 32 * sb + quad * 8);
        f32x4 acc[4];
#pragma unroll
        for (int tt = 0; tt < 4; ++tt) { acc[tt] = (f32x4){0.f, 0.f, 0.f, 0.f};
#pragma unroll
            for (int kb = 0; kb < 4; ++kb) { const bf16x4 a0 = *(const LAS bf16x4*)(qi + (16 * tt + n) * 136 + 32 * kb + quad * 4), a1 = *(const LAS bf16x4*)(qi + (16 * tt + n) * 136 + 32 * kb + 16 + quad * 4);
                acc[tt] = MFMA(__builtin_shufflevector(a0, a1, 0, 1, 2, 3, 4, 5, 6, 7), Sb[kb], acc[tt]); } }
#pragma unroll
        for (int k8 = 0; k8 < 8; ++k8) { const f32x4 c4 = *(const LAS f32x4*)(e63 + 16 * k8 + quad * 4);
            f32x4 sv = S[k8] * c4;
#pragma unroll
            for (int sb = 0; sb < 2; ++sb) { const bf16x8 a = *(const LAS bf16x8*)(keT + (16 * k8 + n) * 72 + 32 * sb + quad * 8); sv = MFMA(a, vB[sb], sv); }
            S[k8] = sv; }
#pragma unroll
        for (int tt = 0; tt < 4; ++tt)
#pragma unroll
            for (int j = 0; j < 4; ++j) { const int ti = 16 * tt + quad * 4 + j; if (!dry) O[(size_t)(rowb + (dir ? 63 - ti : ti)) * 512 + head * 128 + 16 * w + n] = f2bf(acc[tt][j] + bf2f(oin[tt][j])); }
    }
    __syncthreads();
}

__device__ __forceinline__ void hgrn_combine(const Ctx& p, int e) {
    const int lane = mk_tid() & 63, wg = blockIdx.x * 8 + (mk_tid() >> 6), nw = gridDim.x * 8;
    const bf16_t* P = (const bf16_t*)(p.ws + WS_P); const unsigned* OF = (const unsigned*)(p.ws + WS_OF); const unsigned* OB = (const unsigned*)(p.ws + WS_OB);
    unsigned* MX = (unsigned*)(p.ws + WS_A); const float* on = p.in[23] + e * 128;
    const float g0 = on[lane * 2], g1 = on[lane * 2 + 1];
    for (int row = wg; row < MT; row += nw) {
        unsigned a[4], bq[4], gg[4];
#pragma unroll
        for (int h = 0; h < 4; ++h) { a[h] = OF[(size_t)row * 256 + h * 64 + lane]; bq[h] = OB[(size_t)row * 256 + h * 64 + lane]; gg[h] = *(const unsigned*)(P + (size_t)row * 3072 + 2560 + h * 128 + lane * 2); }
#pragma unroll
        for (int h = 0; h < 4; ++h) {
            const float v0 = bflo(a[h]) + bflo(bq[h]), v1 = bfhi(a[h]) + bfhi(bq[h]); const float ss = wsum(v0 * v0 + v1 * v1); const float rs = rsqrtf(ss * (1.0f / 128.0f) + 1e-6f);
            MX[(size_t)row * 512 + 256 + h * 64 + lane] = pk2(v0 * rs * g0 * siluf(bflo(gg[h])), v1 * rs * g1 * siluf(bfhi(gg[h]))); }
    }
}

__device__ __forceinline__ void odd_post1(const Ctx& p, int o) {
    const int lane = mk_tid() & 63, wg = blockIdx.x * 8 + (mk_tid() >> 6), nw = gridDim.x * 8;
    bf16_t* P = (bf16_t*)(p.ws + WS_P); bf16_t* A23 = (bf16_t*)(p.ws + WS_A);
    const float* rope = (const float*)(p.ws + WS_ROPE);
    const float nq = p.in[26][o * 128 + lane], nk = p.in[26][o * 128 + 64 + lane], nr = p.in[33][o * 128 + 64 + lane];
    float gq[6], gk[4];
#pragma unroll
    for (int i = 0; i < 6; ++i) gq[i] = p.in[28][o * 384 + lane + 64 * i];
#pragma unroll
    for (int i = 0; i < 4; ++i) gk[i] = p.in[29][o * 256 + lane + 64 * i];
    const int ax = lane >> 5, f = lane & 15, hh = (lane >> 4) & 1;
    for (int row = wg; row < MT; row += nw) {
        bf16_t* pr = P + (size_t)row * 2304; const bool lat = row < ML; const int tk = row & 2047; const int pos = ax ? (tk & 63) : (tk >> 6);
        const float cs = rope[(pos * 16 + f) * 2], sn = rope[(pos * 16 + f) * 2 + 1];
        float x[17], xq[6], xk[4];
#pragma unroll
        for (int v = 0; v < 17; ++v) x[v] = bf2f(pr[(v < 16 ? v * 64 : 2176) + lane]);
#pragma unroll
        for (int i = 0; i < 6; ++i) xq[i] = bf2f(pr[1536 + lane + 64 * i]);
#pragma unroll
        for (int i = 0; i < 4; ++i) xk[i] = bf2f(pr[1920 + lane + 64 * i]);
#pragma unroll
        for (int v = 0; v < 17; ++v) { const float gn = v < 8 ? nq : (v < 16 ? nk : nr);
            const float ss = wsum(x[v] * x[v]); float y = x[v] * rsqrtf(ss * (1.0f / 64.0f) + 1e-6f) * gn;
            if (lat) { const float pt = __shfl_xor(y, 16); y = y * cs + (hh ? pt : -pt) * sn; }
            if (v < 8) y *= 0.125f * 1.4426950408889634f;
            pr[(v < 16 ? v * 64 : 2176) + lane] = f2bf(y); }
        { float ss = 0.f;
#pragma unroll
          for (int i = 0; i < 6; ++i) ss += xq[i] * xq[i];
          ss = wsum(ss); const float rs = rsqrtf(ss * (1.0f / 384.0f) + 1e-6f);
#pragma unroll
          for (int i = 0; i < 6; ++i) A23[(size_t)row * 640 + lane + 64 * i] = f2bf(xq[i] * rs * gq[i]); }
        { float ss = 0.f;
#pragma unroll
          for (int i = 0; i < 4; ++i) ss += xk[i] * xk[i];
          ss = wsum(ss); const float rs = rsqrtf(ss * (1.0f / 256.0f) + 1e-6f);
#pragma unroll
          for (int i = 0; i < 4; ++i) A23[(size_t)row * 640 + 384 + lane + 64 * i] = f2bf(xk[i] * rs * gk[i]); }
    }
}
__device__ __forceinline__ void odd_post2(const Ctx& p, int o) {
    const int lane = mk_tid() & 63, wg = blockIdx.x * 8 + (mk_tid() >> 6), nw = gridDim.x * 8;
    bf16_t* UQ = (bf16_t*)(p.ws + WS_U); bf16_t* UKV = UQ + 768;
    const float* rope = (const float*)(p.ws + WS_ROPE);
    const float qn0 = p.in[32][o * 256 + lane], qn1 = p.in[32][o * 256 + 64 + lane], kn0 = p.in[32][o * 256 + 128 + lane], kn1 = p.in[32][o * 256 + 192 + lane], rn = p.in[33][o * 128 + lane];
    const int ax = lane >> 5, f = lane & 15, hh = (lane >> 4) & 1; const float scl = 0.07216878364870322f * 1.4426950408889634f;
    for (int row = wg; row < MT; row += nw) {
        const bool lat = row < ML; const int tk = row & 2047; const int pos = ax ? (tk & 63) : (tk >> 6);
        const float cs = rope[(pos * 16 + f) * 2], sn = rope[(pos * 16 + f) * 2 + 1];
        bf16_t* uq = UQ + (size_t)row * 1792; bf16_t* ukv = UKV + (size_t)row * 1792;
        float a0[4], a1[4], ar[4], k0[4], k1[4];
#pragma unroll
        for (int h = 0; h < 4; ++h) { a0[h] = bf2f(uq[h * 192 + lane]); a1[h] = bf2f(uq[h * 192 + 64 + lane]); ar[h] = bf2f(uq[h * 192 + 128 + lane]); k0[h] = bf2f(ukv[h * 256 + lane]); k1[h] = bf2f(ukv[h * 256 + 64 + lane]); }
#pragma unroll
        for (int h = 0; h < 4; ++h) {
            { const float ss = wsum(a0[h] * a0[h] + a1[h] * a1[h]); const float rs = rsqrtf(ss * (1.0f / 128.0f) + 1e-6f) * scl;
              uq[h * 192 + lane] = f2bf(a0[h] * rs * qn0); uq[h * 192 + 64 + lane] = f2bf(a1[h] * rs * qn1); }
            { const float ss = wsum(ar[h] * ar[h]); float y = ar[h] * rsqrtf(ss * (1.0f / 64.0f) + 1e-6f) * rn;
              if (lat) { const float pt = __shfl_xor(y, 16); y = y * cs + (hh ? pt : -pt) * sn; }
              uq[h * 192 + 128 + lane] = f2bf(y * scl); }
            { const float ss = wsum(k0[h] * k0[h] + k1[h] * k1[h]); const float rs = rsqrtf(ss * (1.0f / 128.0f) + 1e-6f);
              ukv[h * 256 + lane] = f2bf(k0[h] * rs * kn0); ukv[h * 256 + 64 + lane] = f2bf(k1[h] * rs * kn1); }
        }
    }
}

constexpr int AT_VT = 25600, AT_VRS = 288;
typedef short s16x4 __attribute__((ext_vector_type(4)));
template <int OFF> __device__ __forceinline__ s16x4 tr_read(unsigned vb) { s16x4 r; asm volatile("ds_read_b64_tr_b16 %0, %1 offset:%2" : "=&v"(r) : "v"(vb), "i"(OFF) : "memory"); return r; }
template <int DT> __device__ __forceinline__ void pv_pair(f32x4 (&O)[8][2], unsigned vb, const bf16x8 (&Pf)[2][2]) {
    const s16x4 a00 = tr_read<(0) * AT_VRS + DT * 32>(vb), a01 = tr_read<(16) * AT_VRS + DT * 32>(vb), a10 = tr_read<(32) * AT_VRS + DT * 32>(vb), a11 = tr_read<(48) * AT_VRS + DT * 32>(vb);
    const s16x4 b00 = tr_read<(0) * AT_VRS + (DT + 1) * 32>(vb), b01 = tr_read<(16) * AT_VRS + (DT + 1) * 32>(vb), b10 = tr_read<(32) * AT_VRS + (DT + 1) * 32>(vb), b11 = tr_read<(48) * AT_VRS + (DT + 1) * 32>(vb);
    asm volatile("s_waitcnt lgkmcnt(0)" ::: "memory"); __builtin_amdgcn_sched_barrier(0);
#define PK8(L, H) (bf16x8){L[0], L[1], L[2], L[3], H[0], H[1], H[2], H[3]}
    const bf16x8 va0 = PK8(a00, a01), va1 = PK8(a10, a11), vb0 = PK8(b00, b01), vb1 = PK8(b10, b11);
#undef PK8
    O[DT][0] = MFMA(va0, Pf[0][0], O[DT][0]); O[DT][1] = MFMA(va0, Pf[1][0], O[DT][1]); O[DT + 1][0] = MFMA(vb0, Pf[0][0], O[DT + 1][0]); O[DT + 1][1] = MFMA(vb0, Pf[1][0], O[DT + 1][1]);
    O[DT][0] = MFMA(va1, Pf[0][1], O[DT][0]); O[DT][1] = MFMA(va1, Pf[1][1], O[DT][1]); O[DT + 1][0] = MFMA(vb1, Pf[0][1], O[DT + 1][0]); O[DT + 1][1] = MFMA(vb1, Pf[1][1], O[DT + 1][1]);
}
constexpr int AT_BUF = 45056;
template <int DQ, int K1W>
__device__ __forceinline__ void attn_core(LAS unsigned char* lds, const bf16_t* __restrict__ Q, int qld, int qrow0, const bf16_t* __restrict__ K1, int k1ld,
                                          const bf16_t* __restrict__ K2, int k2ld, const bf16_t* __restrict__ V, int vld, int b, int ntiles, float mref, f32x4 (&O)[8][2]) {
    constexpr int NDK = DQ / 32, KP = DQ + 8, NKL = DQ / 64, C8 = DQ / 8;
    const int tid = mk_tid(), w = __builtin_amdgcn_readfirstlane(tid >> 6), lane = tid & 63, n = lane & 15, quad = lane >> 4;
    const unsigned vb0 = (unsigned)(size_t)(lds + AT_VT) + (unsigned)((quad * 4 + (n >> 2)) * AT_VRS + (n & 3) * 8);
    bf16x8 Qf[2][NDK];
#pragma unroll
    for (int qt = 0; qt < 2; ++qt)
#pragma unroll
        for (int dk = 0; dk < NDK; ++dk) Qf[qt][dk] = *(const bf16x8*)(Q + (size_t)(qrow0 + w * 32 + qt * 16 + n) * qld + dk * 32 + quad * 8);
    float lrun[2] = {0.f, 0.f};
#pragma unroll
    for (int dt = 0; dt < 8; ++dt) { O[dt][0] = (f32x4){0.f, 0.f, 0.f, 0.f}; O[dt][1] = (f32x4){0.f, 0.f, 0.f, 0.f}; }
    u32x4 kr[NKL], vr[2];
    auto issue = [&](int ktile) {
        const int rowb = ktile < 4 ? ML + b * 256 + ktile * 64 : b * 2048 + (ktile - 4) * 64;
#pragma unroll
        for (int i = 0; i < NKL; ++i) { const int idx = tid + i * 512, key = idx / C8, d0 = (idx % C8) * 8;
            const bf16_t* src = d0 < K1W ? K1 + (size_t)(rowb + key) * k1ld + d0 : K2 + (size_t)(rowb + key) * k2ld + (d0 - K1W);
            kr[i] = *(const u32x4*)src; }
#pragma unroll
        for (int i = 0; i < 2; ++i) { const int idx = tid + i * 512, key = idx >> 4, d0 = (idx & 15) * 8; vr[i] = *(const u32x4*)(V + (size_t)(rowb + key) * vld + d0); }
    };
    auto stage = [&](int bufi) { LAS bf16_t* Ks = (LAS bf16_t*)(lds + bufi * AT_BUF); LAS bf16_t* Vs = (LAS bf16_t*)(lds + bufi * AT_BUF + AT_VT);
#pragma unroll
        for (int i = 0; i < NKL; ++i) { const int idx = tid + i * 512, key = idx / C8, d0 = (idx % C8) * 8; *(LAS u32x4*)(Ks + key * KP + d0) = kr[i]; }
#pragma unroll
        for (int i = 0; i < 2; ++i) { const int idx = tid + i * 512, key = idx >> 4, d0 = (idx & 15) * 8; *(LAS u32x4*)(Vs + key * (AT_VRS / 2) + d0) = vr[i]; } };
    issue(0);
    __syncthreads();
    stage(0);
    if (ntiles > 1) issue(1);
    __syncthreads();
#pragma unroll 1
    for (int ktile = 0; ktile < ntiles; ++ktile) {
        const int bufi = ktile & 1;
        LAS bf16_t* Ks = (LAS bf16_t*)(lds + bufi * AT_BUF);
        const unsigned vb = vb0 + (unsigned)(bufi * AT_BUF);
        f32x4 s[4][2];
#pragma unroll
        for (int st = 0; st < 4; ++st) { s[st][0] = (f32x4){0.f, 0.f, 0.f, 0.f}; s[st][1] = (f32x4){0.f, 0.f, 0.f, 0.f};
#pragma unroll
            for (int dk = 0; dk < NDK; ++dk) { const bf16x8 a = *(const LAS bf16x8*)(Ks + (16 * st + n) * KP + 32 * dk + quad * 8);
                s[st][0] = MFMA(a, Qf[0][dk], s[st][0]); s[st][1] = MFMA(a, Qf[1][dk], s[st][1]); }
            asm volatile("" ::: "memory"); }
        bf16x8 Pf[2][2];
#pragma unroll
        for (int qt = 0; qt < 2; ++qt) {
            float ls = 0.f;
#pragma unroll
            for (int st = 0; st < 4; ++st)
#pragma unroll
                for (int j = 0; j < 4; ++j) { const float pv = __builtin_amdgcn_exp2f(s[st][qt][j] - mref); s[st][qt][j] = pv; ls += pv; }
            lrun[qt] += ls;
#pragma unroll
            for (int kb = 0; kb < 2; ++kb) Pf[qt][kb] = mk8(pk2(s[2 * kb][qt][0], s[2 * kb][qt][1]), pk2(s[2 * kb][qt][2], s[2 * kb][qt][3]), pk2(s[2 * kb + 1][qt][0], s[2 * kb + 1][qt][1]), pk2(s[2 * kb + 1][qt][2], s[2 * kb + 1][qt][3]));
        }
        pv_pair<0>(O, vb, Pf); pv_pair<2>(O, vb, Pf); pv_pair<4>(O, vb, Pf); pv_pair<6>(O, vb, Pf);
        if (ktile + 1 < ntiles) { stage(bufi ^ 1); if (ktile + 2 < ntiles) issue(ktile + 2); }
        __syncthreads();
    }
#pragma unroll
    for (int qt = 0; qt < 2; ++qt) { float l = lrun[qt]; l += __shfl_xor(l, 16); l += __shfl_xor(l, 32); const float inv = rcpf_(l);
#pragma unroll
        for (int dt = 0; dt < 8; ++dt) O[dt][qt] *= inv; }
}

__device__ __forceinline__ void attn_phase(const Ctx& p, int o, int l, bool need_ctx, LAS unsigned char* lds) {
    const int lane = mk_tid() & 63;
    const bf16_t* P = (const bf16_t*)(p.ws + WS_P); const bf16_t* UQ = (const bf16_t*)(p.ws + WS_U); const bf16_t* UKV = UQ + 768;
    bf16_t* MX = (bf16_t*)(p.ws + WS_A);
    const float lam_init = l == 1 ? 0.35550906759f : 0.55605820416f;
    float lam;
    { const float* lv = p.in[25] + o * 256; const float d1 = wsum(lv[lane] * lv[64 + lane]), d2 = wsum(lv[128 + lane] * lv[192 + lane]);
      lam = __uint_as_float(__builtin_amdgcn_readfirstlane(__float_as_uint(expf(d1) - expf(d2) + lam_init))); }
    float mref_d, mref_m;
    { const float L2E = 1.4426950408889634f;
      float gq = fabsf(p.in[26][o * 128 + lane]), gk = fabsf(p.in[26][o * 128 + 64 + lane]);
      float n0a = fmaxf(fabsf(p.in[32][o * 256 + lane]), fabsf(p.in[32][o * 256 + 64 + lane])), n1a = fmaxf(fabsf(p.in[32][o * 256 + 128 + lane]), fabsf(p.in[32][o * 256 + 192 + lane]));
      float r0 = fabsf(p.in[33][o * 128 + lane]), r1 = fabsf(p.in[33][o * 128 + 64 + lane]);
#pragma unroll
      for (int off = 32; off >= 1; off >>= 1) { gq = fmaxf(gq, __shfl_xor(gq, off)); gk = fmaxf(gk, __shfl_xor(gk, off)); n0a = fmaxf(n0a, __shfl_xor(n0a, off)); n1a = fmaxf(n1a, __shfl_xor(n1a, off)); r0 = fmaxf(r0, __shfl_xor(r0, off)); r1 = fmaxf(r1, __shfl_xor(r1, off)); }
      mref_d = __uint_as_float(__builtin_amdgcn_readfirstlane(__float_as_uint(64.0f * gq * gk * 0.125f * L2E * 1.01f + 0.5f)));
      mref_m = __uint_as_float(__builtin_amdgcn_readfirstlane(__float_as_uint(sqrtf((128.f * n0a * n0a + 64.f * r0 * r0) * (128.f * n1a * n1a + 64.f * r1 * r1)) * 0.07216878364870322f * L2E * 1.01f + 0.5f))); }
    const int nunits = need_ctx ? 576 : 512;
#pragma unroll 1
    for (int u = blockIdx.x; u < nunits; u += gridDim.x) {
        const bool isctx = u >= 512; const int uu = isctx ? u - 512 : u;
        const bool mla = isctx ? (uu < 32) : (uu < 256); const int v = isctx ? (uu & 31) : (uu & 255);
        int b, head, qb;
        if (isctx) { b = v >> 2; head = v & 3; qb = 0; } else { b = v >> 5; head = (v >> 3) & 3; qb = v & 7; }
        const int qrow0 = isctx ? ML + b * 256 : b * 2048 + qb * 256; const int ntiles = isctx ? 4 : 36;
        f32x4 O[8][2];
        if (mla) {
            attn_core<192, 128>(lds, UQ + head * 192, 1792, qrow0, UKV + head * 256, 1792, P + 2176, 2304, UKV + head * 256 + 128, 1792, b, ntiles, mref_m, O);
            const int t3 = mk_tid(), w = t3 >> 6, n = t3 & 15, quad = (t3 & 63) >> 4;
#pragma unroll
            for (int qt = 0; qt < 2; ++qt) { const size_t row = (size_t)(qrow0 + w * 32 + qt * 16 + n);
#pragma unroll
                for (int dt = 0; dt < 8; ++dt) { u32x2 ww; ww.x = pk2(O[dt][qt][0], O[dt][qt][1]); ww.y = pk2(O[dt][qt][2], O[dt][qt][3]); *(u32x2*)(MX + row * 1024 + 512 + head * 128 + 16 * dt + quad * 4) = ww; } }
        } else {
            LAS u32x2* O1s = (LAS u32x2*)(lds + 2 * AT_BUF) + mk_tid();
            attn_core<64, 64>(lds, P + head * 128, 2304, qrow0, P + 512 + head * 128, 2304, P, 2304, P + 1024 + head * 128, 2304, b, ntiles, mref_d, O);
#pragma unroll
            for (int dt = 0; dt < 8; ++dt)
#pragma unroll
                for (int qt = 0; qt < 2; ++qt) { u32x2 t2; t2.x = pk2(O[dt][qt][0], O[dt][qt][1]); t2.y = pk2(O[dt][qt][2], O[dt][qt][3]); O1s[(dt * 2 + qt) * 512] = t2; }
            attn_core<64, 64>(lds, P + head * 128 + 64, 2304, qrow0, P + 512 + head * 128 + 64, 2304, P, 2304, P + 1024 + head * 128, 2304, b, ntiles, mref_d, O);
            const float* sl = p.in[27] + o * 128; const int t3 = mk_tid(), w = t3 >> 6, n = t3 & 15, quad = (t3 & 63) >> 4, quad2 = quad;
#pragma unroll
            for (int qt = 0; qt < 2; ++qt) { const size_t row = (size_t)(qrow0 + w * 32 + qt * 16 + n); float ss = 0.f;
#pragma unroll
                for (int dt = 0; dt < 8; ++dt) { { const u32x2 t2 = O1s[(dt * 2 + qt) * 512]; O[dt][qt] = (f32x4){bflo(t2.x), bfhi(t2.x), bflo(t2.y), bfhi(t2.y)} - lam * O[dt][qt]; } ss += O[dt][qt][0] * O[dt][qt][0] + O[dt][qt][1] * O[dt][qt][1] + O[dt][qt][2] * O[dt][qt][2] + O[dt][qt][3] * O[dt][qt][3]; }
                ss += __shfl_xor(ss, 16); ss += __shfl_xor(ss, 32); const float rs = rsqrtf(ss * (1.0f / 128.0f) + 1e-6f) * (1.0f - lam_init);
#pragma unroll
                for (int dt = 0; dt < 8; ++dt) { const f32x4 g = *(const f32x4*)(sl + 16 * dt + quad2 * 4); u32x2 ww; ww.x = pk2(O[dt][qt][0] * rs * g[0], O[dt][qt][1] * rs * g[1]); ww.y = pk2(O[dt][qt][2] * rs * g[2], O[dt][qt][3] * rs * g[3]);
                    *(u32x2*)(MX + row * 1024 + head * 128 + 16 * dt + quad * 4) = ww; } }
        }
    }
}

#ifdef REP_PH
#define HG_DRY (reps == 0 && ph == REP_PH)
#else
#define HG_DRY false
#endif
#ifdef GONLY
#define GSEL(k) && (GONLY == k)
#else
#define GSEL(k)
#endif
__global__ void __launch_bounds__(512) mega(Params kp) {
    extern __shared__ __attribute__((aligned(16))) unsigned char shm[];
    LAS unsigned char* lds = (LAS unsigned char*)shm;
    cg::grid_group grid = cg::this_grid();
    { const float** tabw = (const float**)(kp.ws + WS_TAB); const int t = threadIdx.x; if (t < 34) tabw[t] = kp.in[t]; }
    volatile LAS unsigned* bst = (volatile LAS unsigned*)(lds + LDS_BYTES - 256);
    if (threadIdx.x < 2) bst[threadIdx.x] = 0u;
    __syncthreads();
    const XcdBarrier xbar = xcd_barrier_post((unsigned*)(kp.ws + WS_BAR), bst);
    const int ph_hi = kp.ph_hi;
#ifdef REP_PH
    int reps = 0;
#endif
#pragma unroll 1
    for (int ph = kp.ph_lo; ph < ph_hi; ++ph) {
        unsigned char* ws = kp.ws; asm volatile("" : "+s"(ws));
        Ctx p; p.ws = ws; p.in = (const float* const*)(ws + WS_TAB); p.out = kp.out;
        const int bid = blockIdx.x, nb = gridDim.x, w = __builtin_amdgcn_readfirstlane(mk_tid() >> 6);
        if (ph == 0) {
#if !defined(ONLY) || ONLY==0

#if defined(REP_PH) && defined(REP_PART)
 prep_phase(p, lds, reps ? REP_PART : 0);
#else
 prep_phase(p, lds, 0);
#endif
#endif
 }
        else if (ph == 1) prep2_phase(p, lds);
        else {
            const int l = (ph - 2) / 10, s = (ph - 2) % 10, eo = l >> 1;
            if (s == 0 || s == 7) continue;
            float* SS = (float*)(ws + WS_SS); const float* BIAS = (const float*)(ws + WS_BIAS) + (size_t)l * 9 * 8704; const bool odd = l & 1; const bool need_ctx = l < 3; const int Mres = need_ctx ? MT : ML;
            const float* mod = (const float*)(ws + WS_MOD) + (size_t)l * 9 * 6144;
            const bf16_t* Abuf = (const bf16_t*)(ws + WS_A);
            if (s == 1) {
#if !defined(ONLY) || ONLY==4
                EpiStore<true> E; E.O = (bf16_t*)(ws + WS_P); E.ss = SS + (size_t)(2 * l) * MT; E.bias = BIAS;
                if (!odd) { E.ldc = 3072; run_gemm(lds, Abuf, (const bf16_t*)(ws + WS_WAB) + (size_t)eo * 3072 * 1024, MT, 3072, 1024, E); }
                else { E.ldc = 2304; run_gemm(lds, Abuf, (const bf16_t*)(ws + WS_WCD) + (size_t)eo * 2304 * 1024, MT, 2304, 1024, E); }
#endif
            }
            else if (s == 2) {
                if (!odd) {
#if !defined(ONLY) || ONLY==1
                    for (int u = bid; u < 1152; u += nb) hg_pre_unit(p, eo, u, lds, HG_DRY);
                    if (!HG_DRY)
#endif
#if !defined(ONLY) || ONLY==2
                    for (int u = w * nb + bid; u < 1152; u += 8 * nb) s5_unit<1>(p, eo, u / 36, u % 36, lds);
#endif
                } else odd_post1(p, eo);
            }
            else if (s == 3) {
                if (!odd) s5_carry(p, eo);
                else {
#if !defined(ONLY) || ONLY==4
                    EpiStore<false> E; E.O = (bf16_t*)(ws + WS_U); E.ldc = 1792; E.ss = nullptr; E.bias = nullptr; run_gemm(lds, Abuf, (const bf16_t*)(ws + WS_WU) + (size_t)eo * 1792 * 640, MT, 1792, 640, E);
#endif
                }
            }
            else if (s == 4) {
                if (!odd) {
                    const bool split = nb >= 128;
#if !defined(ONLY) || ONLY==1
                    for (int chn = bid; chn < 64; chn += nb) hgrn_chain2(p, chn, lds, HG_DRY);
                    if (!HG_DRY)
#endif
#if !defined(ONLY) || ONLY==2
                    if (!split || bid >= 64) { const int nbb = split ? nb - 64 : nb, bb = split ? bid - 64 : bid;
                        for (int u = w * nbb + bb; u < 1152; u += 8 * nbb) s5_unit<2>(p, eo, u / 36, u % 36, lds); }
#endif
                } else odd_post2(p, eo);
            }
            else if (s == 5) {
                if (!odd) {
#if !defined(ONLY) || ONLY==4
                    EpiGLU E; E.MX = (bf16_t*)(ws + WS_A); E.Z = (const bf16_t*)(ws + WS_Z); E.bias = p.in[21] + eo * 512;
                    run_gemm(lds, (const bf16_t*)(ws + WS_Z), (const bf16_t*)(ws + WS_WGLU) + (size_t)eo * 512 * 512, MT, 512, 512, E);
                    __syncthreads();
#endif
                    hgrn_combine(p, eo);
                } else {
#if !defined(ONLY) || ONLY==3
                    attn_phase(p, eo, l, need_ctx, lds);
#endif
                }
            }
            else if (s == 6 || s == 9) {
#if !defined(ONLY) || ONLY==4
                EpiRes E; E.H = (float*)(ws + WS_H); E.gate = mod + (s == 6 ? 2 : 5) * 1024; E.out = (l == 3 && s == 9) ? p.out : nullptr;
                if (s == 6) { E.Hb = (bf16_t*)(ws + WS_HB1); E.gn = p.in[7] + l * 1024; E.scn = mod + 4 * 1024; E.ss = SS + (size_t)(2 * l + 1) * MT; }
                else if (l < 3) { E.Hb = (bf16_t*)(ws + WS_A); E.gn = p.in[6] + (l + 1) * 1024; E.scn = mod + 9 * 6144 + 1024; E.ss = SS + (size_t)(2 * l + 2) * MT; }
                else { E.Hb = nullptr; E.gn = nullptr; E.scn = nullptr; E.ss = nullptr; }
                if (s == 6) run_gemm(lds, Abuf, (const bf16_t*)(ws + WS_WO) + (size_t)l * 1024 * 1024, Mres, 1024, 1024, E);
                else run_gemm(lds, (const bf16_t*)(ws + WS_P), (const bf16_t*)(ws + WS_WFO) + (size_t)l * 1024 * 2816, Mres, 1024, 2816, E);
#endif
            }
            else if (s == 8) {
#if !defined(ONLY) || ONLY==4
                EpiSwiGLU E; E.G = (bf16_t*)(ws + WS_P); E.ss = SS + (size_t)(2 * l + 1) * MT; E.bias = BIAS + 3072;
                run_gemm(lds, (const bf16_t*)(ws + WS_HB1), (const bf16_t*)(ws + WS_WFI) + (size_t)l * 5632 * 1024, Mres, 5632, 1024, E);
#endif
            }
        }
        if (ph + 1 < ph_hi) { if (ph_hi > 1000) grid.sync(); else xcd_barrier(xbar); }
#ifdef EXTRA_SYNC
        if (ph == 0) { for (int q = 0; q < 32; ++q) xcd_barrier(xbar); }
#endif
#ifdef REP_PH
        if (ph == REP_PH && reps < 1) { ++reps; --ph; }
#endif
    }
}

extern "C" void kernel_launch(void* const* d_in, const int* in_sizes, int n_in, void* d_out, int out_size, void* d_ws, size_t ws_size, hipStream_t stream) {
    static int grid = 0;
    if (grid == 0) {
        if (n_in != 34 || ws_size < WS_NEED) { fprintf(stderr, "kernel_launch: unexpected n_in %d / ws_size %zu (need %zu)\n", n_in, ws_size, (size_t)WS_NEED); }
        int dev = 0, cus = 0, per_cu = 0;
        hipGetDevice(&dev); hipDeviceGetAttribute(&cus, hipDeviceAttributeMultiprocessorCount, dev);
        hipFuncSetAttribute((const void*)mega, hipFuncAttributeMaxDynamicSharedMemorySize, LDS_BYTES);
        hipOccupancyMaxActiveBlocksPerMultiprocessor(&per_cu, (const void*)mega, 512, LDS_BYTES);
        (void)hipGetLastError();
        if (per_cu < 1) fprintf(stderr, "kernel_launch: occupancy query says %d blocks per CU\n", per_cu);
        grid = cus > 0 ? cus : 256;
    }
    hipMemsetAsync((char*)d_ws + WS_SS, 0, 8ull * MT * 4 + XCD_BAR_WORDS * 4, stream);
    Params p{};
    for (int i = 0; i < 34; ++i) p.in[i] = (const float*)d_in[i];
    p.out = (float*)d_out; p.ws = (unsigned char*)d_ws;
#if MK_MODE == 0
    p.ph_lo = 0; p.ph_hi = NPH;
    void* args[] = {&p};
    hipError_t e = hipLaunchCooperativeKernel((const void*)mega, dim3(grid), dim3(512), args, LDS_BYTES, stream);
    if (e != hipSuccess) fprintf(stderr, "cooperative launch failed: %s (grid %d)\n", hipGetErrorString(e), grid);
#else
    for (int ph = 0; ph < NPH; ++ph) { p.ph_lo = ph; p.ph_hi = ph + 1; hipLaunchKernelGGL(mega, dim3(grid), dim3(512), LDS_BYTES, stream, p); }
#endif
}
```

```cpp
#include <hip/hip_runtime.h>
#include <hip/hip_cooperative_groups.h>
#include <cstdio>
namespace cg = cooperative_groups;
#ifndef MK_MODE
#define MK_MODE 0
#endif
__device__ __forceinline__ int mk_tid() { int t = threadIdx.x; asm volatile("" : "+v"(t)); return t; }
namespace pg8 {
#define PG8_LAS __attribute__((address_space(3)))
typedef unsigned short bf16_t;
typedef short bf16x8 __attribute__((ext_vector_type(8)));
typedef float f32x4 __attribute__((ext_vector_type(4)));
typedef unsigned u32x4 __attribute__((ext_vector_type(4)));
constexpr int BM = 256, BK = 64, HALF = 128, HTB = HALF * BK * 2  , STAGE_BYTES = 8 * HTB, NXCD = 8, WGM = 8;

__host__ __device__ __forceinline__ int lds_byte(int r, int c) { const int st = (r >> 4) * 2 + (c >> 5), rr = r & 15, cc = c & 31, ob = rr * 64 + cc * 2; return st * 1024 + (ob ^ (((ob >> 9) & 1) << 5)); }
__host__ __device__ __forceinline__ void stage_rc(int b, int& R, int& C) { const int st = b / 1024, sb = b % 1024, swz = sb ^ (((sb >> 9) & 1) << 5); R = (st >> 1) * 16 + swz / 64; C = (st & 1) * 32 + (swz % 64) / 2; }
__host__ __device__ __forceinline__ int perm32(int rho) { const int n = rho >> 4, i = rho & 15; return 8 * (i >> 2) + 4 * n + (i & 3); }

struct Unit { int pm, pn, ks; };
struct Gemm { const bf16_t* A; const bf16_t* Bt; int M, N, K, ld; };

struct StaticOrder {
    int nM, nN, nwg, G, c;
    __host__ __device__ void init(int M, int N, int G_, int c_) { nM = M / BM; nN = N / BM; nwg = nM * nN; G = G_; c = c_; }
    __host__ __device__ bool next(int i, Unit& u) const {
        const long L = (long)i * G + c; if (L >= nwg) return false;
        int wgid = (int)L; { const int q = nwg / NXCD, r = nwg % NXCD, xcd = wgid % NXCD, off = wgid / NXCD; wgid = (xcd < r ? xcd * (q + 1) : r * (q + 1) + (xcd - r) * q) + off; }
        const int nig = WGM * nN, gid = wgid / nig, fm = gid * WGM, gsz = (nM - fm) < WGM ? (nM - fm) : WGM;
        u.pm = fm + ((wgid % nig) % gsz); u.pn = (wgid % nig) / gsz; u.ks = 0; return true;
    }
    __device__ __forceinline__ void a_ready(const Unit&) const {}
    __device__ __forceinline__ void done(const Unit&) const {}
};
struct SliceOrder {
    int pm0, nN, nsplit, total, G, c;
    __host__ __device__ void init(int pm0_, int ntm, int N, int nsplit_, int G_, int c_) { pm0 = pm0_; nN = N / BM; nsplit = nsplit_; total = ntm * nN * nsplit_; G = G_; c = c_; }
    __host__ __device__ bool next(int i, Unit& u) const { const int L = i * G + c; if (L >= total) return false; const int tile = L / nsplit; u.ks = L - tile * nsplit; u.pm = pm0 + tile / nN; u.pn = tile % nN; return true; }
    __device__ __forceinline__ void a_ready(const Unit&) const {}
    __device__ __forceinline__ void done(const Unit&) const {}
};
typedef __bf16 bf16x2_native __attribute__((ext_vector_type(2)));
typedef float f32x2_native __attribute__((ext_vector_type(2)));
__device__ __forceinline__ unsigned cvt_pk_bf16(float lo, float hi) { const f32x2_native v = {lo, hi}; const bf16x2_native r = __builtin_convertvector(v, bf16x2_native); return __builtin_bit_cast(unsigned, r); }
typedef float f32x2 __attribute__((ext_vector_type(2)));
template <class Epi, class Sched, bool STAMP = false>
__device__ __forceinline__ void gemm_phase(PG8_LAS unsigned char* lds, const Gemm g, const Sched& S, const Epi& E, unsigned long long* stamps) {
    const int tid = mk_tid(), wid = __builtin_amdgcn_readfirstlane(tid >> 6), lane = tid & 63, wr = wid >> 2, wc = wid & 3, fr = lane & 15, fq = lane >> 4;
    const int K = g.K, nt = K / BK;
    int ts_lo = 0, ts_hi = 0, nts = 0; const unsigned long long rt_entry = STAMP ? (unsigned long long)wall_clock64() : 0ull;
#define PG8_STAMP() do { if (STAMP && wid == 0 && nts < 64) { const unsigned long long _c = (unsigned long long)clock64(); \
        ts_lo = (lane == nts) ? (int)(unsigned)_c : ts_lo; ts_hi = (lane == nts) ? (int)(unsigned)(_c >> 32) : ts_hi; ++nts; } } while (0)
    PG8_STAMP();
    unsigned voffA[2], voffB[2];
#pragma unroll
    for (int i = 0; i < 2; ++i) { int R, C; stage_rc(tid * 16 + i * 8192, R, C); const int Rb = Epi::PERM ? ((R & ~31) + perm32(R & 31)) : R;
        voffA[i] = (unsigned)(R * g.ld + C) * 2u; voffB[i] = (unsigned)(Rb * g.ld + C) * 2u; }
    const size_t kstep = (size_t)(BK * 2);
    const size_t hstep = (size_t)HALF * g.ld * 2;
    const size_t tstep = 2 * hstep;
    const unsigned ldsw = (unsigned)wid * 1024u;
    const int aoff = lds_byte(wr * 64 + fr, fq * 8), boff = lds_byte(wc * 32 + fr, fq * 8);
#define PG8_SA(b, h) (((b) * 2 + (h)) * HTB)
#define PG8_SB(b, h) ((4 + (b) * 2 + (h)) * HTB)
#define PG8_STAGE(bufoff, gbase, voff) do { _Pragma("unroll") for (int _i = 0; _i < 2; ++_i) \
        __builtin_amdgcn_global_load_lds((const unsigned*)((const char*)(gbase) + (voff)[_i]), (PG8_LAS unsigned*)(lds + (bufoff) + ldsw + _i * 8192), 16, 0, 0); } while (0)
#define PG8_LDA(dst, b, h) do { _Pragma("unroll") for (int m = 0; m < 4; ++m) _Pragma("unroll") for (int k = 0; k < 2; ++k) dst[m][k] = *(const PG8_LAS bf16x8*)(lds + PG8_SA(b, h) + aoff + m * 2048 + k * 1024); } while (0)
#define PG8_LDB(dst, b, h) do { _Pragma("unroll") for (int n = 0; n < 2; ++n) _Pragma("unroll") for (int k = 0; k < 2; ++k) dst[n][k] = *(const PG8_LAS bf16x8*)(lds + PG8_SB(b, h) + boff + n * 2048 + k * 1024); } while (0)
#define PG8_MMA(ai, bj, At, Bt) do { __builtin_amdgcn_s_setprio(1); _Pragma("unroll") for (int m = 0; m < 4; ++m) _Pragma("unroll") for (int n = 0; n < 2; ++n) _Pragma("unroll") for (int k = 0; k < 2; ++k) \
        acc[ai][bj][m][n] = __builtin_amdgcn_mfma_f32_16x16x32_bf16(Bt[n][k], At[m][k], acc[ai][bj][m][n], 0, 0, 0); __builtin_amdgcn_s_setprio(0); } while (0)
#define PG8_WAIT_V(n) asm volatile("s_waitcnt vmcnt(" #n ")" ::: "memory")
#define PG8_WAIT_L(n) asm volatile("s_waitcnt lgkmcnt(" #n ")" ::: "memory")
#define PG8_BAR __builtin_amdgcn_s_barrier()
#define PG8_SCHED __builtin_amdgcn_sched_barrier(0)
    Unit cur, nxt; int ui = 0;
    if (!S.next(0, cur)) return;
    f32x4 acc[2][2][4][2];
#pragma unroll
    for (int a = 0; a < 2; ++a)
#pragma unroll
        for (int b = 0; b < 2; ++b)
#pragma unroll
            for (int m = 0; m < 4; ++m)
#pragma unroll
                for (int n = 0; n < 2; ++n) acc[a][b][m][n] = (f32x4){0.f, 0.f, 0.f, 0.f};
    bf16x8 At[4][2], B0[2][2], B1[2][2];
    const char* cA = (const char*)g.A + (size_t)cur.pm * tstep + (size_t)cur.ks * K * 2; const char* cB = (const char*)g.Bt + (size_t)cur.pn * tstep + (size_t)cur.ks * K * 2;
    S.a_ready(cur);
    PG8_STAGE(PG8_SB(0, 0), cB, voffB); PG8_STAGE(PG8_SA(0, 0), cA, voffA); PG8_STAGE(PG8_SB(0, 1), cB + hstep, voffB); PG8_STAGE(PG8_SA(0, 1), cA + hstep, voffA);
    if (wr == 1) PG8_BAR;
    PG8_WAIT_V(4); PG8_BAR;
    PG8_STAGE(PG8_SB(1, 0), cB + kstep, voffB); PG8_STAGE(PG8_SA(1, 0), cA + kstep, voffA); PG8_STAGE(PG8_SB(1, 1), cB + hstep + kstep, voffB);
    PG8_WAIT_V(6); PG8_BAR;
    PG8_STAMP();
    for (;;) {
        const bool has_next = S.next(ui + 1, nxt);
        const char* nA = has_next ? (const char*)g.A + (size_t)nxt.pm * tstep + (size_t)nxt.ks * K * 2 : cA; const char* nB = has_next ? (const char*)g.Bt + (size_t)nxt.pn * tstep + (size_t)nxt.ks * K * 2 : cB;
        for (int t = 0; t < nt; t += 2) {
            const bool last = (t == nt - 2);
            const char* a1 = cA + (size_t)(t + 1) * kstep;
            const char* a2 = last ? nA : cA + (size_t)(t + 2) * kstep; const char* b2 = last ? nB : cB + (size_t)(t + 2) * kstep;
            const char* a3 = a2 + kstep; const char* b3 = b2 + kstep;
            if (last && has_next) S.a_ready(nxt);
            PG8_LDB(B0, 0, 0); PG8_SCHED; PG8_LDA(At, 0, 0); PG8_STAGE(PG8_SA(1, 1), a1 + hstep, voffA);
            PG8_WAIT_L(8); PG8_BAR; PG8_WAIT_L(0); PG8_MMA(0, 0, At, B0); PG8_BAR; PG8_SCHED;
            PG8_LDB(B1, 0, 1); PG8_STAGE(PG8_SB(0, 0), b2, voffB);
            PG8_BAR; PG8_WAIT_L(0); PG8_MMA(0, 1, At, B1); PG8_BAR;
            PG8_LDA(At, 0, 1); PG8_STAGE(PG8_SA(0, 0), a2, voffA);
            PG8_BAR; PG8_WAIT_L(0); PG8_MMA(1, 0, At, B0); PG8_BAR; PG8_SCHED;
            PG8_STAGE(PG8_SB(0, 1), b2 + hstep, voffB);
            PG8_WAIT_V(6); PG8_BAR; PG8_MMA(1, 1, At, B1); PG8_BAR;
            PG8_LDB(B0, 1, 0); PG8_SCHED; PG8_LDA(At, 1, 0); PG8_STAGE(PG8_SA(0, 1), a2 + hstep, voffA);
            PG8_WAIT_L(8); PG8_BAR; PG8_WAIT_L(0); PG8_MMA(0, 0, At, B0); PG8_BAR; PG8_SCHED;
            PG8_LDB(B1, 1, 1); PG8_STAGE(PG8_SB(1, 0), b3, voffB);
            PG8_BAR; PG8_WAIT_L(0); PG8_MMA(0, 1, At, B1); PG8_BAR;
            PG8_LDA(At, 1, 1); PG8_STAGE(PG8_SA(1, 0), a3, voffA);
            PG8_BAR; PG8_WAIT_L(0); PG8_MMA(1, 0, At, B0); PG8_BAR; PG8_SCHED;
            PG8_STAGE(PG8_SB(1, 1), b3 + hstep, voffB);
            PG8_WAIT_V(6); PG8_BAR; PG8_MMA(1, 1, At, B1); PG8_BAR;
        }
        PG8_STAMP();
        if constexpr (!Epi::AFTER_DRAIN) { E(acc, cur, wr, wc, fr, fq); S.done(cur); }
        PG8_STAMP();
        if (!has_next) break;
#pragma unroll
        for (int a = 0; a < 2; ++a)
#pragma unroll
            for (int b = 0; b < 2; ++b)
#pragma unroll
                for (int m = 0; m < 4; ++m)
#pragma unroll
                    for (int n = 0; n < 2; ++n) acc[a][b][m][n] = (f32x4){0.f, 0.f, 0.f, 0.f};
        cur = nxt; cA = nA; cB = nB; ++ui;
    }
    PG8_WAIT_V(0);
    if (wr == 0) PG8_BAR;
    PG8_BAR;
    if constexpr (Epi::AFTER_DRAIN) { E.fused(acc, cur, wr, wc, fr, fq, lds, wid, lane); S.done(cur); }
    PG8_STAMP();
    if (STAMP && wid == 0) { stamps[lane] = lane < nts ? (((unsigned long long)(unsigned)ts_hi << 32) | (unsigned)ts_lo) : 0ull;
        if (lane == 62) stamps[62] = rt_entry; if (lane == 63) stamps[63] = (unsigned long long)wall_clock64(); }
#undef PG8_STAMP
#undef PG8_SA
#undef PG8_SB
#undef PG8_STAGE
#undef PG8_LDA
#undef PG8_LDB
#undef PG8_MMA
#undef PG8_WAIT_V
#undef PG8_WAIT_L
#undef PG8_BAR
#undef PG8_SCHED
}
}

using pg8::bf16_t; using pg8::bf16x8; using pg8::f32x4; using pg8::u32x4;
#define LAS __attribute__((address_space(3)))
typedef unsigned u32x2 __attribute__((ext_vector_type(2)));
typedef short bf16x4 __attribute__((ext_vector_type(4)));

#define XB_TMO      128
#define XB_XCNT(j)  (256  + 64 * (j))
#define XB_XSUB(j)  (1280 + 64 * (j))
#define XB_XGEN(j)  (2304 + 64 * (j))
#define XB_TOP      3328
#define XB_TOPGEN   3392
#define XCD_BAR_WORDS 3456
#define XB_SPIN_CAP (1u << 18)

__device__ __forceinline__ unsigned xb_ld(unsigned* p)              { return __hip_atomic_load(p, __ATOMIC_RELAXED, __HIP_MEMORY_SCOPE_AGENT); }
__device__ __forceinline__ unsigned xb_add(unsigned* p, unsigned v) { return __hip_atomic_fetch_add(p, v, __ATOMIC_RELAXED, __HIP_MEMORY_SCOPE_AGENT); }
__device__ __forceinline__ unsigned xb_xcc_id() { return (unsigned)__builtin_amdgcn_s_getreg((3 << 11) | 20) & 0xFu; }
#define XB_SPIN(cond, bar) do { unsigned _sp = 0; while (cond) { __builtin_amdgcn_s_sleep(1); \
    if ((++_sp & 255u) == 0u) { if (xb_ld(&(bar)[XB_TMO])) break; if (_sp > XB_SPIN_CAP) { atomicAdd(&(bar)[XB_TMO], 1u); break; } } } } while (0)

struct XcdBarrier {
    unsigned* bar; unsigned x;
    volatile LAS unsigned* st;
};

__device__ __forceinline__ XcdBarrier xcd_barrier_post(unsigned* bar, volatile LAS unsigned* st) {
    XcdBarrier b; b.bar = bar; b.x = xb_xcc_id(); b.st = st;
    if (threadIdx.x == 0) (void)xb_add(&bar[XB_XCNT(b.x)], 1u);
    return b;
}
__device__ __forceinline__ void xcd_barrier_complete(unsigned* bar, unsigned x, unsigned& nloc, unsigned& nx) {
    const unsigned G = gridDim.x * gridDim.y * gridDim.z;
    unsigned sum, cnt, mine, sp = 0u;
    for (;;) {
        sum = 0u; cnt = 0u; mine = 0u;
#pragma unroll
        for (unsigned j = 0; j < 16; ++j) { const unsigned c = xb_ld(&bar[XB_XCNT(j)]); sum += c; cnt += (c > 0u) ? 1u : 0u; mine = (j == x) ? c : mine; }
        if (sum == G) break;
        __builtin_amdgcn_s_sleep(1);
        if ((++sp & 255u) == 0u) { if (xb_ld(&bar[XB_TMO])) break; if (sp > XB_SPIN_CAP) { atomicAdd(&bar[XB_TMO], 1u); break; } }
    }
    nloc = mine > 0u ? mine : 1u; nx = cnt > 0u ? cnt : 1u;
}

__device__ __forceinline__ void xcd_barrier(const XcdBarrier& b) {
    asm volatile("s_waitcnt vmcnt(0)" ::: "memory");
    __syncthreads();
    if (threadIdx.x == 0) {
        unsigned* bar = b.bar;
        __builtin_amdgcn_s_waitcnt(0);
        unsigned nloc = b.st[0], nx = b.st[1];
        if (nloc == 0u) { xcd_barrier_complete(bar, b.x, nloc, nx); b.st[0] = nloc; b.st[1] = nx; }
        const unsigned old = xb_add(&bar[XB_XSUB(b.x)], 1u);
        const unsigned gen = old / nloc;
        if (old + 1u == (gen + 1u) * nloc) {
            __builtin_amdgcn_fence(__ATOMIC_RELEASE, "agent");
            asm volatile("s_waitcnt vmcnt(0)" ::: "memory");
            const unsigned og = xb_add(&bar[XB_TOP], 1u);
            const unsigned tg = og / nx;
            if (og + 1u == (tg + 1u) * nx) xb_add(&bar[XB_TOPGEN], 1u);
            else XB_SPIN(xb_ld(&bar[XB_TOPGEN]) == tg, bar);
            __builtin_amdgcn_fence(__ATOMIC_ACQUIRE, "agent");
            xb_add(&bar[XB_XGEN(b.x)], 1u);
            asm volatile("s_waitcnt vmcnt(0)" ::: "memory");
        } else {
            XB_SPIN(xb_ld(&bar[XB_XGEN(b.x)]) == gen, bar);
            __builtin_amdgcn_fence(__ATOMIC_ACQUIRE, "agent");
            asm volatile("s_waitcnt vmcnt(0)" ::: "memory");
        }
    }
    __syncthreads();
}

constexpr int DM = 1024, ML = 16384, MC = 2048, MT = 18432, FH = 2816;
constexpr int LDS_BYTES = 152 * 1024 + 256;
constexpr int NPH = 42;

constexpr size_t WS_H    = 0;
constexpr size_t WS_A    = WS_H + (size_t)MT * DM * 4;
constexpr size_t WS_P    = WS_A + (size_t)MT * DM * 2;
constexpr size_t WS_WFI  = WS_P + (size_t)MT * 3072 * 2;
constexpr size_t WS_WFO  = WS_WFI + 4ull * 5632 * 1024 * 2;
constexpr size_t WS_WO   = WS_WFO + 4ull * 1024 * 2816 * 2;
constexpr size_t WS_WAB  = WS_WO + 4ull * 1024 * 1024 * 2;
constexpr size_t WS_WCD  = WS_WAB + 2ull * 3072 * 1024 * 2;
constexpr size_t WS_WGLU = WS_WCD + 2ull * 2304 * 1024 * 2;
constexpr size_t WS_WU   = WS_WGLU + 2ull * 512 * 512 * 2;
constexpr size_t WS_MOD  = WS_WU + 2ull * 1792 * 640 * 2;
constexpr size_t WS_ROPE = WS_MOD + 4ull * 9 * 6144 * 4;
constexpr size_t WS_S5A  = WS_ROPE + 64 * 16 * 2 * 4;
constexpr size_t WS_S5BB = WS_S5A + 2ull * 2 * 32 * 64 * 4 * 4;
constexpr size_t WS_S5CC = WS_S5BB + 2ull * 2 * 32 * 2 * 64 * 16 * 2;
constexpr size_t WS_LB   = WS_S5CC + 2ull * 2 * 32 * 4 * 16 * 32 * 2;
constexpr size_t WS_TAB  = WS_LB + 2 * 512 * 4;
constexpr size_t WS_SS   = (WS_TAB + 64 * 8 + 255) & ~(size_t)255;
constexpr size_t WS_BAR  = WS_SS + 8ull * MT * 4;
constexpr size_t WS_BIAS = WS_BAR + XCD_BAR_WORDS * 4;
constexpr size_t WS_X    = WS_BIAS + 4ull * 9 * 8704 * 4;
constexpr size_t WS_HB1  = WS_X;
constexpr size_t WS_OF   = WS_X;
constexpr size_t WS_OB   = WS_OF + (size_t)MT * 512 * 2;
constexpr size_t WS_Z    = WS_OB + (size_t)MT * 512 * 2;
constexpr size_t WS_E    = WS_Z + (size_t)MT * 512 * 2;
constexpr size_t WS_E63  = WS_E + 8ull * 2 * 36 * 32 * 128 * 4;
constexpr size_t WS_END_EVEN = WS_E63 + 2ull * 288 * 4 * 128 * 2;
constexpr size_t WS_Q1   = WS_A;
constexpr size_t WS_VT1  = WS_A + (size_t)MT * 512 * 2;
constexpr size_t WS_U    = WS_X;
constexpr size_t WS_END_ODD = WS_U + (size_t)MT * 1792 * 2;
constexpr size_t WS_NEED = WS_END_EVEN > WS_END_ODD ? WS_END_EVEN : WS_END_ODD;
static_assert(WS_NEED <= 402653184ull, "workspace too large");

struct Params { const float* in[34]; float* out; unsigned char* ws; int ph_lo, ph_hi; };
struct Ctx { unsigned char* ws; const float* const* in; float* out; };

__device__ __forceinline__ float bf2f(unsigned v) { return __uint_as_float(v << 16); }
__device__ __forceinline__ float bflo(unsigned w) { return __uint_as_float(w << 16); }
__device__ __forceinline__ float bfhi(unsigned w) { return __uint_as_float(w & 0xffff0000u); }
__device__ __forceinline__ unsigned pk2(float lo, float hi) { return pg8::cvt_pk_bf16(lo, hi); }
__device__ __forceinline__ bf16_t f2bf(float f) { unsigned u = __float_as_uint(f); u += 0x7FFFu + ((u >> 16) & 1u); return (bf16_t)(u >> 16); }
__device__ __forceinline__ float wsum(float v) {
#pragma unroll
    for (int o = 32; o >= 1; o >>= 1) v += __shfl_xor(v, o);
    return v; }
__device__ __forceinline__ float rcpf_(float x) { return __builtin_amdgcn_rcpf(x); }
__device__ __forceinline__ float siluf(float x) { return x * rcpf_(1.0f + __expf(-x)); }
__device__ __forceinline__ bf16x8 mk8(unsigned a, unsigned b, unsigned c, unsigned d) { u32x4 w = {a, b, c, d}; return __builtin_bit_cast(bf16x8, w); }
__device__ __forceinline__ bf16x8 zero8() { return mk8(0u, 0u, 0u, 0u); }
#define MFMA(a, b, c) __builtin_amdgcn_mfma_f32_16x16x32_bf16((a), (b), (c), 0, 0, 0)

__device__ __forceinline__ double dexp(double x) {
    const double y = x * (1.0 / 64.0); double s = 1.0, t = 1.0;
#pragma unroll
    for (int i = 1; i <= 13; ++i) { t *= y * (1.0 / (double)i); s += t; }
#pragma unroll
    for (int i = 0; i < 6; ++i) s *= s;
    return s; }
__device__ __forceinline__ void dsincos(double x, double& sn, double& cs) {
    const double TWO_PI = 6.283185307179586476925287; const double k = rint(x * (1.0 / TWO_PI)); const double r = (x - k * TWO_PI) * 0.125;
    const double r2 = r * r; double s = r, t = r, c = 1.0, u = 1.0;
#pragma unroll
    for (int i = 1; i <= 7; ++i) { t *= -r2 * (1.0 / (double)((2 * i) * (2 * i + 1))); s += t; u *= -r2 * (1.0 / (double)((2 * i - 1) * (2 * i))); c += u; }
#pragma unroll
    for (int i = 0; i < 3; ++i) { const double s2 = 2.0 * s * c, c2 = c * c - s * s; s = s2; c = c2; }
    sn = s; cs = c; }

struct EpiRes {
    static constexpr bool PERM = false, AFTER_DRAIN = false;
    float* H; const float* gate; float* out;
    bf16_t* Hb; const float* gn; const float* scn; float* ss;
    __device__ __forceinline__ void operator()(const f32x4 (&acc)[2][2][4][2], const pg8::Unit& u, int wr, int wc, int fr, int fq) const {
        const int r = u.pm < 64 ? (u.pm >> 3) : 8;
        const int row0 = u.pm * 256 + wr * 64 + fr, col0 = u.pn * 256 + wc * 32 + 4 * fq;
        const float* gp = gate + r * 6144 + col0;
        f32x4 gv[2][2], gs[2][2];
#pragma unroll
        for (int bj = 0; bj < 2; ++bj)
#pragma unroll
            for (int n = 0; n < 2; ++n) { const int co = bj * 128 + n * 16; gv[bj][n] = *(const f32x4*)(gp + co); gs[bj][n] = (f32x4){0.f, 0.f, 0.f, 0.f};
                if (Hb != nullptr) gs[bj][n] = *(const f32x4*)(gn + col0 + co) * (*(const f32x4*)(scn + r * 6144 + col0 + co) + 1.0f); }
#pragma unroll
        for (int am = 0; am < 4; ++am) { const int ai = am >> 1, m0 = (am & 1) * 2;
            f32x4 hv[2][2][2];
#pragma unroll
            for (int mm = 0; mm < 2; ++mm)
#pragma unroll
                for (int bj = 0; bj < 2; ++bj)
#pragma unroll
                    for (int n = 0; n < 2; ++n) hv[mm][bj][n] = *(const f32x4*)(H + (size_t)(row0 + ai * 128 + (m0 + mm) * 16) * 1024 + col0 + bj * 128 + n * 16);
            asm volatile("" ::: "memory");
#pragma unroll
            for (int mm = 0; mm < 2; ++mm) { const int m = m0 + mm; const int row = row0 + ai * 128 + m * 16; float sq = 0.f;
#pragma unroll
                for (int bj = 0; bj < 2; ++bj)
#pragma unroll
                    for (int n = 0; n < 2; ++n) { const size_t off = (size_t)row * 1024 + col0 + bj * 128 + n * 16;
                        const f32x4 v = hv[mm][bj][n] + gv[bj][n] * acc[ai][bj][m][n];
                        if (out == nullptr) *(f32x4*)(H + off) = v; else if (u.pm < 64) *(f32x4*)(out + off) = v;
                        if (Hb != nullptr) { sq += v[0] * v[0] + v[1] * v[1] + v[2] * v[2] + v[3] * v[3]; const f32x4 hb = v * gs[bj][n];
                            u32x2 w; w.x = pk2(hb[0], hb[1]); w.y = pk2(hb[2], hb[3]); *(u32x2*)(Hb + off) = w; } }
                if (Hb != nullptr) { sq += __shfl_xor(sq, 16); sq += __shfl_xor(sq, 32); if (fq == 0) (void)__hip_atomic_fetch_add(ss + row, sq, __ATOMIC_RELAXED, __HIP_MEMORY_SCOPE_AGENT); } }
            asm volatile("" ::: "memory");
        }
    }
};
template <bool NORM> struct EpiStore {
    static constexpr bool PERM = true, AFTER_DRAIN = false;
    bf16_t* O; int ldc; const float* ss; const float* bias;
    __device__ __forceinline__ void operator()(const f32x4 (&acc)[2][2][4][2], const pg8::Unit& u, int wr, int wc, int fr, int fq) const {
        const int row0 = u.pm * 256 + wr * 64 + fr, col0 = u.pn * 256 + wc * 32 + 8 * fq;
        const int r = u.pm < 64 ? (u.pm >> 3) : 8;
        f32x4 bv[2][2];
#pragma unroll
        for (int bj = 0; bj < 2; ++bj)
#pragma unroll
            for (int n = 0; n < 2; ++n) bv[bj][n] = NORM ? *(const f32x4*)(bias + r * 8704 + col0 + bj * 128 + 4 * n) : (f32x4){0.f, 0.f, 0.f, 0.f};
        float rsv[2][4];
#pragma unroll
        for (int ai = 0; ai < 2; ++ai)
#pragma unroll
            for (int m = 0; m < 4; ++m) rsv[ai][m] = NORM ? ss[row0 + ai * 128 + m * 16] : 1.0f;
        asm volatile("" ::: "memory");
#pragma unroll
        for (int ai = 0; ai < 2; ++ai)
#pragma unroll
            for (int m = 0; m < 4; ++m) { const int row = row0 + ai * 128 + m * 16; bf16_t* rowp = O + (size_t)row * ldc + col0;
                const float rs = NORM ? rsqrtf(rsv[ai][m] * (1.0f / 1024.0f) + 1e-6f) : 1.0f;
#pragma unroll
                for (int bj = 0; bj < 2; ++bj) { const f32x4 v0 = acc[ai][bj][m][0] * rs + bv[bj][0], v1 = acc[ai][bj][m][1] * rs + bv[bj][1];
                    u32x4 w; w.x = pk2(v0[0], v0[1]); w.y = pk2(v0[2], v0[3]); w.z = pk2(v1[0], v1[1]); w.w = pk2(v1[2], v1[3]);
                    *(u32x4*)(rowp + bj * 128) = w; } }
    }
};
struct EpiSwiGLU {
    static constexpr bool PERM = true, AFTER_DRAIN = false;
    bf16_t* G; const float* ss; const float* bias;
    __device__ __forceinline__ void operator()(const f32x4 (&acc)[2][2][4][2], const pg8::Unit& u, int wr, int wc, int fr, int fq) const {
        const int row0 = u.pm * 256 + wr * 64 + fr, col0 = u.pn * 128 + wc * 32 + 8 * fq;
        const int r = u.pm < 64 ? (u.pm >> 3) : 8;
        const float* bp = bias + r * 8704 + u.pn * 256 + wc * 32 + 8 * fq;
        const f32x4 bg0 = *(const f32x4*)bp, bg1 = *(const f32x4*)(bp + 4), bu0 = *(const f32x4*)(bp + 128), bu1 = *(const f32x4*)(bp + 132);
        float rsv[2][4];
#pragma unroll
        for (int ai = 0; ai < 2; ++ai)
#pragma unroll
            for (int m = 0; m < 4; ++m) rsv[ai][m] = ss[row0 + ai * 128 + m * 16];
        asm volatile("" ::: "memory");
#pragma unroll
        for (int ai = 0; ai < 2; ++ai)
#pragma unroll
            for (int m = 0; m < 4; ++m) { const int row = row0 + ai * 128 + m * 16; bf16_t* rowp = G + (size_t)row * FH + col0;
                const float rs = rsqrtf(rsv[ai][m] * (1.0f / 1024.0f) + 1e-6f);
                const f32x4 g0 = acc[ai][0][m][0] * rs + bg0, g1 = acc[ai][0][m][1] * rs + bg1, u0 = acc[ai][1][m][0] * rs + bu0, u1 = acc[ai][1][m][1] * rs + bu1;
                u32x4 w; w.x = pk2(siluf(g0[0]) * u0[0], siluf(g0[1]) * u0[1]); w.y = pk2(siluf(g0[2]) * u0[2], siluf(g0[3]) * u0[3]);
                w.z = pk2(siluf(g1[0]) * u1[0], siluf(g1[1]) * u1[1]); w.w = pk2(siluf(g1[2]) * u1[2], siluf(g1[3]) * u1[3]);
                *(u32x4*)rowp = w; }
    }
};
struct EpiGLU {
    static constexpr bool PERM = true, AFTER_DRAIN = false;
    bf16_t* MX; const bf16_t* Z; const float* bias;
    __device__ __forceinline__ void operator()(const f32x4 (&acc)[2][2][4][2], const pg8::Unit& u, int wr, int wc, int fr, int fq) const {
        const int row0 = u.pm * 256 + wr * 64 + fr, col0 = u.pn * 256 + wc * 32 + 8 * fq;
        f32x4 b0[2], b1[2];
#pragma unroll
        for (int bj = 0; bj < 2; ++bj) { b0[bj] = *(const f32x4*)(bias + col0 + bj * 128); b1[bj] = *(const f32x4*)(bias + col0 + bj * 128 + 4); }
#pragma unroll
        for (int ai = 0; ai < 2; ++ai) {
            u32x4 zz[4][2];
#pragma unroll
            for (int m = 0; m < 4; ++m)
#pragma unroll
                for (int bj = 0; bj < 2; ++bj) zz[m][bj] = *(const u32x4*)(Z + (size_t)(row0 + ai * 128 + m * 16) * 512 + col0 + bj * 128);
            asm volatile("" ::: "memory");
#pragma unroll
            for (int m = 0; m < 4; ++m) { const int row = row0 + ai * 128 + m * 16;
#pragma unroll
                for (int bj = 0; bj < 2; ++bj) { const int col = col0 + bj * 128; const u32x4 z = zz[m][bj];
                    const f32x4 v0 = acc[ai][bj][m][0] + b0[bj], v1 = acc[ai][bj][m][1] + b1[bj];
                    u32x4 w;
                    w.x = pk2(bflo(z.x) * rcpf_(1.f + __expf(-v0[0])), bfhi(z.x) * rcpf_(1.f + __expf(-v0[1])));
                    w.y = pk2(bflo(z.y) * rcpf_(1.f + __expf(-v0[2])), bfhi(z.y) * rcpf_(1.f + __expf(-v0[3])));
                    w.z = pk2(bflo(z.z) * rcpf_(1.f + __expf(-v1[0])), bfhi(z.z) * rcpf_(1.f + __expf(-v1[1])));
                    w.w = pk2(bflo(z.w) * rcpf_(1.f + __expf(-v1[2])), bfhi(z.w) * rcpf_(1.f + __expf(-v1[3])));
                    *(u32x4*)(MX + (size_t)row * 1024 + col) = w; } }
            asm volatile("" ::: "memory");
        }
    }
};

template <class Epi> __device__ __forceinline__ void run_gemm(LAS unsigned char* lds, const bf16_t* A, const bf16_t* Bt, int M, int N, int K, const Epi& E) {
    pg8::Gemm g; g.A = A; g.Bt = Bt; g.M = M; g.N = N; g.K = K; g.ld = K;
    pg8::StaticOrder S; S.init(M, N, (int)gridDim.x, (int)blockIdx.x);
    pg8::gemm_phase<Epi, pg8::StaticOrder, false>(lds, g, S, E, nullptr);
}

struct EpiResAtomic {
    static constexpr bool PERM = false, AFTER_DRAIN = false;
    float* H; const float* gate;
    __device__ __forceinline__ void operator()(const f32x4 (&acc)[2][2][4][2], const pg8::Unit& u, int wr, int wc, int fr, int fq) const {
        const int r = u.pm < 64 ? (u.pm >> 3) : 8;
        const int row0 = u.pm * 256 + wr * 64 + fr, col0 = u.pn * 256 + wc * 32 + 4 * fq;
        const float* gp = gate + r * 6144 + col0;
        f32x4 gv[2][2];
#pragma unroll
        for (int bj = 0; bj < 2; ++bj)
#pragma unroll
            for (int n = 0; n < 2; ++n) gv[bj][n] = *(const f32x4*)(gp + bj * 128 + n * 16);
#pragma unroll
        for (int ai = 0; ai < 2; ++ai)
#pragma unroll
            for (int m = 0; m < 4; ++m) { const size_t off = (size_t)(row0 + ai * 128 + m * 16) * 1024 + col0;
#pragma unroll
                for (int bj = 0; bj < 2; ++bj)
#pragma unroll
                    for (int n = 0; n < 2; ++n) { float* pp = H + off + bj * 128 + n * 16; const f32x4 v = gv[bj][n] * acc[ai][bj][m][n];
#pragma unroll
                        for (int q = 0; q < 4; ++q) (void)__hip_atomic_fetch_add(pp + q, v[q], __ATOMIC_RELAXED, __HIP_MEMORY_SCOPE_AGENT); } }
    }
};
template <class Epi> __device__ __forceinline__ void run_gemm_slices(LAS unsigned char* lds, const bf16_t* A, const bf16_t* Bt, int Kfull, int nsplit, const Epi& E) {
    pg8::Gemm g; g.A = A; g.Bt = Bt; g.M = MT; g.N = 1024; g.K = Kfull / nsplit; g.ld = Kfull;
    pg8::SliceOrder S; S.init(64, 8, 1024, nsplit, (int)gridDim.x, (int)blockIdx.x);
    pg8::gemm_phase<Epi, pg8::SliceOrder, false>(lds, g, S, E, nullptr);
}

__device__ __forceinline__ void tr_job(const float* __restrict__ src, bf16_t* __restrict__ dst, int ldd, int K, int N, int mode, int& rot, LAS float* tile) {
    const int tid = mk_tid(), nb = gridDim.x, tn = (N + 255) / 256, nt = (K / 64) * tn;
    const int start = (int)((blockIdx.x + nb - (rot % nb)) % nb); rot += nt;
    const int c4 = (tid & 15) * 4, r0 = tid >> 4;
    float4 v[8], vn[8];
    auto ld = [&](int t, float4 (&x)[8]) { const int k0 = (t / tn) * 64, n0 = (t % tn) * 256;
#pragma unroll
        for (int i = 0; i < 2; ++i)
#pragma unroll
            for (int j = 0; j < 4; ++j) { const int nn = n0 + c4 + 64 * j; x[i * 4 + j] = nn < N ? *(const float4*)(src + (size_t)(k0 + r0 + 32 * i) * N + nn) : (float4){0.f, 0.f, 0.f, 0.f}; } };
#pragma unroll
    for (int q = 0; q < 8; ++q) { v[q] = (float4){0.f, 0.f, 0.f, 0.f}; vn[q] = (float4){0.f, 0.f, 0.f, 0.f}; }
    if (start < nt) ld(start, v);
    if (start + nb < nt) ld(start + nb, vn);
    for (int t = start; t < nt; t += nb) {
        const int k0 = (t / tn) * 64, n0 = (t % tn) * 256;
#pragma unroll
        for (int i = 0; i < 2; ++i)
#pragma unroll
            for (int j = 0; j < 4; ++j) { LAS float* tp = tile + (r0 + 32 * i) * 257 + c4 + 64 * j; tp[0] = v[i * 4 + j].x; tp[1] = v[i * 4 + j].y; tp[2] = v[i * 4 + j].z; tp[3] = v[i * 4 + j].w; }
        __syncthreads();
#pragma unroll
        for (int q = 0; q < 8; ++q) v[q] = vn[q];
        if (t + 2 * nb < nt) ld(t + 2 * nb, vn);
        { const int n = tid >> 1, kh = (tid & 1) * 32; const int nn = n0 + n;
          if (nn < N) {
              const int drow = mode == 0 ? nn : (nn < FH ? (nn / 128) * 256 + (nn % 128) : ((nn - FH) / 128) * 256 + 128 + ((nn - FH) % 128));
#pragma unroll
              for (int q = 0; q < 4; ++q) { const int k8 = kh + q * 8;
                  u32x4 w; w.x = pk2(tile[(k8 + 0) * 257 + n], tile[(k8 + 1) * 257 + n]); w.y = pk2(tile[(k8 + 2) * 257 + n], tile[(k8 + 3) * 257 + n]);
                  w.z = pk2(tile[(k8 + 4) * 257 + n], tile[(k8 + 5) * 257 + n]); w.w = pk2(tile[(k8 + 6) * 257 + n], tile[(k8 + 7) * 257 + n]);
                  *(u32x4*)(dst + (size_t)drow * ldd + k0 + k8) = w; } } }
        __syncthreads();
    }
}

__device__ __forceinline__ void prep_phase(const Ctx& p, LAS unsigned char* lds, int part) {
    const int tid = mk_tid(), nb = gridDim.x, bid = blockIdx.x;
    unsigned char* ws = p.ws;
    if (part != 2) { LAS float* tile = (LAS float*)lds; int rot = 0;
      for (int l = 0; l < 4; ++l) {
          tr_job(p.in[9] + (size_t)l * 1024 * 5632, (bf16_t*)(ws + WS_WFI) + (size_t)l * 5632 * 1024, 1024, 1024, 5632, 1, rot, tile);
          tr_job(p.in[10] + (size_t)l * 2816 * 1024, (bf16_t*)(ws + WS_WFO) + (size_t)l * 1024 * 2816, 2816, 2816, 1024, 0, rot, tile);
          tr_job(p.in[8] + (size_t)l * 1024 * 1024, (bf16_t*)(ws + WS_WO) + (size_t)l * 1024 * 1024, 1024, 1024, 1024, 0, rot, tile); }
      for (int e = 0; e < 2; ++e) {
          tr_job(p.in[11] + (size_t)e * 1024 * 3072, (bf16_t*)(ws + WS_WAB) + (size_t)e * 3072 * 1024, 1024, 1024, 3072, 0, rot, tile);
          tr_job(p.in[20] + (size_t)e * 512 * 512, (bf16_t*)(ws + WS_WGLU) + (size_t)e * 512 * 512, 512, 512, 512, 0, rot, tile);
          tr_job(p.in[24] + (size_t)e * 1024 * 2240, (bf16_t*)(ws + WS_WCD) + (size_t)e * 2304 * 1024, 1024, 1024, 2240, 0, rot, tile);
          tr_job(p.in[30] + (size_t)e * 384 * 768, (bf16_t*)(ws + WS_WU) + (size_t)e * 1792 * 640, 640, 384, 768, 0, rot, tile);
          tr_job(p.in[31] + (size_t)e * 256 * 1024, (bf16_t*)(ws + WS_WU) + (size_t)e * 1792 * 640 + 768 * 640 + 384, 640, 256, 1024, 0, rot, tile); } }
    if (part == 1) return;
    if (part != 3) {
        LAS float* red = (LAS float*)lds;
        LAS float* sc = (LAS float*)(lds + 73728);
        __syncthreads();
        for (int i = tid; i < 9 * 1024; i += 512) { const int r = i >> 10, k = i & 1023; const float v = r < 8 ? p.in[1][r * 1024 + k] : p.in[3][k]; sc[i] = siluf(v); }
        __syncthreads();
        for (int u = bid; u < 192; u += nb) {
            const int l = u / 48, n0 = (u % 48) * 128, cg4 = (tid & 31) * 4, ks = tid >> 5;
            const float* w = p.in[4] + (size_t)l * 1024 * 6144 + n0 + cg4;
            f32x4 a[9];
#pragma unroll
            for (int r = 0; r < 9; ++r) a[r] = (f32x4){0.f, 0.f, 0.f, 0.f};
#pragma unroll 1
            for (int k0 = ks * 64; k0 < ks * 64 + 64; k0 += 16) {
                f32x4 wv[16];
#pragma unroll
                for (int j = 0; j < 16; ++j) wv[j] = *(const f32x4*)(w + (size_t)(k0 + j) * 6144);
#pragma unroll
                for (int j = 0; j < 16; ++j)
#pragma unroll
                    for (int r = 0; r < 9; ++r) a[r] += wv[j] * sc[r * 1024 + k0 + j];
            }
#pragma unroll
            for (int r = 0; r < 9; ++r) *(LAS f32x4*)(red + (ks * 9 + r) * 128 + cg4) = a[r];
            __syncthreads();
            for (int i = tid; i < 9 * 128; i += 512) { const int r = i >> 7, c = i & 127; float v = p.in[5][l * 6144 + n0 + c];
#pragma unroll
                for (int q = 0; q < 16; ++q) v += red[(q * 9 + r) * 128 + c];
                ((float*)(ws + WS_MOD))[((size_t)l * 9 + r) * 6144 + n0 + c] = v; }
            __syncthreads();
        }
    }
    const int gt = bid * 512 + tid, gs = nb * 512;
    for (int i = gt; i < 2 * 73728; i += gs) {
        const int o = i / 73728, r = i % 73728; bf16_t* wb = (bf16_t*)(ws + WS_WU) + (size_t)o * 1792 * 640; u32x4 zz = {0u, 0u, 0u, 0u};
        if (r < 768 * 32) *(u32x4*)(wb + (size_t)(r >> 5) * 640 + 384 + (r & 31) * 8) = zz;
        else { const int r2 = r - 768 * 32; *(u32x4*)(wb + (size_t)(768 + r2 / 48) * 640 + (r2 % 48) * 8) = zz; } }
    for (int i = gt; i < 1024; i += gs) {
        const int pos = i >> 4, f = i & 15; const double inv = dexp(-(double)f * (9.210340371976182736 / 16.0)); double sn, cs; dsincos((double)pos * inv, sn, cs);
        ((float*)(ws + WS_ROPE))[i * 2] = (float)cs; ((float*)(ws + WS_ROPE))[i * 2 + 1] = (float)sn; }
    for (int i = gt; i < 1024; i += gs) {
        const int e = i >> 9, j = i & 511; float v = 0.f;
        if (e == 1) v = 1.0f / (1.0f + expf(p.in[22][j] - p.in[22][512 + j]));
        ((float*)(ws + WS_LB))[i] = v; }
    for (int i = gt; i < 2 * 2 * 32 * 64; i += gs) {
        const int pp = i & 63, idx = i >> 6;
        const double lr = (double)fminf(p.in[12][i], -1e-4f), li = (double)p.in[13][i], step = dexp((double)p.in[14][idx]);
        const double mag = dexp(lr * step); double sn, cs; dsincos(li * step, sn, cs);
        const double ar = mag * cs, ai = mag * sn, iden = 1.0 / (lr * lr + li * li);
        const double cr = ((ar - 1.0) * lr + ai * li) * iden, ci = (ai * lr - (ar - 1.0) * li) * iden;
        double pr = ar, pi = ai;
#pragma unroll
        for (int s = 0; s < 5; ++s) { const double nr = pr * pr - pi * pi, ni = 2.0 * pr * pi; pr = nr; pi = ni; }
        float4 o; o.x = (float)ar; o.y = (float)ai; o.z = (float)pr; o.w = (float)pi; ((float4*)(ws + WS_S5A))[i] = o;
        bf16_t* bbr = (bf16_t*)(ws + WS_S5BB) + ((size_t)idx * 2 + 0) * 1024 + pp * 16; bf16_t* bbi = bbr + 1024;
        const float* bre = p.in[15] + (size_t)i * 16; const float* bim = p.in[16] + (size_t)i * 16;
#pragma unroll
        for (int c = 0; c < 16; ++c) { const double br = bre[c], bi = bim[c]; bbr[c] = f2bf((float)(cr * br - ci * bi)); bbi[c] = f2bf((float)(cr * bi + ci * br)); } }
    for (int i = gt; i < 2 * 2 * 32 * 4 * 16 * 32; i += gs) {
        const int slot = i & 31, c = (i >> 5) & 15, kk = (i >> 9) & 3, idx = i >> 11;
        const int quad = slot >> 3, j8 = slot & 7, st = 16 * (2 * (kk & 1) + (j8 >> 2)) + quad * 4 + (j8 & 3);
        const float v = kk < 2 ? p.in[17][((size_t)idx * 16 + c) * 64 + st] : -p.in[18][((size_t)idx * 16 + c) * 64 + st];
        ((bf16_t*)(ws + WS_S5CC))[i] = f2bf(v); }
}

__device__ __forceinline__ void prep2_phase(const Ctx& p, LAS unsigned char* lds) {
    const int tid = mk_tid(), lane = tid & 63, w = tid >> 6, nb = gridDim.x, bid = blockIdx.x;
    unsigned char* ws = p.ws;
    LAS float* sh = (LAS float*)lds;
    {
        const int job = bid & 7, l = job >> 1, kind = job & 1;
        const int grp = bid >> 3, ngrp = (nb + 7 - job) >> 3;
        const float* mod = (const float*)(ws + WS_MOD) + (size_t)l * 9 * 6144 + (kind ? 3 : 0) * 1024;
        for (int i = tid; i < 9 * 1024; i += 512) sh[i] = mod[(i >> 10) * 6144 + (i & 1023)];
        __syncthreads();
        const bf16_t* W; int nrows;
        if (kind) { W = (const bf16_t*)(ws + WS_WFI) + (size_t)l * 5632 * 1024; nrows = 5632; }
        else if (l & 1) { W = (const bf16_t*)(ws + WS_WCD) + (size_t)(l >> 1) * 2304 * 1024; nrows = 2304; }
        else { W = (const bf16_t*)(ws + WS_WAB) + (size_t)(l >> 1) * 3072 * 1024; nrows = 3072; }
        float* bo = (float*)(ws + WS_BIAS) + (size_t)l * 9 * 8704 + (kind ? 3072 : 0);
        const int rstride = ngrp * 8;
        for (int rowq = grp * 8 + w; rowq < nrows; rowq += rstride * 4) {
          u32x2 wq[4][4];
#pragma unroll
          for (int q4 = 0; q4 < 4; ++q4) { const int rr = rowq + q4 * rstride < nrows ? rowq + q4 * rstride : rowq;
#pragma unroll
              for (int q = 0; q < 4; ++q) wq[q4][q] = *(const u32x2*)(W + (size_t)rr * 1024 + 256 * q + lane * 4); }
#pragma unroll
          for (int q4 = 0; q4 < 4; ++q4) { const int row = rowq + q4 * rstride; if (row >= nrows) break;
            float wv[16];
#pragma unroll
            for (int q = 0; q < 4; ++q) { wv[4 * q] = bflo(wq[q4][q].x); wv[4 * q + 1] = bfhi(wq[q4][q].x); wv[4 * q + 2] = bflo(wq[q4][q].y); wv[4 * q + 3] = bfhi(wq[q4][q].y); }
#pragma unroll
            for (int r = 0; r < 9; ++r) { float a = 0.f;
#pragma unroll
                for (int q = 0; q < 4; ++q) { const f32x4 s4 = *(const LAS f32x4*)(sh + r * 1024 + 256 * q + lane * 4); a += s4[0] * wv[4 * q] + s4[1] * wv[4 * q + 1] + s4[2] * wv[4 * q + 2] + s4[3] * wv[4 * q + 3]; }
                a = wsum(a); if (lane == 0) bo[r * 8704 + row] = a; }
          }
        }
    }
    { const int wg = bid * 8 + w, nw = nb * 8; float* H = (float*)(ws + WS_H); bf16_t* A = (bf16_t*)(ws + WS_A); float* ss = (float*)(ws + WS_SS);
      const float* gw = p.in[6]; const float* mod0 = (const float*)(ws + WS_MOD);
      float4 g[4];
#pragma unroll
      for (int i = 0; i < 4; ++i) g[i] = *(const float4*)(gw + 4 * (lane + 64 * i));
      for (int row = wg; row < MT; row += nw) {
          const float4* src = row < ML ? (const float4*)(p.in[0] + (size_t)row * 1024) : (const float4*)(p.in[2] + (size_t)(row - ML) * 1024);
          float4* dst = (float4*)(H + (size_t)row * 1024); const int r = row < ML ? (row >> 11) : 8; const float* sc = mod0 + r * 6144 + 1024;
          float4 h[4], c4[4]; float sq = 0.f;
#pragma unroll
          for (int i = 0; i < 4; ++i) { h[i] = src[lane + 64 * i]; c4[i] = *(const float4*)(sc + 4 * (lane + 64 * i)); }
#pragma unroll
          for (int i = 0; i < 4; ++i) sq += h[i].x * h[i].x + h[i].y * h[i].y + h[i].z * h[i].z + h[i].w * h[i].w;
          sq = wsum(sq); if (lane == 0) ss[row] = sq;
#pragma unroll
          for (int i = 0; i < 4; ++i) { const int c = 4 * (lane + 64 * i); dst[lane + 64 * i] = h[i];
              u32x2 wv2; wv2.x = pk2(h[i].x * g[i].x * (1.f + c4[i].x), h[i].y * g[i].y * (1.f + c4[i].y)); wv2.y = pk2(h[i].z * g[i].z * (1.f + c4[i].z), h[i].w * g[i].w * (1.f + c4[i].w));
              *(u32x2*)(A + (size_t)row * 1024 + c) = wv2; }
      } }
}

template <int pass> __device__ __forceinline__ void s5_unit(const Ctx& p, int e, int g, int sg, LAS unsigned char* lds) {
    const int tid = mk_tid(), lane = tid & 63, n = lane & 15, quad = lane >> 4;
    LAS bf16x8* ops = (LAS bf16x8*)lds + tid;
    const int seq = sg * 16 + n, b = seq / 72, tc = seq % 72;
    const int rowbase = tc < 8 ? ML + b * 256 + tc * 32 : b * 2048 + (tc - 8) * 32;
    const bf16_t* P = (const bf16_t*)(p.ws + WS_P); bf16_t* Z = (bf16_t*)(p.ws + WS_Z); float* E = p.out;
    const f32x4 dsk = *(const f32x4*)(p.in[19] + e * 512 + g * 16 + quad * 4);
    const f32x4 z4 = {0.f, 0.f, 0.f, 0.f};
    const int srcl = n + 16 * (quad >> 1);
#pragma unroll 1
    for (int dir = 0; dir < 2; ++dir) {
        const int idx = (e * 2 + dir) * 32 + g;
        const float4* A4 = (const float4*)(p.ws + WS_S5A) + (size_t)idx * 64;
        const bf16_t* BB = (const bf16_t*)(p.ws + WS_S5BB) + (size_t)idx * 2048;
        const bf16_t* CC = (const bf16_t*)(p.ws + WS_S5CC) + (size_t)idx * 2048;
        f32x4 ar[4], ai[4], hr[4], hi[4];
#pragma unroll
        for (int pt = 0; pt < 4; ++pt) {
            ops[pt * 512] = quad < 2 ? *(const bf16x8*)(BB + (16 * pt + n) * 16 + quad * 8) : zero8();
            ops[(4 + pt) * 512] = quad < 2 ? *(const bf16x8*)(BB + 1024 + (16 * pt + n) * 16 + quad * 8) : zero8();
            ops[(8 + pt) * 512] = *(const bf16x8*)(CC + (pt * 16 + n) * 32 + quad * 8); }
        const int pc = dir == 0 ? tc : (tc < 8 ? 7 - tc : 79 - tc);
        float* Eb = E + ((size_t)((b * 2 + dir) * 72 + pc) * 32 + g) * 128;
#pragma unroll
        for (int pt = 0; pt < 4; ++pt) {
            float4 e0 = {0.f, 0.f, 0.f, 0.f}, e1 = {0.f, 0.f, 0.f, 0.f};
            if (pass == 2) { const float4* ep = (const float4*)(Eb + (16 * pt + quad * 4) * 2); e0 = ep[0]; e1 = ep[1]; }
            hr[pt][0] = e0.x; hi[pt][0] = e0.y; hr[pt][1] = e0.z; hi[pt][1] = e0.w; hr[pt][2] = e1.x; hi[pt][2] = e1.y; hr[pt][3] = e1.z; hi[pt][3] = e1.w;
#pragma unroll
            for (int j = 0; j < 4; ++j) { const float4 a = A4[16 * pt + quad * 4 + j]; ar[pt][j] = a.x; ai[pt][j] = a.y; } }
        const char* Pg = (const char*)(P + g * 16); char* Zg = (char*)(Z + g * 16);
        const unsigned uoff0 = (unsigned)(rowbase * 3072 + (quad & 1) * 8) * 2u, zoff0 = (unsigned)(rowbase * 512 + quad * 4) * 2u;
        const char* Zr = dir ? (const char*)Zg : Pg;
        bf16x8 ub[8]; u32x2 yfb[8];
#pragma unroll
        for (int j = 0; j < 8; ++j) { const int tt = dir ? 31 - j : j; ub[j] = *(const bf16x8*)(Pg + (uoff0 + (unsigned)tt * 6144u));
            yfb[j] = (u32x2){0u, 0u}; if (pass == 2) yfb[j] = *(const u32x2*)(Zr + (zoff0 + (unsigned)tt * 1024u)); }
#pragma unroll 1
        for (int t8 = 0; t8 < 4; ++t8) {
#pragma unroll
            for (int j = 0; j < 8; ++j) {
                const int t = t8 * 8 + j, tt = dir ? 31 - t : t;
                const bf16x8 uc = ub[j]; const u32x2 yf = yfb[j];
                { const int t2 = t + 8 < 31 ? t + 8 : 31; const int tt2 = dir ? 31 - t2 : t2; ub[j] = *(const bf16x8*)(Pg + (uoff0 + (unsigned)tt2 * 6144u));
                    if (pass == 2) yfb[j] = *(const u32x2*)(Zr + (zoff0 + (unsigned)tt2 * 1024u)); }
#pragma unroll
                for (int pt = 0; pt < 4; ++pt) { const bf16x8 oa = ops[pt * 512], ob = ops[(4 + pt) * 512]; const f32x4 br = MFMA(oa, uc, z4), bi = MFMA(ob, uc, z4);
                    { const f32x4 nr = ar[pt] * hr[pt] - ai[pt] * hi[pt] + br, ni = ar[pt] * hi[pt] + ai[pt] * hr[pt] + bi; hr[pt] = nr; hi[pt] = ni; }
                    if (pt & 1) asm volatile("" ::: "memory"); }
                if (pass == 2) {
                    f32x4 y = z4, y2 = z4;
#pragma unroll
                    for (int kk = 0; kk < 2; ++kk) {
                        const bf16x8 br = mk8(pk2(hr[2 * kk][0], hr[2 * kk][1]), pk2(hr[2 * kk][2], hr[2 * kk][3]), pk2(hr[2 * kk + 1][0], hr[2 * kk + 1][1]), pk2(hr[2 * kk + 1][2], hr[2 * kk + 1][3]));
                        const bf16x8 bi = mk8(pk2(hi[2 * kk][0], hi[2 * kk][1]), pk2(hi[2 * kk][2], hi[2 * kk][3]), pk2(hi[2 * kk + 1][0], hi[2 * kk + 1][1]), pk2(hi[2 * kk + 1][2], hi[2 * kk + 1][3]));
                        y = MFMA(ops[(8 + kk) * 512], br, y); y2 = MFMA(ops[(10 + kk) * 512], bi, y2); }
                    y += y2;
                    char* zp = Zg + (zoff0 + (unsigned)tt * 1024u);
                    if (dir == 0) { u32x2 w; w.x = pk2(y[0], y[1]); w.y = pk2(y[2], y[3]); *(u32x2*)zp = w; }
                    else { const u32x4 uw = __builtin_bit_cast(u32x4, uc);
                        const unsigned a0 = __shfl((int)uw.x, srcl), a1 = __shfl((int)uw.y, srcl), a2 = __shfl((int)uw.z, srcl), a3 = __shfl((int)uw.w, srcl);
                        const unsigned ux = (quad & 1) ? a2 : a0, uy = (quad & 1) ? a3 : a1;
                        float v[4] = {bflo(yf.x) + y[0] + dsk[0] * bflo(ux), bfhi(yf.x) + y[1] + dsk[1] * bfhi(ux), bflo(yf.y) + y[2] + dsk[2] * bflo(uy), bfhi(yf.y) + y[3] + dsk[3] * bfhi(uy)};
#pragma unroll
                        for (int jj = 0; jj < 4; ++jj) { const float x = v[jj], uarg = 1.5957691216f * (x + 0.044715f * x * x * x); v[jj] = x * rcpf_(1.0f + __expf(-uarg)); }
                        u32x2 w; w.x = pk2(v[0], v[1]); w.y = pk2(v[2], v[3]); *(u32x2*)zp = w; }
                }
                asm volatile("" ::: "memory");
            }
        }
        if (pass == 1) {
#pragma unroll
            for (int pt = 0; pt < 4; ++pt) { float4* ep = (float4*)(Eb + (16 * pt + quad * 4) * 2);
                float4 e0, e1; e0.x = hr[pt][0]; e0.y = hi[pt][0]; e0.z = hr[pt][1]; e0.w = hi[pt][1]; e1.x = hr[pt][2]; e1.y = hi[pt][2]; e1.z = hr[pt][3]; e1.w = hi[pt][3]; ep[0] = e0; ep[1] = e1; }
        }
    }
}
__device__ __forceinline__ void s5_carry(const Ctx& p, int e) {
    const int gt = blockIdx.x * 512 + mk_tid(), gs = gridDim.x * 512;
    float2* E = (float2*)p.out;
    for (int i = gt; i < 32768; i += gs) {
        const int pp = i & 63, g = (i >> 6) & 31, dir = (i >> 11) & 1, b = i >> 12;
        const float4 a = ((const float4*)(p.ws + WS_S5A))[(size_t)((e * 2 + dir) * 32 + g) * 64 + pp];
        float2* base = E + ((size_t)((b * 2 + dir) * 72) * 32 + g) * 64 + pp;
        float hr = 0.f, hi = 0.f;
#pragma unroll 1
        for (int q0 = 0; q0 < 72; q0 += 6) {
            float2 ev[6];
#pragma unroll
            for (int j = 0; j < 6; ++j) ev[j] = base[(size_t)(q0 + j) * 2048];
#pragma unroll
            for (int j = 0; j < 6; ++j) { float2 o; o.x = hr; o.y = hi; base[(size_t)(q0 + j) * 2048] = o; const float nr = a.z * hr - a.w * hi + ev[j].x, ni = a.z * hi + a.w * hr + ev[j].y; hr = nr; hi = ni; }
        }
    }
}

constexpr int HG_CUM = 0, HG_QT = 33792, HG_KT = HG_QT + 17408, HG_QI = HG_KT + 17408, HG_KET = HG_QI + 17408, HG_VT = HG_KET + 18432, HG_SC = HG_VT + 18432, HG_TOT = HG_SC + 9216, HG_C63 = HG_TOT + 2048, HG_END = HG_C63 + 512;
static_assert(HG_END <= LDS_BYTES, "hgrn lds");
__device__ __forceinline__ void hgrn_chain(const Ctx& p, int e, int chain, LAS unsigned char* lds) {
    const int tid = mk_tid(), w = tid >> 6, lane = tid & 63, n = lane & 15, quad = lane >> 4;
    const int b = chain >> 3, dir = (chain >> 2) & 1, head = chain & 3;
    const bf16_t* P = (const bf16_t*)(p.ws + WS_P);
    bf16_t* O = (bf16_t*)(p.ws + (dir ? WS_OB : WS_OF));
    LAS float* cum = (LAS float*)(lds + HG_CUM);
    LAS bf16_t* qt = (LAS bf16_t*)(lds + HG_QT);
    LAS bf16_t* kt = (LAS bf16_t*)(lds + HG_KT);
    LAS bf16_t* qi = (LAS bf16_t*)(lds + HG_QI);
    LAS bf16_t* keT = (LAS bf16_t*)(lds + HG_KET);
    LAS bf16_t* vT = (LAS bf16_t*)(lds + HG_VT);
    LAS bf16_t* sc = (LAS bf16_t*)(lds + HG_SC);
    LAS float* tot = (LAS float*)(lds + HG_TOT);
    LAS float* c63s = (LAS float*)(lds + HG_C63);
    const int t = lane, kc = w * 16;
    const int sk = tid & 127, sseg = tid >> 7;
    const float* lbp = (const float*)(p.ws + WS_LB) + e * 512 + head * 128 + kc;
    f32x4 S[8];
#pragma unroll
    for (int i = 0; i < 8; ++i) S[i] = (f32x4){0.f, 0.f, 0.f, 0.f};
    const int qcol = 512 + head * 128 + kc, fcol = (dir ? 1536 : 1024) + head * 128 + kc, vcol = 2048 + head * 128 + kc;
    u32x4 rq0, rq1, rf0, rf1, rv0, rv1;
    { const int rowb = dir == 0 ? ML + b * 256 : ML + b * 256 + 192; const bf16_t* pr = P + (size_t)(rowb + (dir ? 63 - t : t)) * 3072;
      rq0 = *(const u32x4*)(pr + qcol); rq1 = *(const u32x4*)(pr + qcol + 8); rf0 = *(const u32x4*)(pr + fcol); rf1 = *(const u32x4*)(pr + fcol + 8); rv0 = *(const u32x4*)(pr + vcol); rv1 = *(const u32x4*)(pr + vcol + 8); }
#pragma unroll 1
    for (int pc = 0; pc < 36; ++pc) {
        const int tc = dir == 0 ? pc : (pc < 4 ? 3 - pc : 39 - pc);
        const int rowb = tc < 4 ? ML + b * 256 + tc * 64 : b * 2048 + (tc - 4) * 64;
        float qv[16], kv[16];
        {
            const unsigned rq[8] = {rq0.x, rq0.y, rq0.z, rq0.w, rq1.x, rq1.y, rq1.z, rq1.w}, rf[8] = {rf0.x, rf0.y, rf0.z, rf0.w, rf1.x, rf1.y, rf1.z, rf1.w},
                           rv[8] = {rv0.x, rv0.y, rv0.z, rv0.w, rv1.x, rv1.y, rv1.z, rv1.w};
            float lf[16], lb[16];
#pragma unroll
            for (int i = 0; i < 4; ++i) { const f32x4 t4 = *(const f32x4*)(lbp + 4 * i); lb[4 * i] = t4[0]; lb[4 * i + 1] = t4[1]; lb[4 * i + 2] = t4[2]; lb[4 * i + 3] = t4[3]; }
#pragma unroll
            for (int i = 0; i < 16; ++i) {
                const float x = (i & 1) ? bfhi(rq[i >> 1]) : bflo(rq[i >> 1]); float fl = (i & 1) ? bfhi(rf[i >> 1]) : bflo(rf[i >> 1]);
                fl = fminf(fmaxf(fl, -30.f), 30.f);
                qv[i] = siluf(x);
                const float en = __expf(-fl), sg = rcpf_(1.0f + en);
                kv[i] = (1.f - lb[i]) * en * sg;
                lf[i] = __logf(lb[i] + (1.f - lb[i]) * sg);
                vT[(kc + i) * 72 + t] = (bf16_t)((i & 1) ? (rv[i >> 1] >> 16) : (rv[i >> 1] & 0xffffu));
            }
#pragma unroll
            for (int i = 0; i < 4; ++i) *(LAS f32x4*)(cum + t * 132 + kc + 4 * i) = (f32x4){lf[4 * i], lf[4 * i + 1], lf[4 * i + 2], lf[4 * i + 3]};
        }
        if (pc < 35) { const int pc2 = pc + 1; const int tc2 = dir == 0 ? pc2 : (pc2 < 4 ? 3 - pc2 : 39 - pc2); const int rowb2 = tc2 < 4 ? ML + b * 256 + tc2 * 64 : b * 2048 + (tc2 - 4) * 64;
            const bf16_t* pr = P + (size_t)(rowb2 + (dir ? 63 - t : t)) * 3072;
            rq0 = *(const u32x4*)(pr + qcol); rq1 = *(const u32x4*)(pr + qcol + 8); rf0 = *(const u32x4*)(pr + fcol); rf1 = *(const u32x4*)(pr + fcol + 8); rv0 = *(const u32x4*)(pr + vcol); rv1 = *(const u32x4*)(pr + vcol + 8); }
        __syncthreads();
        {
            float c[16];
#pragma unroll
            for (int i = 0; i < 16; ++i) c[i] = cum[(16 * sseg + i) * 132 + sk];
#pragma unroll
            for (int i = 1; i < 16; ++i) c[i] += c[i - 1];
#pragma unroll
            for (int i = 0; i < 16; ++i) cum[(16 * sseg + i) * 132 + sk] = c[i];
            tot[sseg * 128 + sk] = c[15];
        }
        __syncthreads();
        {
            const int seg = t >> 4;
            unsigned wq[8], wk[8], wi[8];
#pragma unroll
            for (int i4 = 0; i4 < 4; ++i4) {
                const f32x4 o0 = *(const LAS f32x4*)(tot + kc + 4 * i4), o1 = *(const LAS f32x4*)(tot + 128 + kc + 4 * i4), o2 = *(const LAS f32x4*)(tot + 256 + kc + 4 * i4);
                const f32x4 cl = *(const LAS f32x4*)(cum + t * 132 + kc + 4 * i4), l31 = *(const LAS f32x4*)(cum + 31 * 132 + kc + 4 * i4), l63 = *(const LAS f32x4*)(cum + 63 * 132 + kc + 4 * i4);
                float a[4], bq[4], cq[4];
#pragma unroll
                for (int j = 0; j < 4; ++j) { const int ii = 4 * i4 + j;
                    const float off = (seg > 0 ? o0[j] : 0.f) + (seg > 1 ? o1[j] : 0.f) + (seg > 2 ? o2[j] : 0.f);
                    const float ct = cl[j] + off, c31 = l31[j] + o0[j], c63 = l63[j] + o0[j] + o1[j] + o2[j];
                    a[j] = qv[ii] * __expf(fminf(ct - c31, 80.f)); bq[j] = kv[ii] * __expf(fminf(c31 - ct, 80.f)); cq[j] = qv[ii] * __expf(ct);
                    keT[(kc + ii) * 72 + t] = f2bf(kv[ii] * __expf(c63 - ct));
                    if (t == 63) c63s[kc + ii] = c63; }
                wq[2 * i4] = pk2(a[0], a[1]); wq[2 * i4 + 1] = pk2(a[2], a[3]); wk[2 * i4] = pk2(bq[0], bq[1]); wk[2 * i4 + 1] = pk2(bq[2], bq[3]); wi[2 * i4] = pk2(cq[0], cq[1]); wi[2 * i4 + 1] = pk2(cq[2], cq[3]);
            }
            *(LAS u32x4*)(qt + t * 136 + kc) = (u32x4){wq[0], wq[1], wq[2], wq[3]}; *(LAS u32x4*)(qt + t * 136 + kc + 8) = (u32x4){wq[4], wq[5], wq[6], wq[7]};
            *(LAS u32x4*)(kt + t * 136 + kc) = (u32x4){wk[0], wk[1], wk[2], wk[3]}; *(LAS u32x4*)(kt + t * 136 + kc + 8) = (u32x4){wk[4], wk[5], wk[6], wk[7]};
            *(LAS u32x4*)(qi + t * 136 + kc) = (u32x4){wi[0], wi[1], wi[2], wi[3]}; *(LAS u32x4*)(qi + t * 136 + kc + 8) = (u32x4){wi[4], wi[5], wi[6], wi[7]};
        }
        __syncthreads();
        {
            const int tt = w >> 1;
#pragma unroll
            for (int si = 0; si < 2; ++si) { const int st = (w & 1) * 2 + si; f32x4 acc = {0.f, 0.f, 0.f, 0.f};
                if (st <= tt) {
#pragma unroll
                    for (int kb = 0; kb < 4; ++kb) { const bf16x8 a = *(const LAS bf16x8*)(qt + (16 * tt + n) * 136 + 32 * kb + quad * 8), bb = *(const LAS bf16x8*)(kt + (16 * st + n) * 136 + 32 * kb + quad * 8);
                        acc = MFMA(a, bb, acc); } }
#pragma unroll
                for (int j = 0; j < 4; ++j) { const int ti = 16 * tt + quad * 4 + j, sidx = 16 * st + n; sc[ti * 72 + sidx] = (st <= tt && sidx <= ti) ? f2bf(acc[j]) : (bf16_t)0; } }
        }
        __syncthreads();
        {
            bf16x8 Sb[4], vB[2];
#pragma unroll
            for (int kb = 0; kb < 4; ++kb) Sb[kb] = mk8(pk2(S[2 * kb][0], S[2 * kb][1]), pk2(S[2 * kb][2], S[2 * kb][3]), pk2(S[2 * kb + 1][0], S[2 * kb + 1][1]), pk2(S[2 * kb + 1][2], S[2 * kb + 1][3]));
#pragma unroll
            for (int sb = 0; sb < 2; ++sb) vB[sb] = *(const LAS bf16x8*)(vT + (16 * w + n) * 72 + 32 * sb + quad * 8);
#pragma unroll
            for (int tt = 0; tt < 4; ++tt) { f32x4 acc = {0.f, 0.f, 0.f, 0.f};
#pragma unroll
                for (int kb = 0; kb < 4; ++kb) { const bf16x4 a0 = *(const LAS bf16x4*)(qi + (16 * tt + n) * 136 + 32 * kb + quad * 4), a1 = *(const LAS bf16x4*)(qi + (16 * tt + n) * 136 + 32 * kb + 16 + quad * 4);
                    acc = MFMA(__builtin_shufflevector(a0, a1, 0, 1, 2, 3, 4, 5, 6, 7), Sb[kb], acc); }
#pragma unroll
                for (int sb = 0; sb < 2; ++sb) if (32 * sb <= 16 * tt + 15) { const bf16x8 a = *(const LAS bf16x8*)(sc + (16 * tt + n) * 72 + 32 * sb + quad * 8); acc = MFMA(a, vB[sb], acc); }
#pragma unroll
                for (int j = 0; j < 4; ++j) { const int ti = 16 * tt + quad * 4 + j; O[(size_t)(rowb + (dir ? 63 - ti : ti)) * 512 + head * 128 + 16 * w + n] = f2bf(acc[j]); } }
#pragma unroll
            for (int k8 = 0; k8 < 8; ++k8) { const f32x4 c4 = *(const LAS f32x4*)(c63s + 16 * k8 + quad * 4);
                f32x4 s = S[k8]; s[0] *= __expf(c4[0]); s[1] *= __expf(c4[1]); s[2] *= __expf(c4[2]); s[3] *= __expf(c4[3]);
#pragma unroll
                for (int sb = 0; sb < 2; ++sb) { const bf16x8 a = *(const LAS bf16x8*)(keT + (16 * k8 + n) * 72 + 32 * sb + quad * 8); s = MFMA(a, vB[sb], s); }
                S[k8] = s; }
        }
        __syncthreads();
    }
}

__device__ __forceinline__ void hg_pre_unit(const Ctx& p, int e, int u, LAS unsigned char* lds, bool dry) {
    const int tid = mk_tid(), w = __builtin_amdgcn_readfirstlane(tid >> 6), lane = tid & 63, n = lane & 15, quad = lane >> 4;
    const int head = u & 3, ch = u >> 2, b = ch / 36, tc = ch % 36;
    const int rowb = tc < 4 ? ML + b * 256 + tc * 64 : b * 2048 + (tc - 4) * 64;
    bf16_t* P = (bf16_t*)(p.ws + WS_P);
    LAS float* cum = (LAS float*)(lds + HG_CUM);
    LAS bf16_t* qt = (LAS bf16_t*)(lds + HG_QT); LAS bf16_t* kt = (LAS bf16_t*)(lds + HG_KT); LAS bf16_t* qi = (LAS bf16_t*)(lds + HG_QI);
    LAS bf16_t* keT = (LAS bf16_t*)(lds + HG_KET); LAS bf16_t* vT = (LAS bf16_t*)(lds + HG_VT); LAS bf16_t* sc = (LAS bf16_t*)(lds + HG_SC);
    LAS float* tot = (LAS float*)(lds + HG_TOT);
    const int t = lane, kc = w * 16;
    const int sk = tid & 127, sseg = tid >> 7;
    const float* lbp = (const float*)(p.ws + WS_LB) + e * 512 + head * 128 + kc;
    u32x4 rq0, rq1, rfa0, rfa1, rfb0, rfb1, rv0, rv1;
    { const bf16_t* pr = P + (size_t)(rowb + t) * 3072 + head * 128 + kc;
      rq0 = *(const u32x4*)(pr + 512); rq1 = *(const u32x4*)(pr + 520); rfa0 = *(const u32x4*)(pr + 1024); rfa1 = *(const u32x4*)(pr + 1032);
      rfb0 = *(const u32x4*)(pr + 1536); rfb1 = *(const u32x4*)(pr + 1544); rv0 = *(const u32x4*)(pr + 2048); rv1 = *(const u32x4*)(pr + 2056); }
    float lb[16];
#pragma unroll
    for (int i = 0; i < 4; ++i) { const f32x4 t4 = *(const f32x4*)(lbp + 4 * i); lb[4 * i] = t4[0]; lb[4 * i + 1] = t4[1]; lb[4 * i + 2] = t4[2]; lb[4 * i + 3] = t4[3]; }
    float qv[16];
    { const unsigned rq[8] = {rq0.x, rq0.y, rq0.z, rq0.w, rq1.x, rq1.y, rq1.z, rq1.w};
#pragma unroll
      for (int i = 0; i < 16; ++i) qv[i] = siluf((i & 1) ? bfhi(rq[i >> 1]) : bflo(rq[i >> 1])); }
#pragma unroll 1
    for (int dir = 0; dir < 2; ++dir) {
        const int s = dir ? 63 - t : t;
        bf16_t* O = (bf16_t*)(p.ws + (dir ? WS_OB : WS_OF));
        float kv[16];
        {
            const unsigned rv[8] = {rv0.x, rv0.y, rv0.z, rv0.w, rv1.x, rv1.y, rv1.z, rv1.w};
            const u32x4 f0 = dir ? rfb0 : rfa0, f1 = dir ? rfb1 : rfa1;
            const unsigned rf[8] = {f0.x, f0.y, f0.z, f0.w, f1.x, f1.y, f1.z, f1.w};
            float lf[16];
#pragma unroll
            for (int i = 0; i < 16; ++i) {
                float fl = (i & 1) ? bfhi(rf[i >> 1]) : bflo(rf[i >> 1]);
                fl = fminf(fmaxf(fl, -30.f), 30.f);
                const float en = __expf(-fl), sg = rcpf_(1.0f + en);
                kv[i] = (1.f - lb[i]) * en * sg;
                lf[i] = __logf(lb[i] + (1.f - lb[i]) * sg);
                vT[(kc + i) * 72 + s] = (bf16_t)((i & 1) ? (rv[i >> 1] >> 16) : (rv[i >> 1] & 0xffffu));
            }
#pragma unroll
            for (int i = 0; i < 4; ++i) *(LAS f32x4*)(cum + s * 132 + kc + 4 * i) = (f32x4){lf[4 * i], lf[4 * i + 1], lf[4 * i + 2], lf[4 * i + 3]};
        }
        __syncthreads();
        {
            float c[16];
#pragma unroll
            for (int i = 0; i < 16; ++i) c[i] = cum[(16 * sseg + i) * 132 + sk];
#pragma unroll
            for (int i = 1; i < 16; ++i) c[i] += c[i - 1];
#pragma unroll
            for (int i = 0; i < 16; ++i) cum[(16 * sseg + i) * 132 + sk] = c[i];
            tot[sseg * 128 + sk] = c[15];
        }
        __syncthreads();
        {
            const int seg = s >> 4;
            unsigned wq[8], wk[8], wi[8];
#pragma unroll
            for (int i4 = 0; i4 < 4; ++i4) {
                const f32x4 o0 = *(const LAS f32x4*)(tot + kc + 4 * i4), o1 = *(const LAS f32x4*)(tot + 128 + kc + 4 * i4), o2 = *(const LAS f32x4*)(tot + 256 + kc + 4 * i4);
                const f32x4 cl = *(const LAS f32x4*)(cum + s * 132 + kc + 4 * i4), l31 = *(const LAS f32x4*)(cum + 31 * 132 + kc + 4 * i4), l63 = *(const LAS f32x4*)(cum + 63 * 132 + kc + 4 * i4);
                float a[4], bq[4], cq[4], e63[4];
#pragma unroll
                for (int j = 0; j < 4; ++j) { const int ii = 4 * i4 + j;
                    const float off = (seg > 0 ? o0[j] : 0.f) + (seg > 1 ? o1[j] : 0.f) + (seg > 2 ? o2[j] : 0.f);
                    const float ct = cl[j] + off, c31 = l31[j] + o0[j], c63 = l63[j] + o0[j] + o1[j] + o2[j];
                    a[j] = qv[ii] * __expf(fminf(ct - c31, 80.f)); bq[j] = kv[ii] * __expf(fminf(c31 - ct, 80.f)); cq[j] = qv[ii] * __expf(ct);
                    keT[(kc + ii) * 72 + s] = f2bf(kv[ii] * __expf(c63 - ct)); e63[j] = __expf(c63); }
                if (s == 63 && !dry) { u32x2 ev; ev.x = pk2(e63[0], e63[1]); ev.y = pk2(e63[2], e63[3]);
                    *(u32x2*)((bf16_t*)(p.ws + WS_E63) + ((size_t)(dir * 288 + ch) * 4 + head) * 128 + kc + 4 * i4) = ev; }
                wq[2 * i4] = pk2(a[0], a[1]); wq[2 * i4 + 1] = pk2(a[2], a[3]); wk[2 * i4] = pk2(bq[0], bq[1]); wk[2 * i4 + 1] = pk2(bq[2], bq[3]); wi[2 * i4] = pk2(cq[0], cq[1]); wi[2 * i4 + 1] = pk2(cq[2], cq[3]);
            }
            *(LAS u32x4*)(qt + s * 136 + kc) = (u32x4){wq[0], wq[1], wq[2], wq[3]}; *(LAS u32x4*)(qt + s * 136 + kc + 8) = (u32x4){wq[4], wq[5], wq[6], wq[7]};
            *(LAS u32x4*)(kt + s * 136 + kc) = (u32x4){wk[0], wk[1], wk[2], wk[3]}; *(LAS u32x4*)(kt + s * 136 + kc + 8) = (u32x4){wk[4], wk[5], wk[6], wk[7]};
            *(LAS u32x4*)(qi + s * 136 + kc) = (u32x4){wi[0], wi[1], wi[2], wi[3]}; *(LAS u32x4*)(qi + s * 136 + kc + 8) = (u32x4){wi[4], wi[5], wi[6], wi[7]};
        }
        __syncthreads();
        {
            const int tt = w >> 1;
#pragma unroll
            for (int si = 0; si < 2; ++si) { const int st = (w & 1) * 2 + si; f32x4 acc = {0.f, 0.f, 0.f, 0.f};
                if (st <= tt) {
#pragma unroll
                    for (int kb = 0; kb < 4; ++kb) { const bf16x8 a = *(const LAS bf16x8*)(qt + (16 * tt + n) * 136 + 32 * kb + quad * 8), bb = *(const LAS bf16x8*)(kt + (16 * st + n) * 136 + 32 * kb + quad * 8);
                        acc = MFMA(a, bb, acc); } }
#pragma unroll
                for (int j = 0; j < 4; ++j) { const int ti = 16 * tt + quad * 4 + j, sidx = 16 * st + n; sc[ti * 72 + sidx] = (st <= tt && sidx <= ti) ? f2bf(acc[j]) : (bf16_t)0; } }
        }
        __syncthreads();
        {
            bf16x8 vB[2];
#pragma unroll
            for (int sb = 0; sb < 2; ++sb) vB[sb] = *(const LAS bf16x8*)(vT + (16 * w + n) * 72 + 32 * sb + quad * 8);
#pragma unroll
            for (int tt = 0; tt < 4; ++tt) { f32x4 acc = {0.f, 0.f, 0.f, 0.f};
#pragma unroll
                for (int sb = 0; sb < 2; ++sb) if (32 * sb <= 16 * tt + 15) { const bf16x8 a = *(const LAS bf16x8*)(sc + (16 * tt + n) * 72 + 32 * sb + quad * 8); acc = MFMA(a, vB[sb], acc); }
#pragma unroll
                for (int j = 0; j < 4; ++j) { const int ti = 16 * tt + quad * 4 + j; if (!dry) O[(size_t)(rowb + (dir ? 63 - ti : ti)) * 512 + head * 128 + 16 * w + n] = f2bf(acc[j]); } }
            if (!dry) { const int r = tid >> 3, c16 = (tid & 7) * 16; const u32x4 x0 = *(const LAS u32x4*)(qi + r * 136 + c16), x1 = *(const LAS u32x4*)(qi + r * 136 + c16 + 8);
              bf16_t* dq = dir ? (bf16_t*)(p.ws + WS_Q1) + (size_t)(rowb + r) * 512 + head * 128 + c16 : P + (size_t)(rowb + r) * 3072 + 512 + head * 128 + c16;
              *(u32x4*)dq = x0; *(u32x4*)(dq + 8) = x1; }
            if (!dry) { const int r = tid >> 3, c16 = (tid & 7) * 16, k = 2 * r + (c16 >> 6), s0 = c16 & 63;
              const u32x4 x0 = *(const LAS u32x4*)(keT + k * 72 + s0), x1 = *(const LAS u32x4*)(keT + k * 72 + s0 + 8), y0 = *(const LAS u32x4*)(vT + k * 72 + s0), y1 = *(const LAS u32x4*)(vT + k * 72 + s0 + 8);
              bf16_t* dk = P + (size_t)(rowb + r) * 3072 + (dir ? 1536 : 1024) + head * 128 + c16; *(u32x4*)dk = x0; *(u32x4*)(dk + 8) = x1;
              bf16_t* dv = dir ? (bf16_t*)(p.ws + WS_VT1) + (size_t)(rowb + r) * 512 + head * 128 + c16 : P + (size_t)(rowb + r) * 3072 + 2048 + head * 128 + c16; *(u32x4*)dv = y0; *(u32x4*)(dv + 8) = y1; }
        }
        __syncthreads();
    }
}

constexpr int HC_BUF = 17408 + 18432 + 18432 + 512;
static_assert(2 * HC_BUF <= LDS_BYTES - 256, "chain lds");
__device__ __forceinline__ void hgrn_chain2(const Ctx& p, int chain, LAS unsigned char* lds, bool dry) {
    const int tid = mk_tid(), w = __builtin_amdgcn_readfirstlane(tid >> 6), lane = tid & 63, n = lane & 15, quad = lane >> 4;
    const int b = chain >> 3, dir = (chain >> 2) & 1, head = chain & 3;
    const bf16_t* P = (const bf16_t*)(p.ws + WS_P);
    bf16_t* O = (bf16_t*)(p.ws + (dir ? WS_OB : WS_OF));
    const bf16_t* srcQ = dir ? (const bf16_t*)(p.ws + WS_Q1) + head * 128 : P + 512 + head * 128; const int ldq = dir ? 512 : 3072;
    const bf16_t* srcK = P + (dir ? 1536 : 1024) + head * 128;
    const bf16_t* srcV = dir ? (const bf16_t*)(p.ws + WS_VT1) + head * 128 : P + 2048 + head * 128; const int ldv = dir ? 512 : 3072;
    const bf16_t* E63 = (const bf16_t*)(p.ws + WS_E63);
    const int r = tid >> 3, c16 = (tid & 7) * 16, kk2 = 2 * r + (c16 >> 6), s0 = c16 & 63;
    f32x4 S[8];
#pragma unroll
    for (int i = 0; i < 8; ++i) S[i] = (f32x4){0.f, 0.f, 0.f, 0.f};
    u32x4 pq0, pq1, pk0, pk1, pv0, pv1; unsigned pe = 0u;
    auto fetch = [&](int pc) { const int tc = dir == 0 ? pc : (pc < 4 ? 3 - pc : 39 - pc); const int rowb = tc < 4 ? ML + b * 256 + tc * 64 : b * 2048 + (tc - 4) * 64;
        const bf16_t* q = srcQ + (size_t)(rowb + r) * ldq + c16; pq0 = *(const u32x4*)q; pq1 = *(const u32x4*)(q + 8);
        const bf16_t* k = srcK + (size_t)(rowb + r) * 3072 + c16; pk0 = *(const u32x4*)k; pk1 = *(const u32x4*)(k + 8);
        const bf16_t* v = srcV + (size_t)(rowb + r) * ldv + c16; pv0 = *(const u32x4*)v; pv1 = *(const u32x4*)(v + 8);
        if (tid < 64) pe = *(const unsigned*)(E63 + ((size_t)(dir * 288 + b * 36 + tc) * 4 + head) * 128 + tid * 2); };
    fetch(0);
#pragma unroll 1
    for (int pc = 0; pc < 36; ++pc) {
        LAS unsigned char* buf = lds + (pc & 1) * HC_BUF;
        LAS bf16_t* qi = (LAS bf16_t*)buf; LAS bf16_t* keT = (LAS bf16_t*)(buf + 17408); LAS bf16_t* vT = (LAS bf16_t*)(buf + 17408 + 18432); LAS float* e63 = (LAS float*)(buf + 17408 + 2 * 18432);
        *(LAS u32x4*)(qi + r * 136 + c16) = pq0; *(LAS u32x4*)(qi + r * 136 + c16 + 8) = pq1;
        *(LAS u32x4*)(keT + kk2 * 72 + s0) = pk0; *(LAS u32x4*)(keT + kk2 * 72 + s0 + 8) = pk1;
        *(LAS u32x4*)(vT + kk2 * 72 + s0) = pv0; *(LAS u32x4*)(vT + kk2 * 72 + s0 + 8) = pv1;
        if (tid < 64) { e63[tid * 2] = bflo(pe); e63[tid * 2 + 1] = bfhi(pe); }
        __syncthreads();
        const int tc = dir == 0 ? pc : (pc < 4 ? 3 - pc : 39 - pc); const int rowb = tc < 4 ? ML + b * 256 + tc * 64 : b * 2048 + (tc - 4) * 64;
        if (pc < 35) fetch(pc + 1);
        unsigned short oin[4][4];
#pragma unroll
        for (int tt = 0; tt < 4; ++tt)
#pragma unroll
            for (int j = 0; j < 4; ++j) { const int ti = 16 * tt + quad * 4 + j; oin[tt][j] = O[(size_t)(rowb + (dir ? 63 - ti : ti)) * 512 + head * 128 + 16 * w + n]; }
        bf16x8 Sb[4], vB[2];
#pragma unroll
        for (int kb = 0; kb < 4; ++kb) Sb[kb] = mk8(pk2(S[2 * kb][0], S[2 * kb][1]), pk2(S[2 * kb][2], S[2 * kb][3]), pk2(S[2 * kb + 1][0], S[2 * kb + 1][1]), pk2(S[2 * kb + 1][2], S[2 * kb + 1][3]));
#pragma unroll
        for (int sb = 0; sb < 2; ++sb) vB[sb] = *(const LAS bf16x8*)(vT + (16 * w + n) * 72 + 32 * sb + quad * 8);
        f32x4 acc[4];
#pragma unroll
        for (int tt = 0; tt < 4; ++tt) { acc[tt] = (f32x4){0.f, 0.f, 0.f, 0.f};
#pragma unroll
            for (int kb = 0; kb < 4; ++kb) { const bf16x4 a0 = *(const LAS bf16x4*)(qi + (16 * tt + n) * 136 + 32 * kb + quad * 4), a1 = *(const LAS bf16x4*)(qi + (16 * tt + n) * 136 + 32 * kb + 16 + quad * 4);
                acc[tt] = MFMA(__builtin_shufflevector(a0, a1, 0, 1, 2, 3, 4, 5, 6, 7), Sb[kb], acc[tt]); } }
#pragma unroll
        for (int k8 = 0; k8 < 8; ++k8) { const f32x4 c4 = *(const LAS f32x4*)(e63 + 16 * k8 + quad * 4);
            f32x4 sv = S[k8] * c4;
#pragma unroll
            for (int sb = 0; sb < 2; ++sb) { const bf16x8 a = *(const LAS bf16x8*)(keT + (16 * k8 + n) * 72 + 32 * sb + quad * 8); sv = MFMA(a, vB[sb], sv); }
            S[k8] = sv; }
#pragma unroll
        for (int tt = 0; tt < 4; ++tt)
#pragma unroll
            for (int j = 0; j < 4; ++j) { const int ti = 16 * tt + quad * 4 + j; if (!dry) O[(size_t)(rowb + (dir ? 63 - ti : ti)) * 512 + head * 128 + 16 * w + n] = f2bf(acc[tt][j] + bf2f(oin[tt][j])); }
    }
    __syncthreads();
}

__device__ __forceinline__ void hgrn_combine(const Ctx& p, int e) {
    const int lane = mk_tid() & 63, wg = blockIdx.x * 8 + (mk_tid() >> 6), nw = gridDim.x * 8;
    const bf16_t* P = (const bf16_t*)(p.ws + WS_P); const unsigned* OF = (const unsigned*)(p.ws + WS_OF); const unsigned* OB = (const unsigned*)(p.ws + WS_OB);
    unsigned* MX = (unsigned*)(p.ws + WS_A); const float* on = p.in[23] + e * 128;
    const float g0 = on[lane * 2], g1 = on[lane * 2 + 1];
    for (int row = wg; row < MT; row += nw) {
        unsigned a[4], bq[4], gg[4];
#pragma unroll
        for (int h = 0; h < 4; ++h) { a[h] = OF[(size_t)row * 256 + h * 64 + lane]; bq[h] = OB[(size_t)row * 256 + h * 64 + lane]; gg[h] = *(const unsigned*)(P + (size_t)row * 3072 + 2560 + h * 128 + lane * 2); }
#pragma unroll
        for (int h = 0; h < 4; ++h) {
            const float v0 = bflo(a[h]) + bflo(bq[h]), v1 = bfhi(a[h]) + bfhi(bq[h]); const float ss = wsum(v0 * v0 + v1 * v1); const float rs = rsqrtf(ss * (1.0f / 128.0f) + 1e-6f);
            MX[(size_t)row * 512 + 256 + h * 64 + lane] = pk2(v0 * rs * g0 * siluf(bflo(gg[h])), v1 * rs * g1 * siluf(bfhi(gg[h]))); }
    }
}

__device__ __forceinline__ void odd_post1(const Ctx& p, int o) {
    const int lane = mk_tid() & 63, wg = blockIdx.x * 8 + (mk_tid() >> 6), nw = gridDim.x * 8;
    bf16_t* P = (bf16_t*)(p.ws + WS_P); bf16_t* A23 = (bf16_t*)(p.ws + WS_A);
    const float* rope = (const float*)(p.ws + WS_ROPE);
    const float nq = p.in[26][o * 128 + lane], nk = p.in[26][o * 128 + 64 + lane], nr = p.in[33][o * 128 + 64 + lane];
    float gq[6], gk[4];
#pragma unroll
    for (int i = 0; i < 6; ++i) gq[i] = p.in[28][o * 384 + lane + 64 * i];
#pragma unroll
    for (int i = 0; i < 4; ++i) gk[i] = p.in[29][o * 256 + lane + 64 * i];
    const int ax = lane >> 5, f = lane & 15, hh = (lane >> 4) & 1;
    for (int row = wg; row < MT; row += nw) {
        bf16_t* pr = P + (size_t)row * 2304; const bool lat = row < ML; const int tk = row & 2047; const int pos = ax ? (tk & 63) : (tk >> 6);
        const float cs = rope[(pos * 16 + f) * 2], sn = rope[(pos * 16 + f) * 2 + 1];
        float x[17], xq[6], xk[4];
#pragma unroll
        for (int v = 0; v < 17; ++v) x[v] = bf2f(pr[(v < 16 ? v * 64 : 2176) + lane]);
#pragma unroll
        for (int i = 0; i < 6; ++i) xq[i] = bf2f(pr[1536 + lane + 64 * i]);
#pragma unroll
        for (int i = 0; i < 4; ++i) xk[i] = bf2f(pr[1920 + lane + 64 * i]);
#pragma unroll
        for (int v = 0; v < 17; ++v) { const float gn = v < 8 ? nq : (v < 16 ? nk : nr);
            const float ss = wsum(x[v] * x[v]); float y = x[v] * rsqrtf(ss * (1.0f / 64.0f) + 1e-6f) * gn;
            if (lat) { const float pt = __shfl_xor(y, 16); y = y * cs + (hh ? pt : -pt) * sn; }
            if (v < 8) y *= 0.125f * 1.4426950408889634f;
            pr[(v < 16 ? v * 64 : 2176) + lane] = f2bf(y); }
        { float ss = 0.f;
#pragma unroll
          for (int i = 0; i < 6; ++i) ss += xq[i] * xq[i];
          ss = wsum(ss); const float rs = rsqrtf(ss * (1.0f / 384.0f) + 1e-6f);
#pragma unroll
          for (int i = 0; i < 6; ++i) A23[(size_t)row * 640 + lane + 64 * i] = f2bf(xq[i] * rs * gq[i]); }
        { float ss = 0.f;
#pragma unroll
          for (int i = 0; i < 4; ++i) ss += xk[i] * xk[i];
          ss = wsum(ss); const float rs = rsqrtf(ss * (1.0f / 256.0f) + 1e-6f);
#pragma unroll
          for (int i = 0; i < 4; ++i) A23[(size_t)row * 640 + 384 + lane + 64 * i] = f2bf(xk[i] * rs * gk[i]); }
    }
}
__device__ __forceinline__ void odd_post2(const Ctx& p, int o) {
    const int lane = mk_tid() & 63, wg = blockIdx.x * 8 + (mk_tid() >> 6), nw = gridDim.x * 8;
    bf16_t* UQ = (bf16_t*)(p.ws + WS_U); bf16_t* UKV = UQ + 768;
    const float* rope = (const float*)(p.ws + WS_ROPE);
    const float qn0 = p.in[32][o * 256 + lane], qn1 = p.in[32][o * 256 + 64 + lane], kn0 = p.in[32][o * 256 + 128 + lane], kn1 = p.in[32][o * 256 + 192 + lane], rn = p.in[33][o * 128 + lane];
    const int ax = lane >> 5, f = lane & 15, hh = (lane >> 4) & 1; const float scl = 0.07216878364870322f * 1.4426950408889634f;
    for (int row = wg; row < MT; row += nw) {
        const bool lat = row < ML; const int tk = row & 2047; const int pos = ax ? (tk & 63) : (tk >> 6);
        const float cs = rope[(pos * 16 + f) * 2], sn = rope[(pos * 16 + f) * 2 + 1];
        bf16_t* uq = UQ + (size_t)row * 1792; bf16_t* ukv = UKV + (size_t)row * 1792;
        float a0[4], a1[4], ar[4], k0[4], k1[4];
#pragma unroll
        for (int h = 0; h < 4; ++h) { a0[h] = bf2f(uq[h * 192 + lane]); a1[h] = bf2f(uq[h * 192 + 64 + lane]); ar[h] = bf2f(uq[h * 192 + 128 + lane]); k0[h] = bf2f(ukv[h * 256 + lane]); k1[h] = bf2f(ukv[h * 256 + 64 + lane]); }
#pragma unroll
        for (int h = 0; h < 4; ++h) {
            { const float ss = wsum(a0[h] * a0[h] + a1[h] * a1[h]); const float rs = rsqrtf(ss * (1.0f / 128.0f) + 1e-6f) * scl;
              uq[h * 192 + lane] = f2bf(a0[h] * rs * qn0); uq[h * 192 + 64 + lane] = f2bf(a1[h] * rs * qn1); }
            { const float ss = wsum(ar[h] * ar[h]); float y = ar[h] * rsqrtf(ss * (1.0f / 64.0f) + 1e-6f) * rn;
              if (lat) { const float pt = __shfl_xor(y, 16); y = y * cs + (hh ? pt : -pt) * sn; }
              uq[h * 192 + 128 + lane] = f2bf(y * scl); }
            { const float ss = wsum(k0[h] * k0[h] + k1[h] * k1[h]); const float rs = rsqrtf(ss * (1.0f / 128.0f) + 1e-6f);
              ukv[h * 256 + lane] = f2bf(k0[h] * rs * kn0); ukv[h * 256 + 64 + lane] = f2bf(k1[h] * rs * kn1); }
        }
    }
}

constexpr int AT_VT = 25600, AT_VRS = 288;
typedef short s16x4 __attribute__((ext_vector_type(4)));
template <int OFF> __device__ __forceinline__ s16x4 tr_read(unsigned vb) { s16x4 r; asm volatile("ds_read_b64_tr_b16 %0, %1 offset:%2" : "=&v"(r) : "v"(vb), "i"(OFF) : "memory"); return r; }
template <int DT> __device__ __forceinline__ void pv_pair(f32x4 (&O)[8][2], unsigned vb, const bf16x8 (&Pf)[2][2]) {
    const s16x4 a00 = tr_read<(0) * AT_VRS + DT * 32>(vb), a01 = tr_read<(16) * AT_VRS + DT * 32>(vb), a10 = tr_read<(32) * AT_VRS + DT * 32>(vb), a11 = tr_read<(48) * AT_VRS + DT * 32>(vb);
    const s16x4 b00 = tr_read<(0) * AT_VRS + (DT + 1) * 32>(vb), b01 = tr_read<(16) * AT_VRS + (DT + 1) * 32>(vb), b10 = tr_read<(32) * AT_VRS + (DT + 1) * 32>(vb), b11 = tr_read<(48) * AT_VRS + (DT + 1) * 32>(vb);
    asm volatile("s_waitcnt lgkmcnt(0)" ::: "memory"); __builtin_amdgcn_sched_barrier(0);
#define PK8(L, H) (bf16x8){L[0], L[1], L[2], L[3], H[0], H[1], H[2], H[3]}
    const bf16x8 va0 = PK8(a00, a01), va1 = PK8(a10, a11), vb0 = PK8(b00, b01), vb1 = PK8(b10, b11);
#undef PK8
    O[DT][0] = MFMA(va0, Pf[0][0], O[DT][0]); O[DT][1] = MFMA(va0, Pf[1][0], O[DT][1]); O[DT + 1][0] = MFMA(vb0, Pf[0][0], O[DT + 1][0]); O[DT + 1][1] = MFMA(vb0, Pf[1][0], O[DT + 1][1]);
    O[DT][0] = MFMA(va1, Pf[0][1], O[DT][0]); O[DT][1] = MFMA(va1, Pf[1][1], O[DT][1]); O[DT + 1][0] = MFMA(vb1, Pf[0][1], O[DT + 1][0]); O[DT + 1][1] = MFMA(vb1, Pf[1][1], O[DT + 1][1]);
}
constexpr int AT_BUF = 45056;
template <int DQ, int K1W>
__device__ __forceinline__ void attn_core(LAS unsigned char* lds, const bf16_t* __restrict__ Q, int qld, int qrow0, const bf16_t* __restrict__ K1, int k1ld,
                                          const bf16_t* __restrict__ K2, int k2ld, const bf16_t* __restrict__ V, int vld, int b, int ntiles, float mref, f32x4 (&O)[8][2]) {
    constexpr int NDK = DQ / 32, KP = DQ + 8, NKL = DQ / 64, C8 = DQ / 8;
    const int tid = mk_tid(), w = __builtin_amdgcn_readfirstlane(tid >> 6), lane = tid & 63, n = lane & 15, quad = lane >> 4;
    const unsigned vb0 = (unsigned)(size_t)(lds + AT_VT) + (unsigned)((quad * 4 + (n >> 2)) * AT_VRS + (n & 3) * 8);
    bf16x8 Qf[2][NDK];
#pragma unroll
    for (int qt = 0; qt < 2; ++qt)
#pragma unroll
        for (int dk = 0; dk < NDK; ++dk) Qf[qt][dk] = *(const bf16x8*)(Q + (size_t)(qrow0 + w * 32 + qt * 16 + n) * qld + dk * 32 + quad * 8);
    float lrun[2] = {0.f, 0.f};
#pragma unroll
    for (int dt = 0; dt < 8; ++dt) { O[dt][0] = (f32x4){0.f, 0.f, 0.f, 0.f}; O[dt][1] = (f32x4){0.f, 0.f, 0.f, 0.f}; }
    u32x4 kr[NKL], vr[2];
    auto issue = [&](int ktile) {
        const int rowb = ktile < 4 ? ML + b * 256 + ktile * 64 : b * 2048 + (ktile - 4) * 64;
#pragma unroll
        for (int i = 0; i < NKL; ++i) { const int idx = tid + i * 512, key = idx / C8, d0 = (idx % C8) * 8;
            const bf16_t* src = d0 < K1W ? K1 + (size_t)(rowb + key) * k1ld + d0 : K2 + (size_t)(rowb + key) * k2ld + (d0 - K1W);
            kr[i] = *(const u32x4*)src; }
#pragma unroll
        for (int i = 0; i < 2; ++i) { const int idx = tid + i * 512, key = idx >> 4, d0 = (idx & 15) * 8; vr[i] = *(const u32x4*)(V + (size_t)(rowb + key) * vld + d0); }
    };
    auto stage = [&](int bufi) { LAS bf16_t* Ks = (LAS bf16_t*)(lds + bufi * AT_BUF); LAS bf16_t* Vs = (LAS bf16_t*)(lds + bufi * AT_BUF + AT_VT);
#pragma unroll
        for (int i = 0; i < NKL; ++i) { const int idx = tid + i * 512, key = idx / C8, d0 = (idx % C8) * 8; *(LAS u32x4*)(Ks + key * KP + d0) = kr[i]; }
#pragma unroll
        for (int i = 0; i < 2; ++i) { const int idx = tid + i * 512, key = idx >> 4, d0 = (idx & 15) * 8; *(LAS u32x4*)(Vs + key * (AT_VRS / 2) + d0) = vr[i]; } };
    issue(0);
    __syncthreads();
    stage(0);
    if (ntiles > 1) issue(1);
    __syncthreads();
#pragma unroll 1
    for (int ktile = 0; ktile < ntiles; ++ktile) {
        const int bufi = ktile & 1;
        LAS bf16_t* Ks = (LAS bf16_t*)(lds + bufi * AT_BUF);
        const unsigned vb = vb0 + (unsigned)(bufi * AT_BUF);
        f32x4 s[4][2];
#pragma unroll
        for (int st = 0; st < 4; ++st) { s[st][0] = (f32x4){0.f, 0.f, 0.f, 0.f}; s[st][1] = (f32x4){0.f, 0.f, 0.f, 0.f};
#pragma unroll
            for (int dk = 0; dk < NDK; ++dk) { const bf16x8 a = *(const LAS bf16x8*)(Ks + (16 * st + n) * KP + 32 * dk + quad * 8);
                s[st][0] = MFMA(a, Qf[0][dk], s[st][0]); s[st][1] = MFMA(a, Qf[1][dk], s[st][1]); }
            asm volatile("" ::: "memory"); }
        bf16x8 Pf[2][2];
#pragma unroll
        for (int qt = 0; qt < 2; ++qt) {
            float ls = 0.f;
#pragma unroll
            for (int st = 0; st < 4; ++st)
#pragma unroll
                for (int j = 0; j < 4; ++j) { const float pv = __builtin_amdgcn_exp2f(s[st][qt][j] - mref); s[st][qt][j] = pv; ls += pv; }
            lrun[qt] += ls;
#pragma unroll
            for (int kb = 0; kb < 2; ++kb) Pf[qt][kb] = mk8(pk2(s[2 * kb][qt][0], s[2 * kb][qt][1]), pk2(s[2 * kb][qt][2], s[2 * kb][qt][3]), pk2(s[2 * kb + 1][qt][0], s[2 * kb + 1][qt][1]), pk2(s[2 * kb + 1][qt][2], s[2 * kb + 1][qt][3]));
        }
        pv_pair<0>(O, vb, Pf); pv_pair<2>(O, vb, Pf); pv_pair<4>(O, vb, Pf); pv_pair<6>(O, vb, Pf);
        if (ktile + 1 < ntiles) { stage(bufi ^ 1); if (ktile + 2 < ntiles) issue(ktile + 2); }
        __syncthreads();
    }
#pragma unroll
    for (int qt = 0; qt < 2; ++qt) { float l = lrun[qt]; l += __shfl_xor(l, 16); l += __shfl_xor(l, 32); const float inv = rcpf_(l);
#pragma unroll
        for (int dt = 0; dt < 8; ++dt) O[dt][qt] *= inv; }
}

__device__ __forceinline__ void attn_phase(const Ctx& p, int o, int l, bool need_ctx, LAS unsigned char* lds) {
    const int lane = mk_tid() & 63;
    const bf16_t* P = (const bf16_t*)(p.ws + WS_P); const bf16_t* UQ = (const bf16_t*)(p.ws + WS_U); const bf16_t* UKV = UQ + 768;
    bf16_t* MX = (bf16_t*)(p.ws + WS_A);
    const float lam_init = l == 1 ? 0.35550906759f : 0.55605820416f;
    float lam;
    { const float* lv = p.in[25] + o * 256; const float d1 = wsum(lv[lane] * lv[64 + lane]), d2 = wsum(lv[128 + lane] * lv[192 + lane]);
      lam = __uint_as_float(__builtin_amdgcn_readfirstlane(__float_as_uint(expf(d1) - expf(d2) + lam_init))); }
    float mref_d, mref_m;
    { const float L2E = 1.4426950408889634f;
      float gq = fabsf(p.in[26][o * 128 + lane]), gk = fabsf(p.in[26][o * 128 + 64 + lane]);
      float n0a = fmaxf(fabsf(p.in[32][o * 256 + lane]), fabsf(p.in[32][o * 256 + 64 + lane])), n1a = fmaxf(fabsf(p.in[32][o * 256 + 128 + lane]), fabsf(p.in[32][o * 256 + 192 + lane]));
      float r0 = fabsf(p.in[33][o * 128 + lane]), r1 = fabsf(p.in[33][o * 128 + 64 + lane]);
#pragma unroll
      for (int off = 32; off >= 1; off >>= 1) { gq = fmaxf(gq, __shfl_xor(gq, off)); gk = fmaxf(gk, __shfl_xor(gk, off)); n0a = fmaxf(n0a, __shfl_xor(n0a, off)); n1a = fmaxf(n1a, __shfl_xor(n1a, off)); r0 = fmaxf(r0, __shfl_xor(r0, off)); r1 = fmaxf(r1, __shfl_xor(r1, off)); }
      mref_d = __uint_as_float(__builtin_amdgcn_readfirstlane(__float_as_uint(64.0f * gq * gk * 0.125f * L2E * 1.01f + 0.5f)));
      mref_m = __uint_as_float(__builtin_amdgcn_readfirstlane(__float_as_uint(sqrtf((128.f * n0a * n0a + 64.f * r0 * r0) * (128.f * n1a * n1a + 64.f * r1 * r1)) * 0.07216878364870322f * L2E * 1.01f + 0.5f))); }
    const int nunits = need_ctx ? 576 : 512;
#pragma unroll 1
    for (int u = blockIdx.x; u < nunits; u += gridDim.x) {
        const bool isctx = u >= 512; const int uu = isctx ? u - 512 : u;
        const bool mla = isctx ? (uu < 32) : (uu < 256); const int v = isctx ? (uu & 31) : (uu & 255);
        int b, head, qb;
        if (isctx) { b = v >> 2; head = v & 3; qb = 0; } else { b = v >> 5; head = (v >> 3) & 3; qb = v & 7; }
        const int qrow0 = isctx ? ML + b * 256 : b * 2048 + qb * 256; const int ntiles = isctx ? 4 : 36;
        f32x4 O[8][2];
        if (mla) {
            attn_core<192, 128>(lds, UQ + head * 192, 1792, qrow0, UKV + head * 256, 1792, P + 2176, 2304, UKV + head * 256 + 128, 1792, b, ntiles, mref_m, O);
            const int t3 = mk_tid(), w = t3 >> 6, n = t3 & 15, quad = (t3 & 63) >> 4;
#pragma unroll
            for (int qt = 0; qt < 2; ++qt) { const size_t row = (size_t)(qrow0 + w * 32 + qt * 16 + n);
#pragma unroll
                for (int dt = 0; dt < 8; ++dt) { u32x2 ww; ww.x = pk2(O[dt][qt][0], O[dt][qt][1]); ww.y = pk2(O[dt][qt][2], O[dt][qt][3]); *(u32x2*)(MX + row * 1024 + 512 + head * 128 + 16 * dt + quad * 4) = ww; } }
        } else {
            LAS u32x2* O1s = (LAS u32x2*)(lds + 2 * AT_BUF) + mk_tid();
            attn_core<64, 64>(lds, P + head * 128, 2304, qrow0, P + 512 + head * 128, 2304, P, 2304, P + 1024 + head * 128, 2304, b, ntiles, mref_d, O);
#pragma unroll
            for (int dt = 0; dt < 8; ++dt)
#pragma unroll
                for (int qt = 0; qt < 2; ++qt) { u32x2 t2; t2.x = pk2(O[dt][qt][0], O[dt][qt][1]); t2.y = pk2(O[dt][qt][2], O[dt][qt][3]); O1s[(dt * 2 + qt) * 512] = t2; }
            attn_core<64, 64>(lds, P + head * 128 + 64, 2304, qrow0, P + 512 + head * 128 + 64, 2304, P, 2304, P + 1024 + head * 128, 2304, b, ntiles, mref_d, O);
            const float* sl = p.in[27] + o * 128; const int t3 = mk_tid(), w = t3 >> 6, n = t3 & 15, quad = (t3 & 63) >> 4, quad2 = quad;
#pragma unroll
            for (int qt = 0; qt < 2; ++qt) { const size_t row = (size_t)(qrow0 + w * 32 + qt * 16 + n); float ss = 0.f;
#pragma unroll
                for (int dt = 0; dt < 8; ++dt) { { const u32x2 t2 = O1s[(dt * 2 + qt) * 512]; O[dt][qt] = (f32x4){bflo(t2.x), bfhi(t2.x), bflo(t2.y), bfhi(t2.y)} - lam * O[dt][qt]; } ss += O[dt][qt][0] * O[dt][qt][0] + O[dt][qt][1] * O[dt][qt][1] + O[dt][qt][2] * O[dt][qt][2] + O[dt][qt][3] * O[dt][qt][3]; }
                ss += __shfl_xor(ss, 16); ss += __shfl_xor(ss, 32); const float rs = rsqrtf(ss * (1.0f / 128.0f) + 1e-6f) * (1.0f - lam_init);
#pragma unroll
                for (int dt = 0; dt < 8; ++dt) { const f32x4 g = *(const f32x4*)(sl + 16 * dt + quad2 * 4); u32x2 ww; ww.x = pk2(O[dt][qt][0] * rs * g[0], O[dt][qt][1] * rs * g[1]); ww.y = pk2(O[dt][qt][2] * rs * g[2], O[dt][qt][3] * rs * g[3]);
                    *(u32x2*)(MX + row * 1024 + head * 128 + 16 * dt + quad * 4) = ww; } }
        }
    }
}

#ifdef REP_PH
#define HG_DRY (reps == 0 && ph == REP_PH)
#else
#define HG_DRY false
#endif
#ifdef GONLY
#define GSEL(k) && (GONLY == k)
#else
#define GSEL(k)
#endif
__global__ void __launch_bounds__(512) mega(Params kp) {
    extern __shared__ __attribute__((aligned(16))) unsigned char shm[];
    LAS unsigned char* lds = (LAS unsigned char*)shm;
    cg::grid_group grid = cg::this_grid();
    { const float** tabw = (const float**)(kp.ws + WS_TAB); const int t = threadIdx.x; if (t < 34) tabw[t] = kp.in[t]; }
    volatile LAS unsigned* bst = (volatile LAS unsigned*)(lds + LDS_BYTES - 256);
    if (threadIdx.x < 2) bst[threadIdx.x] = 0u;
    __syncthreads();
    const XcdBarrier xbar = xcd_barrier_post((unsigned*)(kp.ws + WS_BAR), bst);
    const int ph_hi = kp.ph_hi;
#ifdef REP_PH
    int reps = 0;
#endif
#pragma unroll 1
    for (int ph = kp.ph_lo; ph < ph_hi; ++ph) {
        unsigned char* ws = kp.ws; asm volatile("" : "+s"(ws));
        Ctx p; p.ws = ws; p.in = (const float* const*)(ws + WS_TAB); p.out = kp.out;
        const int bid = blockIdx.x, nb = gridDim.x, w = __builtin_amdgcn_readfirstlane(mk_tid() >> 6);
        if (ph == 0) {
#if !defined(ONLY) || ONLY==0

#if defined(REP_PH) && defined(REP_PART)
 prep_phase(p, lds, reps ? REP_PART : 0);
#else
 prep_phase(p, lds, 0);
#endif
#endif
 }
        else if (ph == 1) prep2_phase(p, lds);
        else {
            const int l = (ph - 2) / 10, s = (ph - 2) % 10, eo = l >> 1;
            if (s == 0 || s == 7) continue;
            float* SS = (float*)(ws + WS_SS); const float* BIAS = (const float*)(ws + WS_BIAS) + (size_t)l * 9 * 8704; const bool odd = l & 1; const bool need_ctx = l < 3; const int Mres = need_ctx ? MT : ML;
            const float* mod = (const float*)(ws + WS_MOD) + (size_t)l * 9 * 6144;
            const bf16_t* Abuf = (const bf16_t*)(ws + WS_A);
            if (s == 1) {
#if !defined(ONLY) || ONLY==4
                EpiStore<true> E; E.O = (bf16_t*)(ws + WS_P); E.ss = SS + (size_t)(2 * l) * MT; E.bias = BIAS;
                if (!odd) { E.ldc = 3072; run_gemm(lds, Abuf, (const bf16_t*)(ws + WS_WAB) + (size_t)eo * 3072 * 1024, MT, 3072, 1024, E); }
                else { E.ldc = 2304; run_gemm(lds, Abuf, (const bf16_t*)(ws + WS_WCD) + (size_t)eo * 2304 * 1024, MT, 2304, 1024, E); }
#endif
            }
            else if (s == 2) {
                if (!odd) {
#if !defined(ONLY) || ONLY==1
                    for (int u = bid; u < 1152; u += nb) hg_pre_unit(p, eo, u, lds, HG_DRY);
                    if (!HG_DRY)
#endif
#if !defined(ONLY) || ONLY==2
                    for (int u = w * nb + bid; u < 1152; u += 8 * nb) s5_unit<1>(p, eo, u / 36, u % 36, lds);
#endif
                } else odd_post1(p, eo);
            }
            else if (s == 3) {
                if (!odd) s5_carry(p, eo);
                else {
#if !defined(ONLY) || ONLY==4
                    EpiStore<false> E; E.O = (bf16_t*)(ws + WS_U); E.ldc = 1792; E.ss = nullptr; E.bias = nullptr; run_gemm(lds, Abuf, (const bf16_t*)(ws + WS_WU) + (size_t)eo * 1792 * 640, MT, 1792, 640, E);
#endif
                }
            }
            else if (s == 4) {
                if (!odd) {
                    const bool split = nb >= 128;
#if !defined(ONLY) || ONLY==1
                    for (int chn = bid; chn < 64; chn += nb) hgrn_chain2(p, chn, lds, HG_DRY);
                    if (!HG_DRY)
#endif
#if !defined(ONLY) || ONLY==2
                    if (!split || bid >= 64) { const int nbb = split ? nb - 64 : nb, bb = split ? bid - 64 : bid;
                        for (int u = w * nbb + bb; u < 1152; u += 8 * nbb) s5_unit<2>(p, eo, u / 36, u % 36, lds); }
#endif
                } else odd_post2(p, eo);
            }
            else if (s == 5) {
                if (!odd) {
#if !defined(ONLY) || ONLY==4
                    EpiGLU E; E.MX = (bf16_t*)(ws + WS_A); E.Z = (const bf16_t*)(ws + WS_Z); E.bias = p.in[21] + eo * 512;
                    run_gemm(lds, (const bf16_t*)(ws + WS_Z), (const bf16_t*)(ws + WS_WGLU) + (size_t)eo * 512 * 512, MT, 512, 512, E);
                    __syncthreads();
#endif
                    hgrn_combine(p, eo);
                } else {
#if !defined(ONLY) || ONLY==3
                    attn_phase(p, eo, l, need_ctx, lds);
#endif
                }
            }
            else if (s == 6 || s == 9) {
#if !defined(ONLY) || ONLY==4
                EpiRes E; E.H = (float*)(ws + WS_H); E.gate = mod + (s == 6 ? 2 : 5) * 1024; E.out = (l == 3 && s == 9) ? p.out : nullptr;
                if (s == 6) { E.Hb = (bf16_t*)(ws + WS_HB1); E.gn = p.in[7] + l * 1024; E.scn = mod + 4 * 1024; E.ss = SS + (size_t)(2 * l + 1) * MT; }
                else if (l < 3) { E.Hb = (bf16_t*)(ws + WS_A); E.gn = p.in[6] + (l + 1) * 1024; E.scn = mod + 9 * 6144 + 1024; E.ss = SS + (size_t)(2 * l + 2) * MT; }
                else { E.Hb = nullptr; E.gn = nullptr; E.scn = nullptr; E.ss = nullptr; }
                if (s == 6) run_gemm(lds, Abuf, (const bf16_t*)(ws + WS_WO) + (size_t)l * 1024 * 1024, Mres, 1024, 1024, E);
                else run_gemm(lds, (const bf16_t*)(ws + WS_P), (const bf16_t*)(ws + WS_WFO) + (size_t)l * 1024 * 2816, Mres, 1024, 2816, E);
#endif
            }
            else if (s == 8) {
#if !defined(ONLY) || ONLY==4
                EpiSwiGLU E; E.G = (bf16_t*)(ws + WS_P); E.ss = SS + (size_t)(2 * l + 1) * MT; E.bias = BIAS + 3072;
                run_gemm(lds, (const bf16_t*)(ws + WS_HB1), (const bf16_t*)(ws + WS_WFI) + (size_t)l * 5632 * 1024, Mres, 5632, 1024, E);
#endif
            }
        }
        if (ph + 1 < ph_hi) { if (ph_hi > 1000) grid.sync(); else xcd_barrier(xbar); }
#ifdef EXTRA_SYNC
        if (ph == 0) { for (int q = 0; q < 32; ++q) xcd_barrier(xbar); }
#endif
#ifdef REP_PH
        if (ph == REP_PH && reps < 1) { ++reps; --ph; }
#endif
    }
}

extern "C" void kernel_launch(void* const* d_in, const int* in_sizes, int n_in, void* d_out, int out_size, void* d_ws, size_t ws_size, hipStream_t stream) {
    static int grid = 0;
    if (grid == 0) {
        if (n_in != 34 || ws_size < WS_NEED) { fprintf(stderr, "kernel_launch: unexpected n_in %d / ws_size %zu (need %zu)\n", n_in, ws_size, (size_t)WS_NEED); }
        int dev = 0, cus = 0, per_cu = 0;
        hipGetDevice(&dev); hipDeviceGetAttribute(&cus, hipDeviceAttributeMultiprocessorCount, dev);
        hipFuncSetAttribute((const void*)mega, hipFuncAttributeMaxDynamicSharedMemorySize, LDS_BYTES);
        hipOccupancyMaxActiveBlocksPerMultiprocessor(&per_cu, (const void*)mega, 512, LDS_BYTES);
        (void)hipGetLastError();
        if (per_cu < 1) fprintf(stderr, "kernel_launch: occupancy query says %d blocks per CU\n", per_cu);
        grid = cus > 0 ? cus : 256;
    }
    hipMemsetAsync((char*)d_ws + WS_SS, 0, 8ull * MT * 4 + XCD_BAR_WORDS * 4, stream);
    Params p{};
    for (int i = 0; i < 34; ++i) p.in[i] = (const float*)d_in[i];
    p.out = (float*)d_out; p.ws = (unsigned char*)d_ws;
#if MK_MODE == 0
    p.ph_lo = 0; p.ph_hi = NPH;
    void* args[] = {&p};
    hipError_t e = hipLaunchCooperativeKernel((const void*)mega, dim3(grid), dim3(512), args, LDS_BYTES, stream);
    if (e != hipSuccess) fprintf(stderr, "cooperative launch failed: %s (grid %d)\n", hipGetErrorString(e), grid);
#else
    for (int ph = 0; ph < NPH; ++ph) { p.ph_lo = ph; p.ph_hi = ph + 1; hipLaunchKernelGGL(mega, dim3(grid), dim3(512), LDS_BYTES, stream, p); }
#endif
}
```

```cpp
#include <hip/hip_runtime.h>
#include <hip/hip_cooperative_groups.h>
#include <cstdio>
namespace cg = cooperative_groups;
#ifndef MK_MODE
#define MK_MODE 0
#endif
__device__ __forceinline__ int mk_tid() { int t = threadIdx.x; asm volatile("" : "+v"(t)); return t; }
namespace pg8 {
#define PG8_LAS __attribute__((address_space(3)))
typedef unsigned short bf16_t;
typedef short bf16x8 __attribute__((ext_vector_type(8)));
typedef float f32x4 __attribute__((ext_vector_type(4)));
typedef unsigned u32x4 __attribute__((ext_vector_type(4)));
constexpr int BM = 256, BK = 64, HALF = 128, HTB = HALF * BK * 2  , STAGE_BYTES = 8 * HTB, NXCD = 8, WGM = 8;

__host__ __device__ __forceinline__ int lds_byte(int r, int c) { const int st = (r >> 4) * 2 + (c >> 5), rr = r & 15, cc = c & 31, ob = rr * 64 + cc * 2; return st * 1024 + (ob ^ (((ob >> 9) & 1) << 5)); }
__host__ __device__ __forceinline__ void stage_rc(int b, int& R, int& C) { const int st = b / 1024, sb = b % 1024, swz = sb ^ (((sb >> 9) & 1) << 5); R = (st >> 1) * 16 + swz / 64; C = (st & 1) * 32 + (swz % 64) / 2; }
__host__ __device__ __forceinline__ int perm32(int rho) { const int n = rho >> 4, i = rho & 15; return 8 * (i >> 2) + 4 * n + (i & 3); }

struct Unit { int pm, pn, ks; };
struct Gemm { const bf16_t* A; const bf16_t* Bt; int M, N, K, ld; };

struct StaticOrder {
    int nM, nN, nwg, G, c;
    __host__ __device__ void init(int M, int N, int G_, int c_) { nM = M / BM; nN = N / BM; nwg = nM * nN; G = G_; c = c_; }
    __host__ __device__ bool next(int i, Unit& u) const {
        const long L = (long)i * G + c; if (L >= nwg) return false;
        int wgid = (int)L; { const int q = nwg / NXCD, r = nwg % NXCD, xcd = wgid % NXCD, off = wgid / NXCD; wgid = (xcd < r ? xcd * (q + 1) : r * (q + 1) + (xcd - r) * q) + off; }
        const int nig = WGM * nN, gid = wgid / nig, fm = gid * WGM, gsz = (nM - fm) < WGM ? (nM - fm) : WGM;
        u.pm = fm + ((wgid % nig) % gsz); u.pn = (wgid % nig) / gsz; u.ks = 0; return true;
    }
    __device__ __forceinline__ void a_ready(const Unit&) const {}
    __device__ __forceinline__ void done(const Unit&) const {}
};
struct SliceOrder {
    int pm0, nN, nsplit, total, G, c;
    __host__ __device__ void init(int pm0_, int ntm, int N, int nsplit_, int G_, int c_) { pm0 = pm0_; nN = N / BM; nsplit = nsplit_; total = ntm * nN * nsplit_; G = G_; c = c_; }
    __host__ __device__ bool next(int i, Unit& u) const { const int L = i * G + c; if (L >= total) return false; const int tile = L / nsplit; u.ks = L - tile * nsplit; u.pm = pm0 + tile / nN; u.pn = tile % nN; return true; }
    __device__ __forceinline__ void a_ready(const Unit&) const {}
    __device__ __forceinline__ void done(const Unit&) const {}
};
typedef __bf16 bf16x2_native __attribute__((ext_vector_type(2)));
typedef float f32x2_native __attribute__((ext_vector_type(2)));
__device__ __forceinline__ unsigned cvt_pk_bf16(float lo, float hi) { const f32x2_native v = {lo, hi}; const bf16x2_native r = __builtin_convertvector(v, bf16x2_native); return __builtin_bit_cast(unsigned, r); }
typedef float f32x2 __attribute__((ext_vector_type(2)));
template <class Epi, class Sched, bool STAMP = false>
__device__ __forceinline__ void gemm_phase(PG8_LAS unsigned char* lds, const Gemm g, const Sched& S, const Epi& E, unsigned long long* stamps) {
    const int tid = mk_tid(), wid = __builtin_amdgcn_readfirstlane(tid >> 6), lane = tid & 63, wr = wid >> 2, wc = wid & 3, fr = lane & 15, fq = lane >> 4;
    const int K = g.K, nt = K / BK;
    int ts_lo = 0, ts_hi = 0, nts = 0; const unsigned long long rt_entry = STAMP ? (unsigned long long)wall_clock64() : 0ull;
#define PG8_STAMP() do { if (STAMP && wid == 0 && nts < 64) { const unsigned long long _c = (unsigned long long)clock64(); \
        ts_lo = (lane == nts) ? (int)(unsigned)_c : ts_lo; ts_hi = (lane == nts) ? (int)(unsigned)(_c >> 32) : ts_hi; ++nts; } } while (0)
    PG8_STAMP();
    unsigned voffA[2], voffB[2];
#pragma unroll
    for (int i = 0; i < 2; ++i) { int R, C; stage_rc(tid * 16 + i * 8192, R, C); const int Rb = Epi::PERM ? ((R & ~31) + perm32(R & 31)) : R;
        voffA[i] = (unsigned)(R * g.ld + C) * 2u; voffB[i] = (unsigned)(Rb * g.ld + C) * 2u; }
    const size_t kstep = (size_t)(BK * 2);
    const size_t hstep = (size_t)HALF * g.ld * 2;
    const size_t tstep = 2 * hstep;
    const unsigned ldsw = (unsigned)wid * 1024u;
    const int aoff = lds_byte(wr * 64 + fr, fq * 8), boff = lds_byte(wc * 32 + fr, fq * 8);
#define PG8_SA(b, h) (((b) * 2 + (h)) * HTB)
#define PG8_SB(b, h) ((4 + (b) * 2 + (h)) * HTB)
#define PG8_STAGE(bufoff, gbase, voff) do { _Pragma("unroll") for (int _i = 0; _i < 2; ++_i) \
        __builtin_amdgcn_global_load_lds((const unsigned*)((const char*)(gbase) + (voff)[_i]), (PG8_LAS unsigned*)(lds + (bufoff) + ldsw + _i * 8192), 16, 0, 0); } while (0)
#define PG8_LDA(dst, b, h) do { _Pragma("unroll") for (int m = 0; m < 4; ++m) _Pragma("unroll") for (int k = 0; k < 2; ++k) dst[m][k] = *(const PG8_LAS bf16x8*)(lds + PG8_SA(b, h) + aoff + m * 2048 + k * 1024); } while (0)
#define PG8_LDB(dst, b, h) do { _Pragma("unroll") for (int n = 0; n < 2; ++n) _Pragma("unroll") for (int k = 0; k < 2; ++k) dst[n][k] = *(const PG8_LAS bf16x8*)(lds + PG8_SB(b, h) + boff + n * 2048 + k * 1024); } while (0)
#define PG8_MMA(ai, bj, At, Bt) do { __builtin_amdgcn_s_setprio(1); _Pragma("unroll") for (int m = 0; m < 4; ++m) _Pragma("unroll") for (int n = 0; n < 2; ++n) _Pragma("unroll") for (int k = 0; k < 2; ++k) \
        acc[ai][bj][m][n] = __builtin_amdgcn_mfma_f32_16x16x32_bf16(Bt[n][k], At[m][k], acc[ai][bj][m][n], 0, 0, 0); __builtin_amdgcn_s_setprio(0); } while (0)
#define PG8_WAIT_V(n) asm volatile("s_waitcnt vmcnt(" #n ")" ::: "memory")
#define PG8_WAIT_L(n) asm volatile("s_waitcnt lgkmcnt(" #n ")" ::: "memory")
#define PG8_BAR __builtin_amdgcn_s_barrier()
#define PG8_SCHED __builtin_amdgcn_sched_barrier(0)
    Unit cur, nxt; int ui = 0;
    if (!S.next(0, cur)) return;
    f32x4 acc[2][2][4][2];
#pragma unroll
    for (int a = 0; a < 2; ++a)
#pragma unroll
        for (int b = 0; b < 2; ++b)
#pragma unroll
            for (int m = 0; m < 4; ++m)
#pragma unroll
                for (int n = 0; n < 2; ++n) acc[a][b][m][n] = (f32x4){0.f, 0.f, 0.f, 0.f};
    bf16x8 At[4][2], B0[2][2], B1[2][2];
    const char* cA = (const char*)g.A + (size_t)cur.pm * tstep + (size_t)cur.ks * K * 2; const char* cB = (const char*)g.Bt + (size_t)cur.pn * tstep + (size_t)cur.ks * K * 2;
    S.a_ready(cur);
    PG8_STAGE(PG8_SB(0, 0), cB, voffB); PG8_STAGE(PG8_SA(0, 0), cA, voffA); PG8_STAGE(PG8_SB(0, 1), cB + hstep, voffB); PG8_STAGE(PG8_SA(0, 1), cA + hstep, voffA);
    if (wr == 1) PG8_BAR;
    PG8_WAIT_V(4); PG8_BAR;
    PG8_STAGE(PG8_SB(1, 0), cB + kstep, voffB); PG8_STAGE(PG8_SA(1, 0), cA + kstep, voffA); PG8_STAGE(PG8_SB(1, 1), cB + hstep + kstep, voffB);
    PG8_WAIT_V(6); PG8_BAR;
    PG8_STAMP();
    for (;;) {
        const bool has_next = S.next(ui + 1, nxt);
        const char* nA = has_next ? (const char*)g.A + (size_t)nxt.pm * tstep + (size_t)nxt.ks * K * 2 : cA; const char* nB = has_next ? (const char*)g.Bt + (size_t)nxt.pn * tstep + (size_t)nxt.ks * K * 2 : cB;
        for (int t = 0; t < nt; t += 2) {
            const bool last = (t == nt - 2);
            const char* a1 = cA + (size_t)(t + 1) * kstep;
            const char* a2 = last ? nA : cA + (size_t)(t + 2) * kstep; const char* b2 = last ? nB : cB + (size_t)(t + 2) * kstep;
            const char* a3 = a2 + kstep; const char* b3 = b2 + kstep;
            if (last && has_next) S.a_ready(nxt);
            PG8_LDB(B0, 0, 0); PG8_SCHED; PG8_LDA(At, 0, 0); PG8_STAGE(PG8_SA(1, 1), a1 + hstep, voffA);
            PG8_WAIT_L(8); PG8_BAR; PG8_WAIT_L(0); PG8_MMA(0, 0, At, B0); PG8_BAR; PG8_SCHED;
            PG8_LDB(B1, 0, 1); PG8_STAGE(PG8_SB(0, 0), b2, voffB);
            PG8_BAR; PG8_WAIT_L(0); PG8_MMA(0, 1, At, B1); PG8_BAR;
            PG8_LDA(At, 0, 1); PG8_STAGE(PG8_SA(0, 0), a2, voffA);
            PG8_BAR; PG8_WAIT_L(0); PG8_MMA(1, 0, At, B0); PG8_BAR; PG8_SCHED;
            PG8_STAGE(PG8_SB(0, 1), b2 + hstep, voffB);
            PG8_WAIT_V(6); PG8_BAR; PG8_MMA(1, 1, At, B1); PG8_BAR;
            PG8_LDB(B0, 1, 0); PG8_SCHED; PG8_LDA(At, 1, 0); PG8_STAGE(PG8_SA(0, 1), a2 + hstep, voffA);
            PG8_WAIT_L(8); PG8_BAR; PG8_WAIT_L(0); PG8_MMA(0, 0, At, B0); PG8_BAR; PG8_SCHED;
            PG8_LDB(B1, 1, 1); PG8_STAGE(PG8_SB(1, 0), b3, voffB);
            PG8_BAR; PG8_WAIT_L(0); PG8_MMA(0, 1, At, B1); PG8_BAR;
            PG8_LDA(At, 1, 1); PG8_STAGE(PG8_SA(1, 0), a3, voffA);
            PG8_BAR; PG8_WAIT_L(0); PG8_MMA(1, 0, At, B0); PG8_BAR; PG8_SCHED;
            PG8_STAGE(PG8_SB(1, 1), b3 + hstep, voffB);
            PG8_WAIT_V(6); PG8_BAR; PG8_MMA(1, 1, At, B1); PG8_BAR;
        }
        PG8_STAMP();
        if constexpr (!Epi::AFTER_DRAIN) { E(acc, cur, wr, wc, fr, fq); S.done(cur); }
        PG8_STAMP();
        if (!has_next) break;
#pragma unroll
        for (int a = 0; a < 2; ++a)
#pragma unroll
            for (int b = 0; b < 2; ++b)
#pragma unroll
                for (int m = 0; m < 4; ++m)
#pragma unroll
                    for (int n = 0; n < 2; ++n) acc[a][b][m][n] = (f32x4){0.f, 0.f, 0.f, 0.f};
        cur = nxt; cA = nA; cB = nB; ++ui;
    }
    PG8_WAIT_V(0);
    if (wr == 0) PG8_BAR;
    PG8_BAR;
    if constexpr (Epi::AFTER_DRAIN) { E.fused(acc, cur, wr, wc, fr, fq, lds, wid, lane); S.done(cur); }
    PG8_STAMP();
    if (STAMP && wid == 0) { stamps[lane] = lane < nts ? (((unsigned long long)(unsigned)ts_hi << 32) | (unsigned)ts_lo) : 0ull;
        if (lane == 62) stamps[62] = rt_entry; if (lane == 63) stamps[63] = (unsigned long long)wall_clock64(); }
#undef PG8_STAMP
#undef PG8_SA
#undef PG8_SB
#undef PG8_STAGE
#undef PG8_LDA
#undef PG8_LDB
#undef PG8_MMA
#undef PG8_WAIT_V
#undef PG8_WAIT_L
#undef PG8_BAR
#undef PG8_SCHED
}
}

using pg8::bf16_t; using pg8::bf16x8; using pg8::f32x4; using pg8::u32x4;
#define LAS __attribute__((address_space(3)))
typedef unsigned u32x2 __attribute__((ext_vector_type(2)));
typedef short bf16x4 __attribute__((ext_vector_type(4)));

#define XB_TMO      128
#define XB_XCNT(j)  (256  + 64 * (j))
#define XB_XSUB(j)  (1280 + 64 * (j))
#define XB_XGEN(j)  (2304 + 64 * (j))
#define XB_TOP      3328
#define XB_TOPGEN   3392
#define XCD_BAR_WORDS 3456
#define XB_SPIN_CAP (1u << 18)

__device__ __forceinline__ unsigned xb_ld(unsigned* p)              { return __hip_atomic_load(p, __ATOMIC_RELAXED, __HIP_MEMORY_SCOPE_AGENT); }
__device__ __forceinline__ unsigned xb_add(unsigned* p, unsigned v) { return __hip_atomic_fetch_add(p, v, __ATOMIC_RELAXED, __HIP_MEMORY_SCOPE_AGENT); }
__device__ __forceinline__ unsigned xb_xcc_id() { return (unsigned)__builtin_amdgcn_s_getreg((3 << 11) | 20) & 0xFu; }
#define XB_SPIN(cond, bar) do { unsigned _sp = 0; while (cond) { __builtin_amdgcn_s_sleep(1); \
    if ((++_sp & 255u) == 0u) { if (xb_ld(&(bar)[XB_TMO])) break; if (_sp > XB_SPIN_CAP) { atomicAdd(&(bar)[XB_TMO], 1u); break; } } } } while (0)

struct XcdBarrier {
    unsigned* bar; unsigned x;
    volatile LAS unsigned* st;
};

__device__ __forceinline__ XcdBarrier xcd_barrier_post(unsigned* bar, volatile LAS unsigned* st) {
    XcdBarrier b; b.bar = bar; b.x = xb_xcc_id(); b.st = st;
    if (threadIdx.x == 0) (void)xb_add(&bar[XB_XCNT(b.x)], 1u);
    return b;
}
__device__ __forceinline__ void xcd_barrier_complete(unsigned* bar, unsigned x, unsigned& nloc, unsigned& nx) {
    const unsigned G = gridDim.x * gridDim.y * gridDim.z;
    unsigned sum, cnt, mine, sp = 0u;
    for (;;) {
        sum = 0u; cnt = 0u; mine = 0u;
#pragma unroll
        for (unsigned j = 0; j < 16; ++j) { const unsigned c = xb_ld(&bar[XB_XCNT(j)]); sum += c; cnt += (c > 0u) ? 1u : 0u; mine = (j == x) ? c : mine; }
        if (sum == G) break;
        __builtin_amdgcn_s_sleep(1);
        if ((++sp & 255u) == 0u) { if (xb_ld(&bar[XB_TMO])) break; if (sp > XB_SPIN_CAP) { atomicAdd(&bar[XB_TMO], 1u); break; } }
    }
    nloc = mine > 0u ? mine : 1u; nx = cnt > 0u ? cnt : 1u;
}

__device__ __forceinline__ void xcd_barrier(const XcdBarrier& b) {
    asm volatile("s_waitcnt vmcnt(0)" ::: "memory");
    __syncthreads();
    if (threadIdx.x == 0) {
        unsigned* bar = b.bar;
        __builtin_amdgcn_s_waitcnt(0);
        unsigned nloc = b.st[0], nx = b.st[1];
        if (nloc == 0u) { xcd_barrier_complete(bar, b.x, nloc, nx); b.st[0] = nloc; b.st[1] = nx; }
        const unsigned old = xb_add(&bar[XB_XSUB(b.x)], 1u);
        const unsigned gen = old / nloc;
        if (old + 1u == (gen + 1u) * nloc) {
            __builtin_amdgcn_fence(__ATOMIC_RELEASE, "agent");
            asm volatile("s_waitcnt vmcnt(0)" ::: "memory");
            const unsigned og = xb_add(&bar[XB_TOP], 1u);
            const unsigned tg = og / nx;
            if (og + 1u == (tg + 1u) * nx) xb_add(&bar[XB_TOPGEN], 1u);
            else XB_SPIN(xb_ld(&bar[XB_TOPGEN]) == tg, bar);
            __builtin_amdgcn_fence(__ATOMIC_ACQUIRE, "agent");
            xb_add(&bar[XB_XGEN(b.x)], 1u);
            asm volatile("s_waitcnt vmcnt(0)" ::: "memory");
        } else {
            XB_SPIN(xb_ld(&bar[XB_XGEN(b.x)]) == gen, bar);
            __builtin_amdgcn_fence(__ATOMIC_ACQUIRE, "agent");
            asm volatile("s_waitcnt vmcnt(0)" ::: "memory");
        }
    }
    __syncthreads();
}

constexpr int DM = 1024, ML = 16384, MC = 2048, MT = 18432, FH = 2816;
constexpr int LDS_BYTES = 152 * 1024 + 256;
constexpr int NPH = 42;

constexpr size_t WS_H    = 0;
constexpr size_t WS_A    = WS_H + (size_t)MT * DM * 4;
constexpr size_t WS_P    = WS_A + (size_t)MT * DM * 2;
constexpr size_t WS_WFI  = WS_P + (size_t)MT * 3072 * 2;
constexpr size_t WS_WFO  = WS_WFI + 4ull * 5632 * 1024 * 2;
constexpr size_t WS_WO   = WS_WFO + 4ull * 1024 * 2816 * 2;
constexpr size_t WS_WAB  = WS_WO + 4ull * 1024 * 1024 * 2;
constexpr size_t WS_WCD  = WS_WAB + 2ull * 3072 * 1024 * 2;
constexpr size_t WS_WGLU = WS_WCD + 2ull * 2304 * 1024 * 2;
constexpr size_t WS_WU   = WS_WGLU + 2ull * 512 * 512 * 2;
constexpr size_t WS_MOD  = WS_WU + 2ull * 1792 * 640 * 2;
constexpr size_t WS_ROPE = WS_MOD + 4ull * 9 * 6144 * 4;
constexpr size_t WS_S5A  = WS_ROPE + 64 * 16 * 2 * 4;
constexpr size_t WS_S5BB = WS_S5A + 2ull * 2 * 32 * 64 * 4 * 4;
constexpr size_t WS_S5CC = WS_S5BB + 2ull * 2 * 32 * 2 * 64 * 16 * 2;
constexpr size_t WS_LB   = WS_S5CC + 2ull * 2 * 32 * 4 * 16 * 32 * 2;
constexpr size_t WS_TAB  = WS_LB + 2 * 512 * 4;
constexpr size_t WS_SS   = (WS_TAB + 64 * 8 + 255) & ~(size_t)255;
constexpr size_t WS_BAR  = WS_SS + 8ull * MT * 4;
constexpr size_t WS_BIAS = WS_BAR + XCD_BAR_WORDS * 4;
constexpr size_t WS_X    = WS_BIAS + 4ull * 9 * 8704 * 4;
constexpr size_t WS_HB1  = WS_X;
constexpr size_t WS_OF   = WS_X;
constexpr size_t WS_OB   = WS_OF + (size_t)MT * 512 * 2;
constexpr size_t WS_Z    = WS_OB + (size_t)MT * 512 * 2;
constexpr size_t WS_E    = WS_Z + (size_t)MT * 512 * 2;
constexpr size_t WS_E63  = WS_E + 8ull * 2 * 36 * 32 * 128 * 4;
constexpr size_t WS_END_EVEN = WS_E63 + 2ull * 288 * 4 * 128 * 2;
constexpr size_t WS_Q1   = WS_A;
constexpr size_t WS_VT1  = WS_A + (size_t)MT * 512 * 2;
constexpr size_t WS_U    = WS_X;
constexpr size_t WS_END_ODD = WS_U + (size_t)MT * 1792 * 2;
constexpr size_t WS_NEED = WS_END_EVEN > WS_END_ODD ? WS_END_EVEN : WS_END_ODD;
static_assert(WS_NEED <= 402653184ull, "workspace too large");

struct Params { const float* in[34]; float* out; unsigned char* ws; int ph_lo, ph_hi; };
struct Ctx { unsigned char* ws; const float* const* in; float* out; };

__device__ __forceinline__ float bf2f(unsigned v) { return __uint_as_float(v << 16); }
__device__ __forceinline__ float bflo(unsigned w) { return __uint_as_float(w << 16); }
__device__ __forceinline__ float bfhi(unsigned w) { return __uint_as_float(w & 0xffff0000u); }
__device__ __forceinline__ unsigned pk2(float lo, float hi) { return pg8::cvt_pk_bf16(lo, hi); }
__device__ __forceinline__ bf16_t f2bf(float f) { unsigned u = __float_as_uint(f); u += 0x7FFFu + ((u >> 16) & 1u); return (bf16_t)(u >> 16); }
__device__ __forceinline__ float wsum(float v) {
#pragma unroll
    for (int o = 32; o >= 1; o >>= 1) v += __shfl_xor(v, o);
    return v; }
__device__ __forceinline__ float rcpf_(float x) { return __builtin_amdgcn_rcpf(x); }
__device__ __forceinline__ float siluf(float x) { return x * rcpf_(1.0f + __expf(-x)); }
__device__ __forceinline__ bf16x8 mk8(unsigned a, unsigned b, unsigned c, unsigned d) { u32x4 w = {a, b, c, d}; return __builtin_bit_cast(bf16x8, w); }
__device__ __forceinline__ bf16x8 zero8() { return mk8(0u, 0u, 0u, 0u); }
#define MFMA(a, b, c) __builtin_amdgcn_mfma_f32_16x16x32_bf16((a), (b), (c), 0, 0, 0)

__device__ __forceinline__ double dexp(double x) {
    const double y = x * (1.0 / 64.0); double s = 1.0, t = 1.0;
#pragma unroll
    for (int i = 1; i <= 13; ++i) { t *= y * (1.0 / (double)i); s += t; }
#pragma unroll
    for (int i = 0; i < 6; ++i) s *= s;
    return s; }
__device__ __forceinline__ void dsincos(double x, double& sn, double& cs) {
    const double TWO_PI = 6.283185307179586476925287; const double k = rint(x * (1.0 / TWO_PI)); const double r = (x - k * TWO_PI) * 0.125;
    const double r2 = r * r; double s = r, t = r, c = 1.0, u = 1.0;
#pragma unroll
    for (int i = 1; i <= 7; ++i) { t *= -r2 * (1.0 / (double)((2 * i) * (2 * i + 1))); s += t; u *= -r2 * (1.0 / (double)((2 * i - 1) * (2 * i))); c += u; }
#pragma unroll
    for (int i = 0; i < 3; ++i) { const double s2 = 2.0 * s * c, c2 = c * c - s * s; s = s2; c = c2; }
    sn = s; cs = c; }

struct EpiRes {
    static constexpr bool PERM = false, AFTER_DRAIN = false;
    float* H; const float* gate; float* out;
    bf16_t* Hb; const float* gn; const float* scn; float* ss;
    __device__ __forceinline__ void operator()(const f32x4 (&acc)[2][2][4][2], const pg8::Unit& u, int wr, int wc, int fr, int fq) const {
        const int r = u.pm < 64 ? (u.pm >> 3) : 8;
        const int row0 = u.pm * 256 + wr * 64 + fr, col0 = u.pn * 256 + wc * 32 + 4 * fq;
        const float* gp = gate + r * 6144 + col0;
        f32x4 gv[2][2], gs[2][2];
#pragma unroll
        for (int bj = 0; bj < 2; ++bj)
#pragma unroll
            for (int n = 0; n < 2; ++n) { const int co = bj * 128 + n * 16; gv[bj][n] = *(const f32x4*)(gp + co); gs[bj][n] = (f32x4){0.f, 0.f, 0.f, 0.f};
                if (Hb != nullptr) gs[bj][n] = *(const f32x4*)(gn + col0 + co) * (*(const f32x4*)(scn + r * 6144 + col0 + co) + 1.0f); }
#pragma unroll
        for (int am = 0; am < 4; ++am) { const int ai = am >> 1, m0 = (am & 1) * 2;
            f32x4 hv[2][2][2];
#pragma unroll
            for (int mm = 0; mm < 2; ++mm)
#pragma unroll
                for (int bj = 0; bj < 2; ++bj)
#pragma unroll
                    for (int n = 0; n < 2; ++n) hv[mm][bj][n] = *(const f32x4*)(H + (size_t)(row0 + ai * 128 + (m0 + mm) * 16) * 1024 + col0 + bj * 128 + n * 16);
            asm volatile("" ::: "memory");
#pragma unroll
            for (int mm = 0; mm < 2; ++mm) { const int m = m0 + mm; const int row = row0 + ai * 128 + m * 16; float sq = 0.f;
#pragma unroll
                for (int bj = 0; bj < 2; ++bj)
#pragma unroll
                    for (int n = 0; n < 2; ++n) { const size_t off = (size_t)row * 1024 + col0 + bj * 128 + n * 16;
                        const f32x4 v = hv[mm][bj][n] + gv[bj][n] * acc[ai][bj][m][n];
                        if (out == nullptr) *(f32x4*)(H + off) = v; else if (u.pm < 64) *(f32x4*)(out + off) = v;
                        if (Hb != nullptr) { sq += v[0] * v[0] + v[1] * v[1] + v[2] * v[2] + v[3] * v[3]; const f32x4 hb = v * gs[bj][n];
                            u32x2 w; w.x = pk2(hb[0], hb[1]); w.y = pk2(hb[2], hb[3]); *(u32x2*)(Hb + off) = w; } }
                if (Hb != nullptr) { sq += __shfl_xor(sq, 16); sq += __shfl_xor(sq, 32); if (fq == 0) (void)__hip_atomic_fetch_add(ss + row, sq, __ATOMIC_RELAXED, __HIP_MEMORY_SCOPE_AGENT); } }
            asm volatile("" ::: "memory");
        }
    }
};
template <bool NORM> struct EpiStore {
    static constexpr bool PERM = true, AFTER_DRAIN = false;
    bf16_t* O; int ldc; const float* ss; const float* bias;
    __device__ __forceinline__ void operator()(const f32x4 (&acc)[2][2][4][2], const pg8::Unit& u, int wr, int wc, int fr, int fq) const {
        const int row0 = u.pm * 256 + wr * 64 + fr, col0 = u.pn * 256 + wc * 32 + 8 * fq;
        const int r = u.pm < 64 ? (u.pm >> 3) : 8;
        f32x4 bv[2][2];
#pragma unroll
        for (int bj = 0; bj < 2; ++bj)
#pragma unroll
            for (int n = 0; n < 2; ++n) bv[bj][n] = NORM ? *(const f32x4*)(bias + r * 8704 + col0 + bj * 128 + 4 * n) : (f32x4){0.f, 0.f, 0.f, 0.f};
        float rsv[2][4];
#pragma unroll
        for (int ai = 0; ai < 2; ++ai)
#pragma unroll
            for (int m = 0; m < 4; ++m) rsv[ai][m] = NORM ? ss[row0 + ai * 128 + m * 16] : 1.0f;
        asm volatile("" ::: "memory");
#pragma unroll
        for (int ai = 0; ai < 2; ++ai)
#pragma unroll
            for (int m = 0; m < 4; ++m) { const int row = row0 + ai * 128 + m * 16; bf16_t* rowp = O + (size_t)row * ldc + col0;
                const float rs = NORM ? rsqrtf(rsv[ai][m] * (1.0f / 1024.0f) + 1e-6f) : 1.0f;
#pragma unroll
                for (int bj = 0; bj < 2; ++bj) { const f32x4 v0 = acc[ai][bj][m][0] * rs + bv[bj][0], v1 = acc[ai][bj][m][1] * rs + bv[bj][1];
                    u32x4 w; w.x = pk2(v0[0], v0[1]); w.y = pk2(v0[2], v0[3]); w.z = pk2(v1[0], v1[1]); w.w = pk2(v1[2], v1[3]);
                    *(u32x4*)(rowp + bj * 128) = w; } }
    }
};
struct EpiSwiGLU {
    static constexpr bool PERM = true, AFTER_DRAIN = false;
    bf16_t* G; const float* ss; const float* bias;
    __device__ __forceinline__ void operator()(const f32x4 (&acc)[2][2][4][2], const pg8::Unit& u, int wr, int wc, int fr, int fq) const {
        const int row0 = u.pm * 256 + wr * 64 + fr, col0 = u.pn * 128 + wc * 32 + 8 * fq;
        const int r = u.pm < 64 ? (u.pm >> 3) : 8;
        const float* bp = bias + r * 8704 + u.pn * 256 + wc * 32 + 8 * fq;
        const f32x4 bg0 = *(const f32x4*)bp, bg1 = *(const f32x4*)(bp + 4), bu0 = *(const f32x4*)(bp + 128), bu1 = *(const f32x4*)(bp + 132);
        float rsv[2][4];
#pragma unroll
        for (int ai = 0; ai < 2; ++ai)
#pragma unroll
            for (int m = 0; m < 4; ++m) rsv[ai][m] = ss[row0 + ai * 128 + m * 16];
        asm volatile("" ::: "memory");
#pragma unroll
        for (int ai = 0; ai < 2; ++ai)
#pragma unroll
            for (int m = 0; m < 4; ++m) { const int row = row0 + ai * 128 + m * 16; bf16_t* rowp = G + (size_t)row * FH + col0;
                const float rs = rsqrtf(rsv[ai][m] * (1.0f / 1024.0f) + 1e-6f);
                const f32x4 g0 = acc[ai][0][m][0] * rs + bg0, g1 = acc[ai][0][m][1] * rs + bg1, u0 = acc[ai][1][m][0] * rs + bu0, u1 = acc[ai][1][m][1] * rs + bu1;
                u32x4 w; w.x = pk2(siluf(g0[0]) * u0[0], siluf(g0[1]) * u0[1]); w.y = pk2(siluf(g0[2]) * u0[2], siluf(g0[3]) * u0[3]);
                w.z = pk2(siluf(g1[0]) * u1[0], siluf(g1[1]) * u1[1]); w.w = pk2(siluf(g1[2]) * u1[2], siluf(g1[3]) * u1[3]);
                *(u32x4*)rowp = w; }
    }
};
struct EpiGLU {
    static constexpr bool PERM = true, AFTER_DRAIN = false;
    bf16_t* MX; const bf16_t* Z; const float* bias;
    __device__ __forceinline__ void operator()(const f32x4 (&acc)[2][2][4][2], const pg8::Unit& u, int wr, int wc, int fr, int fq) const {
        const int row0 = u.pm * 256 + wr * 64 + fr, col0 = u.pn * 256 + wc * 32 + 8 * fq;
        f32x4 b0[2], b1[2];
#pragma unroll
        for (int bj = 0; bj < 2; ++bj) { b0[bj] = *(const f32x4*)(bias + col0 + bj * 128); b1[bj] = *(const f32x4*)(bias + col0 + bj * 128 + 4); }
#pragma unroll
        for (int ai = 0; ai < 2; ++ai) {
            u32x4 zz[4][2];
#pragma unroll
            for (int m = 0; m < 4; ++m)
#pragma unroll
                for (int bj = 0; bj < 2; ++bj) zz[m][bj] = *(const u32x4*)(Z + (size_t)(row0 + ai * 128 + m * 16) * 512 + col0 + bj * 128);
            asm volatile("" ::: "memory");
#pragma unroll
            for (int m = 0; m < 4; ++m) { const int row = row0 + ai * 128 + m * 16;
#pragma unroll
                for (int bj = 0; bj < 2; ++bj) { const int col = col0 + bj * 128; const u32x4 z = zz[m][bj];
                    const f32x4 v0 = acc[ai][bj][m][0] + b0[bj], v1 = acc[ai][bj][m][1] + b1[bj];
                    u32x4 w;
                    w.x = pk2(bflo(z.x) * rcpf_(1.f + __expf(-v0[0])), bfhi(z.x) * rcpf_(1.f + __expf(-v0[1])));
                    w.y = pk2(bflo(z.y) * rcpf_(1.f + __expf(-v0[2])), bfhi(z.y) * rcpf_(1.f + __expf(-v0[3])));
                    w.z = pk2(bflo(z.z) * rcpf_(1.f + __expf(-v1[0])), bfhi(z.z) * rcpf_(1.f + __expf(-v1[1])));
                    w.w = pk2(bflo(z.w) * rcpf_(1.f + __expf(-v1[2])), bfhi(z.w) * rcpf_(1.f + __expf(-v1[3])));
                    *(u32x4*)(MX + (size_t)row * 1024 + col) = w; } }
            asm volatile("" ::: "memory");
        }
    }
};

template <class Epi> __device__ __forceinline__ void run_gemm(LAS unsigned char* lds, const bf16_t* A, const bf16_t* Bt, int M, int N, int K, const Epi& E) {
    pg8::Gemm g; g.A = A; g.Bt = Bt; g.M = M; g.N = N; g.K = K; g.ld = K;
    pg8::StaticOrder S; S.init(M, N, (int)gridDim.x, (int)blockIdx.x);
    pg8::gemm_phase<Epi, pg8::StaticOrder, false>(lds, g, S, E, nullptr);
}

struct EpiResAtomic {
    static constexpr bool PERM = false, AFTER_DRAIN = false;
    float* H; const float* gate;
    __device__ __forceinline__ void operator()(const f32x4 (&acc)[2][2][4][2], const pg8::Unit& u, int wr, int wc, int fr, int fq) const {
        const int r = u.pm < 64 ? (u.pm >> 3) : 8;
        const int row0 = u.pm * 256 + wr * 64 + fr, col0 = u.pn * 256 + wc * 32 + 4 * fq;
        const float* gp = gate + r * 6144 + col0;
        f32x4 gv[2][2];
#pragma unroll
        for (int bj = 0; bj < 2; ++bj)
#pragma unroll
            for (int n = 0; n < 2; ++n) gv[bj][n] = *(const f32x4*)(gp + bj * 128 + n * 16);
#pragma unroll
        for (int ai = 0; ai < 2; ++ai)
#pragma unroll
            for (int m = 0; m < 4; ++m) { const size_t off = (size_t)(row0 + ai * 128 + m * 16) * 1024 + col0;
#pragma unroll
                for (int bj = 0; bj < 2; ++bj)
#pragma unroll
                    for (int n = 0; n < 2; ++n) { float* pp = H + off + bj * 128 + n * 16; const f32x4 v = gv[bj][n] * acc[ai][bj][m][n];
#pragma unroll
                        for (int q = 0; q < 4; ++q) (void)__hip_atomic_fetch_add(pp + q, v[q], __ATOMIC_RELAXED, __HIP_MEMORY_SCOPE_AGENT); } }
    }
};
template <class Epi> __device__ __forceinline__ void run_gemm_slices(LAS unsigned char* lds, const bf16_t* A, const bf16_t* Bt, int Kfull, int nsplit, const Epi& E) {
    pg8::Gemm g; g.A = A; g.Bt = Bt; g.M = MT; g.N = 1024; g.K = Kfull / nsplit; g.ld = Kfull;
    pg8::SliceOrder S; S.init(64, 8, 1024, nsplit, (int)gridDim.x, (int)blockIdx.x);
    pg8::gemm_phase<Epi, pg8::SliceOrder, false>(lds, g, S, E, nullptr);
}

__device__ __forceinline__ void tr_job(const float* __restrict__ src, bf16_t* __restrict__ dst, int ldd, int K, int N, int mode, int& rot, LAS float* tile) {
    const int tid = mk_tid(), nb = gridDim.x, tn = (N + 255) / 256, nt = (K / 64) * tn;
    const int start = (int)((blockIdx.x + nb - (rot % nb)) % nb); rot += nt;
    const int c4 = (tid & 15) * 4, r0 = tid >> 4;
    float4 v[8], vn[8];
    auto ld = [&](int t, float4 (&x)[8]) { const int k0 = (t / tn) * 64, n0 = (t % tn) * 256;
#pragma unroll
        for (int i = 0; i < 2; ++i)
#pragma unroll
            for (int j = 0; j < 4; ++j) { const int nn = n0 + c4 + 64 * j; x[i * 4 + j] = nn < N ? *(const float4*)(src + (size_t)(k0 + r0 + 32 * i) * N + nn) : (float4){0.f, 0.f, 0.f, 0.f}; } };
#pragma unroll
    for (int q = 0; q < 8; ++q) { v[q] = (float4){0.f, 0.f, 0.f, 0.f}; vn[q] = (float4){0.f, 0.f, 0.f, 0.f}; }
    if (start < nt) ld(start, v);
    if (start + nb < nt) ld(start + nb, vn);
    for (int t = start; t < nt; t += nb) {
        const int k0 = (t / tn) * 64, n0 = (t % tn) * 256;
#pragma unroll
        for (int i = 0; i < 2; ++i)
#pragma unroll
            for (int j = 0; j < 4; ++j) { LAS float* tp = tile + (r0 + 32 * i) * 257 + c4 + 64 * j; tp[0] = v[i * 4 + j].x; tp[1] = v[i * 4 + j].y; tp[2] = v[i * 4 + j].z; tp[3] = v[i * 4 + j].w; }
        __syncthreads();
#pragma unroll
        for (int q = 0; q < 8; ++q) v[q] = vn[q];
        if (t + 2 * nb < nt) ld(t + 2 * nb, vn);
        { const int n = tid >> 1, kh = (tid & 1) * 32; const int nn = n0 + n;
          if (nn < N) {
              const int drow = mode == 0 ? nn : (nn < FH ? (nn / 128) * 256 + (nn % 128) : ((nn - FH) / 128) * 256 + 128 + ((nn - FH) % 128));
#pragma unroll
              for (int q = 0; q < 4; ++q) { const int k8 = kh + q * 8;
                  u32x4 w; w.x = pk2(tile[(k8 + 0) * 257 + n], tile[(k8 + 1) * 257 + n]); w.y = pk2(tile[(k8 + 2) * 257 + n], tile[(k8 + 3) * 257 + n]);
                  w.z = pk2(tile[(k8 + 4) * 257 + n], tile[(k8 + 5) * 257 + n]); w.w = pk2(tile[(k8 + 6) * 257 + n], tile[(k8 + 7) * 257 + n]);
                  *(u32x4*)(dst + (size_t)drow * ldd + k0 + k8) = w; } } }
        __syncthreads();
    }
}

__device__ __forceinline__ void prep_phase(const Ctx& p, LAS unsigned char* lds, int part) {
    const int tid = mk_tid(), nb = gridDim.x, bid = blockIdx.x;
    unsigned char* ws = p.ws;
    if (part != 2) { LAS float* tile = (LAS float*)lds; int rot = 0;
      for (int l = 0; l < 4; ++l) {
          tr_job(p.in[9] + (size_t)l * 1024 * 5632, (bf16_t*)(ws + WS_WFI) + (size_t)l * 5632 * 1024, 1024, 1024, 5632, 1, rot, tile);
          tr_job(p.in[10] + (size_t)l * 2816 * 1024, (bf16_t*)(ws + WS_WFO) + (size_t)l * 1024 * 2816, 2816, 2816, 1024, 0, rot, tile);
          tr_job(p.in[8] + (size_t)l * 1024 * 1024, (bf16_t*)(ws + WS_WO) + (size_t)l * 1024 * 1024, 1024, 1024, 1024, 0, rot, tile); }
      for (int e = 0; e < 2; ++e) {
          tr_job(p.in[11] + (size_t)e * 1024 * 3072, (bf16_t*)(ws + WS_WAB) + (size_t)e * 3072 * 1024, 1024, 1024, 3072, 0, rot, tile);
          tr_job(p.in[20] + (size_t)e * 512 * 512, (bf16_t*)(ws + WS_WGLU) + (size_t)e * 512 * 512, 512, 512, 512, 0, rot, tile);
          tr_job(p.in[24] + (size_t)e * 1024 * 2240, (bf16_t*)(ws + WS_WCD) + (size_t)e * 2304 * 1024, 1024, 1024, 2240, 0, rot, tile);
          tr_job(p.in[30] + (size_t)e * 384 * 768, (bf16_t*)(ws + WS_WU) + (size_t)e * 1792 * 640, 640, 384, 768, 0, rot, tile);
          tr_job(p.in[31] + (size_t)e * 256 * 1024, (bf16_t*)(ws + WS_WU) + (size_t)e * 1792 * 640 + 768 * 640 + 384, 640, 256, 1024, 0, rot, tile); } }
    if (part == 1) return;
    if (part != 3) {
        LAS float* red = (LAS float*)lds;
        LAS float* sc = (LAS float*)(lds + 73728);
        __syncthreads();
        for (int i = tid; i < 9 * 1024; i += 512) { const int r = i >> 10, k = i & 1023; const float v = r < 8 ? p.in[1][r * 1024 + k] : p.in[3][k]; sc[i] = siluf(v); }
        __syncthreads();
        for (int u = bid; u < 192; u += nb) {
            const int l = u / 48, n0 = (u % 48) * 128, cg4 = (tid & 31) * 4, ks = tid >> 5;
            const float* w = p.in[4] + (size_t)l * 1024 * 6144 + n0 + cg4;
            f32x4 a[9];
#pragma unroll
            for (int r = 0; r < 9; ++r) a[r] = (f32x4){0.f, 0.f, 0.f, 0.f};
#pragma unroll 1
            for (int k0 = ks * 64; k0 < ks * 64 + 64; k0 += 16) {
                f32x4 wv[16];
#pragma unroll
                for (int j = 0; j < 16; ++j) wv[j] = *(const f32x4*)(w + (size_t)(k0 + j) * 6144);
#pragma unroll
                for (int j = 0; j < 16; ++j)
#pragma unroll
                    for (int r = 0; r < 9; ++r) a[r] += wv[j] * sc[r * 1024 + k0 + j];
            }
#pragma unroll
            for (int r = 0; r < 9; ++r) *(LAS f32x4*)(red + (ks * 9 + r) * 128 + cg4) = a[r];
            __syncthreads();
            for (int i = tid; i < 9 * 128; i += 512) { const int r = i >> 7, c = i & 127; float v = p.in[5][l * 6144 + n0 + c];
#pragma unroll
                for (int q = 0; q < 16; ++q) v += red[(q * 9 + r) * 128 + c];
                ((float*)(ws + WS_MOD))[((size_t)l * 9 + r) * 6144 + n0 + c] = v; }
            __syncthreads();
        }
    }
    const int gt = bid * 512 + tid, gs = nb * 512;
    for (int i = gt; i < 2 * 73728; i += gs) {
        const int o = i / 73728, r = i % 73728; bf16_t* wb = (bf16_t*)(ws + WS_WU) + (size_t)o * 1792 * 640; u32x4 zz = {0u, 0u, 0u, 0u};
        if (r < 768 * 32) *(u32x4*)(wb + (size_t)(r >> 5) * 640 + 384 + (r & 31) * 8) = zz;
        else { const int r2 = r - 768 * 32; *(u32x4*)(wb + (size_t)(768 + r2 / 48) * 640 + (r2 % 48) * 8) = zz; } }
    for (int i = gt; i < 1024; i += gs) {
        const int pos = i >> 4, f = i & 15; const double inv = dexp(-(double)f * (9.210340371976182736 / 16.0)); double sn, cs; dsincos((double)pos * inv, sn, cs);
        ((float*)(ws + WS_ROPE))[i * 2] = (float)cs; ((float*)(ws + WS_ROPE))[i * 2 + 1] = (float)sn; }
    for (int i = gt; i < 1024; i += gs) {
        const int e = i >> 9, j = i & 511; float v = 0.f;
        if (e == 1) v = 1.0f / (1.0f + expf(p.in[22][j] - p.in[22][512 + j]));
        ((float*)(ws + WS_LB))[i] = v; }
    for (int i = gt; i < 2 * 2 * 32 * 64; i += gs) {
        const int pp = i & 63, idx = i >> 6;
        const double lr = (double)fminf(p.in[12][i], -1e-4f), li = (double)p.in[13][i], step = dexp((double)p.in[14][idx]);
        const double mag = dexp(lr * step); double sn, cs; dsincos(li * step, sn, cs);
        const double ar = mag * cs, ai = mag * sn, iden = 1.0 / (lr * lr + li * li);
        const double cr = ((ar - 1.0) * lr + ai * li) * iden, ci = (ai * lr - (ar - 1.0) * li) * iden;
        double pr = ar, pi = ai;
#pragma unroll
        for (int s = 0; s < 5; ++s) { const double nr = pr * pr - pi * pi, ni = 2.0 * pr * pi; pr = nr; pi = ni; }
        float4 o; o.x = (float)ar; o.y = (float)ai; o.z = (float)pr; o.w = (float)pi; ((float4*)(ws + WS_S5A))[i] = o;
        bf16_t* bbr = (bf16_t*)(ws + WS_S5BB) + ((size_t)idx * 2 + 0) * 1024 + pp * 16; bf16_t* bbi = bbr + 1024;
        const float* bre = p.in[15] + (size_t)i * 16; const float* bim = p.in[16] + (size_t)i * 16;
#pragma unroll
        for (int c = 0; c < 16; ++c) { const double br = bre[c], bi = bim[c]; bbr[c] = f2bf((float)(cr * br - ci * bi)); bbi[c] = f2bf((float)(cr * bi + ci * br)); } }
    for (int i = gt; i < 2 * 2 * 32 * 4 * 16 * 32; i += gs) {
        const int slot = i & 31, c = (i >> 5) & 15, kk = (i >> 9) & 3, idx = i >> 11;
        const int quad = slot >> 3, j8 = slot & 7, st = 16 * (2 * (kk & 1) + (j8 >> 2)) + quad * 4 + (j8 & 3);
        const float v = kk < 2 ? p.in[17][((size_t)idx * 16 + c) * 64 + st] : -p.in[18][((size_t)idx * 16 + c) * 64 + st];
        ((bf16_t*)(ws + WS_S5CC))[i] = f2bf(v); }
}

__device__ __forceinline__ void prep2_phase(const Ctx& p, LAS unsigned char* lds) {
    const int tid = mk_tid(), lane = tid & 63, w = tid >> 6, nb = gridDim.x, bid = blockIdx.x;
    unsigned char* ws = p.ws;
    LAS float* sh = (LAS float*)lds;
    {
        const int job = bid & 7, l = job >> 1, kind = job & 1;
        const int grp = bid >> 3, ngrp = (nb + 7 - job) >> 3;
        const float* mod = (const float*)(ws + WS_MOD) + (size_t)l * 9 * 6144 + (kind ? 3 : 0) * 1024;
        for (int i = tid; i < 9 * 1024; i += 512) sh[i] = mod[(i >> 10) * 6144 + (i & 1023)];
        __syncthreads();
        const bf16_t* W; int nrows;
        if (kind) { W = (const bf16_t*)(ws + WS_WFI) + (size_t)l * 5632 * 1024; nrows = 5632; }
        else if (l & 1) { W = (const bf16_t*)(ws + WS_WCD) + (size_t)(l >> 1) * 2304 * 1024; nrows = 2304; }
        else { W = (const bf16_t*)(ws + WS_WAB) + (size_t)(l >> 1) * 3072 * 1024; nrows = 3072; }
        float* bo = (float*)(ws + WS_BIAS) + (size_t)l * 9 * 8704 + (kind ? 3072 : 0);
        const int rstride = ngrp * 8;
        for (int rowq = grp * 8 + w; rowq < nrows; rowq += rstride * 4) {
          u32x2 wq[4][4];
#pragma unroll
          for (int q4 = 0; q4 < 4; ++q4) { const int rr = rowq + q4 * rstride < nrows ? rowq + q4 * rstride : rowq;
#pragma unroll
              for (int q = 0; q < 4; ++q) wq[q4][q] = *(const u32x2*)(W + (size_t)rr * 1024 + 256 * q + lane * 4); }
#pragma unroll
          for (int q4 = 0; q4 < 4; ++q4) { const int row = rowq + q4 * rstride; if (row >= nrows) break;
            float wv[16];
#pragma unroll
            for (int q = 0; q < 4; ++q) { wv[4 * q] = bflo(wq[q4][q].x); wv[4 * q + 1] = bfhi(wq[q4][q].x); wv[4 * q + 2] = bflo(wq[q4][q].y); wv[4 * q + 3] = bfhi(wq[q4][q].y); }
#pragma unroll
            for (int r = 0; r < 9; ++r) { float a = 0.f;
#pragma unroll
                for (int q = 0; q < 4; ++q) { const f32x4 s4 = *(const LAS f32x4*)(sh + r * 1024 + 256 * q + lane * 4); a += s4[0] * wv[4 * q] + s4[1] * wv[4 * q + 1] + s4[2] * wv[4 * q + 2] + s4[3] * wv[4 * q + 3]; }
                a = wsum(a); if (lane == 0) bo[r * 8704 + row] = a; }
          }
        }
    }
    { const int wg = bid * 8 + w, nw = nb * 8; float* H = (float*)(ws + WS_H); bf16_t* A = (bf16_t*)(ws + WS_A); float* ss = (float*)(ws + WS_SS);
      const float* gw = p.in[6]; const float* mod0 = (const float*)(ws + WS_MOD);
      float4 g[4];
#pragma unroll
      for (int i = 0; i < 4; ++i) g[i] = *(const float4*)(gw + 4 * (lane + 64 * i));
      for (int row = wg; row < MT; row += nw) {
          const float4* src = row < ML ? (const float4*)(p.in[0] + (size_t)row * 1024) : (const float4*)(p.in[2] + (size_t)(row - ML) * 1024);
          float4* dst = (float4*)(H + (size_t)row * 1024); const int r = row < ML ? (row >> 11) : 8; const float* sc = mod0 + r * 6144 + 1024;
          float4 h[4], c4[4]; float sq = 0.f;
#pragma unroll
          for (int i = 0; i < 4; ++i) { h[i] = src[lane + 64 * i]; c4[i] = *(const float4*)(sc + 4 * (lane + 64 * i)); }
#pragma unroll
          for (int i = 0; i < 4; ++i) sq += h[i].x * h[i].x + h[i].y * h[i].y + h[i].z * h[i].z + h[i].w * h[i].w;
          sq = wsum(sq); if (lane == 0) ss[row] = sq;
#pragma unroll
          for (int i = 0; i < 4; ++i) { const int c = 4 * (lane + 64 * i); dst[lane + 64 * i] = h[i];
              u32x2 wv2; wv2.x = pk2(h[i].x * g[i].x * (1.f + c4[i].x), h[i].y * g[i].y * (1.f + c4[i].y)); wv2.y = pk2(h[i].z * g[i].z * (1.f + c4[i].z), h[i].w * g[i].w * (1.f + c4[i].w));
              *(u32x2*)(A + (size_t)row * 1024 + c) = wv2; }
      } }
}

template <int pass> __device__ __forceinline__ void s5_unit(const Ctx& p, int e, int g, int sg, LAS unsigned char* lds) {
    const int tid = mk_tid(), lane = tid & 63, n = lane & 15, quad = lane >> 4;
    LAS bf16x8* ops = (LAS bf16x8*)lds + tid;
    const int seq = sg * 16 + n, b = seq / 72, tc = seq % 72;
    const int rowbase = tc < 8 ? ML + b * 256 + tc * 32 : b * 2048 + (tc - 8) * 32;
    const bf16_t* P = (const bf16_t*)(p.ws + WS_P); bf16_t* Z = (bf16_t*)(p.ws + WS_Z); float* E = p.out;
    const f32x4 dsk = *(const f32x4*)(p.in[19] + e * 512 + g * 16 + quad * 4);
    const f32x4 z4 = {0.f, 0.f, 0.f, 0.f};
    const int srcl = n + 16 * (quad >> 1);
#pragma unroll 1
    for (int dir = 0; dir < 2; ++dir) {
        const int idx = (e * 2 + dir) * 32 + g;
        const float4* A4 = (const float4*)(p.ws + WS_S5A) + (size_t)idx * 64;
        const bf16_t* BB = (const bf16_t*)(p.ws + WS_S5BB) + (size_t)idx * 2048;
        const bf16_t* CC = (const bf16_t*)(p.ws + WS_S5CC) + (size_t)idx * 2048;
        f32x4 ar[4], ai[4], hr[4], hi[4];
#pragma unroll
        for (int pt = 0; pt < 4; ++pt) {
            ops[pt * 512] = quad < 2 ? *(const bf16x8*)(BB + (16 * pt + n) * 16 + quad * 8) : zero8();
            ops[(4 + pt) * 512] = quad < 2 ? *(const bf16x8*)(BB + 1024 + (16 * pt + n) * 16 + quad * 8) : zero8();
            ops[(8 + pt) * 512] = *(const bf16x8*)(CC + (pt * 16 + n) * 32 + quad * 8); }
        const int pc = dir == 0 ? tc : (tc < 8 ? 7 - tc : 79 - tc);
        float* Eb = E + ((size_t)((b * 2 + dir) * 72 + pc) * 32 + g) * 128;
#pragma unroll
        for (int pt = 0; pt < 4; ++pt) {
            float4 e0 = {0.f, 0.f, 0.f, 0.f}, e1 = {0.f, 0.f, 0.f, 0.f};
            if (pass == 2) { const float4* ep = (const float4*)(Eb + (16 * pt + quad * 4) * 2); e0 = ep[0]; e1 = ep[1]; }
            hr[pt][0] = e0.x; hi[pt][0] = e0.y; hr[pt][1] = e0.z; hi[pt][1] = e0.w; hr[pt][2] = e1.x; hi[pt][2] = e1.y; hr[pt][3] = e1.z; hi[pt][3] = e1.w;
#pragma unroll
            for (int j = 0; j < 4; ++j) { const float4 a = A4[16 * pt + quad * 4 + j]; ar[pt][j] = a.x; ai[pt][j] = a.y; } }
        const char* Pg = (const char*)(P + g * 16); char* Zg = (char*)(Z + g * 16);
        const unsigned uoff0 = (unsigned)(rowbase * 3072 + (quad & 1) * 8) * 2u, zoff0 = (unsigned)(rowbase * 512 + quad * 4) * 2u;
        const char* Zr = dir ? (const char*)Zg : Pg;
        bf16x8 ub[8]; u32x2 yfb[8];
#pragma unroll
        for (int j = 0; j < 8; ++j) { const int tt = dir ? 31 - j : j; ub[j] = *(const bf16x8*)(Pg + (uoff0 + (unsigned)tt * 6144u));
            yfb[j] = (u32x2){0u, 0u}; if (pass == 2) yfb[j] = *(const u32x2*)(Zr + (zoff0 + (unsigned)tt * 1024u)); }
#pragma unroll 1
        for (int t8 = 0; t8 < 4; ++t8) {
#pragma unroll
            for (int j = 0; j < 8; ++j) {
                const int t = t8 * 8 + j, tt = dir ? 31 - t : t;
                const bf16x8 uc = ub[j]; const u32x2 yf = yfb[j];
                { const int t2 = t + 8 < 31 ? t + 8 : 31; const int tt2 = dir ? 31 - t2 : t2; ub[j] = *(const bf16x8*)(Pg + (uoff0 + (unsigned)tt2 * 6144u));
                    if (pass == 2) yfb[j] = *(const u32x2*)(Zr + (zoff0 + (unsigned)tt2 * 1024u)); }
#pragma unroll
                for (int pt = 0; pt < 4; ++pt) { const bf16x8 oa = ops[pt * 512], ob = ops[(4 + pt) * 512]; const f32x4 br = MFMA(oa, uc, z4), bi = MFMA(ob, uc, z4);
                    { const f32x4 nr = ar[pt] * hr[pt] - ai[pt] * hi[pt] + br, ni = ar[pt] * hi[pt] + ai[pt] * hr[pt] + bi; hr[pt] = nr; hi[pt] = ni; }
                    if (pt & 1) asm volatile("" ::: "memory"); }
                if (pass == 2) {
                    f32x4 y = z4, y2 = z4;
#pragma unroll
                    for (int kk = 0; kk < 2; ++kk) {
                        const bf16x8 br = mk8(pk2(hr[2 * kk][0], hr[2 * kk][1]), pk2(hr[2 * kk][2], hr[2 * kk][3]), pk2(hr[2 * kk + 1][0], hr[2 * kk + 1][1]), pk2(hr[2 * kk + 1][2], hr[2 * kk + 1][3]));
                        const bf16x8 bi = mk8(pk2(hi[2 * kk][0], hi[2 * kk][1]), pk2(hi[2 * kk][2], hi[2 * kk][3]), pk2(hi[2 * kk + 1][0], hi[2 * kk + 1][1]), pk2(hi[2 * kk + 1][2], hi[2 * kk + 1][3]));
                        y = MFMA(ops[(8 + kk) * 512], br, y); y2 = MFMA(ops[(10 + kk) * 512], bi, y2); }
                    y += y2;
                    char* zp = Zg + (zoff0 + (unsigned)tt * 1024u);
                    if (dir == 0) { u32x2 w; w.x = pk2(y[0], y[1]); w.y = pk2(y[2], y[3]); *(u32x2*)zp = w; }
                    else { const u32x4 uw = __builtin_bit_cast(u32x4, uc);
                        const unsigned a0 = __shfl((int)uw.x, srcl), a1 = __shfl((int)uw.y, srcl), a2 = __shfl((int)uw.z, srcl), a3 = __shfl((int)uw.w, srcl);
                        const unsigned ux = (quad & 1) ? a2 : a0, uy = (quad & 1) ? a3 : a1;
                        float v[4] = {bflo(yf.x) + y[0] + dsk[0] * bflo(ux), bfhi(yf.x) + y[1] + dsk[1] * bfhi(ux), bflo(yf.y) + y[2] + dsk[2] * bflo(uy), bfhi(yf.y) + y[3] + dsk[3] * bfhi(uy)};
#pragma unroll
                        for (int jj = 0; jj < 4; ++jj) { const float x = v[jj], uarg = 1.5957691216f * (x + 0.044715f * x * x * x); v[jj] = x * rcpf_(1.0f + __expf(-uarg)); }
                        u32x2 w; w.x = pk2(v[0], v[1]); w.y = pk2(v[2], v[3]); *(u32x2*)zp = w; }
                }
                asm volatile("" ::: "memory");
            }
        }
        if (pass == 1) {
#pragma unroll
            for (int pt = 0; pt < 4; ++pt) { float4* ep = (float4*)(Eb + (16 * pt + quad * 4) * 2);
                float4 e0, e1; e0.x = hr[pt][0]; e0.y = hi[pt][0]; e0.z = hr[pt][1]; e0.w = hi[pt][1]; e1.x = hr[pt][2]; e1.y = hi[pt][2]; e1.z = hr[pt][3]; e1.w = hi[pt][3]; ep[0] = e0; ep[1] = e1; }
        }
    }
}
__device__ __forceinline__ void s5_carry(const Ctx& p, int e) {
    const int gt = blockIdx.x * 512 + mk_tid(), gs = gridDim.x * 512;
    float2* E = (float2*)p.out;
    for (int i = gt; i < 32768; i += gs) {
        const int pp = i & 63, g = (i >> 6) & 31, dir = (i >> 11) & 1, b = i >> 12;
        const float4 a = ((const float4*)(p.ws + WS_S5A))[(size_t)((e * 2 + dir) * 32 + g) * 64 + pp];
        float2* base = E + ((size_t)((b * 2 + dir) * 72) * 32 + g) * 64 + pp;
        float hr = 0.f, hi = 0.f;
#pragma unroll 1
        for (int q0 = 0; q0 < 72; q0 += 6) {
            float2 ev[6];
#pragma unroll
            for (int j = 0; j < 6; ++j) ev[j] = base[(size_t)(q0 + j) * 2048];
#pragma unroll
            for (int j = 0; j < 6; ++j) { float2 o; o.x = hr; o.y = hi; base[(size_t)(q0 + j) * 2048] = o; const float nr = a.z * hr - a.w * hi + ev[j].x, ni = a.z * hi + a.w * hr + ev[j].y; hr = nr; hi = ni; }
        }
    }
}

constexpr int HG_CUM = 0, HG_QT = 33792, HG_KT = HG_QT + 17408, HG_QI = HG_KT + 17408, HG_KET = HG_QI + 17408, HG_VT = HG_KET + 18432, HG_SC = HG_VT + 18432, HG_TOT = HG_SC + 9216, HG_C63 = HG_TOT + 2048, HG_END = HG_C63 + 512;
static_assert(HG_END <= LDS_BYTES, "hgrn lds");
__device__ __forceinline__ void hgrn_chain(const Ctx& p, int e, int chain, LAS unsigned char* lds) {
    const int tid = mk_tid(), w = tid >> 6, lane = tid & 63, n = lane & 15, quad = lane >> 4;
    const int b = chain >> 3, dir = (chain >> 2) & 1, head = chain & 3;
    const bf16_t* P = (const bf16_t*)(p.ws + WS_P);
    bf16_t* O = (bf16_t*)(p.ws + (dir ? WS_OB : WS_OF));
    LAS float* cum = (LAS float*)(lds + HG_CUM);
    LAS bf16_t* qt = (LAS bf16_t*)(lds + HG_QT);
    LAS bf16_t* kt = (LAS bf16_t*)(lds + HG_KT);
    LAS bf16_t* qi = (LAS bf16_t*)(lds + HG_QI);
    LAS bf16_t* keT = (LAS bf16_t*)(lds + HG_KET);
    LAS bf16_t* vT = (LAS bf16_t*)(lds + HG_VT);
    LAS bf16_t* sc = (LAS bf16_t*)(lds + HG_SC);
    LAS float* tot = (LAS float*)(lds + HG_TOT);
    LAS float* c63s = (LAS float*)(lds + HG_C63);
    const int t = lane, kc = w * 16;
    const int sk = tid & 127, sseg = tid >> 7;
    const float* lbp = (const float*)(p.ws + WS_LB) + e * 512 + head * 128 + kc;
    f32x4 S[8];
#pragma unroll
    for (int i = 0; i < 8; ++i) S[i] = (f32x4){0.f, 0.f, 0.f, 0.f};
    const int qcol = 512 + head * 128 + kc, fcol = (dir ? 1536 : 1024) + head * 128 + kc, vcol = 2048 + head * 128 + kc;
    u32x4 rq0, rq1, rf0, rf1, rv0, rv1;
    { const int rowb = dir == 0 ? ML + b * 256 : ML + b * 256 + 192; const bf16_t* pr = P + (size_t)(rowb + (dir ? 63 - t : t)) * 3072;
      rq0 = *(const u32x4*)(pr + qcol); rq1 = *(const u32x4*)(pr + qcol + 8); rf0 = *(const u32x4*)(pr + fcol); rf1 = *(const u32x4*)(pr + fcol + 8); rv0 = *(const u32x4*)(pr + vcol); rv1 = *(const u32x4*)(pr + vcol + 8); }
#pragma unroll 1
    for (int pc = 0; pc < 36; ++pc) {
        const int tc = dir == 0 ? pc : (pc < 4 ? 3 - pc : 39 - pc);
        const int rowb = tc < 4 ? ML + b * 256 + tc * 64 : b * 2048 + (tc - 4) * 64;
        float qv[16], kv[16];
        {
            const unsigned rq[8] = {rq0.x, rq0.y, rq0.z, rq0.w, rq1.x, rq1.y, rq1.z, rq1.w}, rf[8] = {rf0.x, rf0.y, rf0.z, rf0.w, rf1.x, rf1.y, rf1.z, rf1.w},
                           rv[8] = {rv0.x, rv0.y, rv0.z, rv0.w, rv1.x, rv1.y, rv1.z, rv1.w};
            float lf[16], lb[16];
#pragma unroll
            for (int i = 0; i < 4; ++i) { const f32x4 t4 = *(const f32x4*)(lbp + 4 * i); lb[4 * i] = t4[0]; lb[4 * i + 1] = t4[1]; lb[4 * i + 2] = t4[2]; lb[4 * i + 3] = t4[3]; }
#pragma unroll
            for (int i = 0; i < 16; ++i) {
                const float x = (i & 1) ? bfhi(rq[i >> 1]) : bflo(rq[i >> 1]); float fl = (i & 1) ? bfhi(rf[i >> 1]) : bflo(rf[i >> 1]);
                fl = fminf(fmaxf(fl, -30.f), 30.f);
                qv[i] = siluf(x);
                const float en = __expf(-fl), sg = rcpf_(1.0f + en);
                kv[i] = (1.f - lb[i]) * en * sg;
                lf[i] = __logf(lb[i] + (1.f - lb[i]) * sg);
                vT[(kc + i) * 72 + t] = (bf16_t)((i & 1) ? (rv[i >> 1] >> 16) : (rv[i >> 1] & 0xffffu));
            }
#pragma unroll
            for (int i = 0; i < 4; ++i) *(LAS f32x4*)(cum + t * 132 + kc + 4 * i) = (f32x4){lf[4 * i], lf[4 * i + 1], lf[4 * i + 2], lf[4 * i + 3]};
        }
        if (pc < 35) { const int pc2 = pc + 1; const int tc2 = dir == 0 ? pc2 : (pc2 < 4 ? 3 - pc2 : 39 - pc2); const int rowb2 = tc2 < 4 ? ML + b * 256 + tc2 * 64 : b * 2048 + (tc2 - 4) * 64;
            const bf16_t* pr = P + (size_t)(rowb2 + (dir ? 63 - t : t)) * 3072;
            rq0 = *(const u32x4*)(pr + qcol); rq1 = *(const u32x4*)(pr + qcol + 8); rf0 = *(const u32x4*)(pr + fcol); rf1 = *(const u32x4*)(pr + fcol + 8); rv0 = *(const u32x4*)(pr + vcol); rv1 = *(const u32x4*)(pr + vcol + 8); }
        __syncthreads();
        {
            float c[16];
#pragma unroll
            for (int i = 0; i < 16; ++i) c[i] = cum[(16 * sseg + i) * 132 + sk];
#pragma unroll
            for (int i = 1; i < 16; ++i) c[i] += c[i - 1];
#pragma unroll
            for (int i = 0; i < 16; ++i) cum[(16 * sseg + i) * 132 + sk] = c[i];
            tot[sseg * 128 + sk] = c[15];
        }
        __syncthreads();
        {
            const int seg = t >> 4;
            unsigned wq[8], wk[8], wi[8];
#pragma unroll
            for (int i4 = 0; i4 < 4; ++i4) {
                const f32x4 o0 = *(const LAS f32x4*)(tot + kc + 4 * i4), o1 = *(const LAS f32x4*)(tot + 128 + kc + 4 * i4), o2 = *(const LAS f32x4*)(tot + 256 + kc + 4 * i4);
                const f32x4 cl = *(const LAS f32x4*)(cum + t * 132 + kc + 4 * i4), l31 = *(const LAS f32x4*)(cum + 31 * 132 + kc + 4 * i4), l63 = *(const LAS f32x4*)(cum + 63 * 132 + kc + 4 * i4);
                float a[4], bq[4], cq[4];
#pragma unroll
                for (int j = 0; j < 4; ++j) { const int ii = 4 * i4 + j;
                    const float off = (seg > 0 ? o0[j] : 0.f) + (seg > 1 ? o1[j] : 0.f) + (seg > 2 ? o2[j] : 0.f);
                    const float ct = cl[j] + off, c31 = l31[j] + o0[j], c63 = l63[j] + o0[j] + o1[j] + o2[j];
                    a[j] = qv[ii] * __expf(fminf(ct - c31, 80.f)); bq[j] = kv[ii] * __expf(fminf(c31 - ct, 80.f)); cq[j] = qv[ii] * __expf(ct);
                    keT[(kc + ii) * 72 + t] = f2bf(kv[ii] * __expf(c63 - ct));
                    if (t == 63) c63s[kc + ii] = c63; }
                wq[2 * i4] = pk2(a[0], a[1]); wq[2 * i4 + 1] = pk2(a[2], a[3]); wk[2 * i4] = pk2(bq[0], bq[1]); wk[2 * i4 + 1] = pk2(bq[2], bq[3]); wi[2 * i4] = pk2(cq[0], cq[1]); wi[2 * i4 + 1] = pk2(cq[2], cq[3]);
            }
            *(LAS u32x4*)(qt + t * 136 + kc) = (u32x4){wq[0], wq[1], wq[2], wq[3]}; *(LAS u32x4*)(qt + t * 136 + kc + 8) = (u32x4){wq[4], wq[5], wq[6], wq[7]};
            *(LAS u32x4*)(kt + t * 136 + kc) = (u32x4){wk[0], wk[1], wk[2], wk[3]}; *(LAS u32x4*)(kt + t * 136 + kc + 8) = (u32x4){wk[4], wk[5], wk[6], wk[7]};
            *(LAS u32x4*)(qi + t * 136 + kc) = (u32x4){wi[0], wi[1], wi[2], wi[3]}; *(LAS u32x4*)(qi + t * 136 + kc + 8) = (u32x4){wi[4], wi[5], wi[6], wi[7]};
        }
        __syncthreads();
        {
            const int tt = w >> 1;
#pragma unroll
            for (int si = 0; si < 2; ++si) { const int st = (w & 1) * 2 + si; f32x4 acc = {0.f, 0.f, 0.f, 0.f};
                if (st <= tt) {
#pragma unroll
                    for (int kb = 0; kb < 4; ++kb) { const bf16x8 a = *(const LAS bf16x8*)(qt + (16 * tt + n) * 136 + 32 * kb + quad * 8), bb = *(const LAS bf16x8*)(kt + (16 * st + n) * 136 + 32 * kb + quad * 8);
                        acc = MFMA(a, bb, acc); } }
#pragma unroll
                for (int j = 0; j < 4; ++j) { const int ti = 16 * tt + quad * 4 + j, sidx = 16 * st + n; sc[ti * 72 + sidx] = (st <= tt && sidx <= ti) ? f2bf(acc[j]) : (bf16_t)0; } }
        }
        __syncthreads();
        {
            bf16x8 Sb[4], vB[2];
#pragma unroll
            for (int kb = 0; kb < 4; ++kb) Sb[kb] = mk8(pk2(S[2 * kb][0], S[2 * kb][1]), pk2(S[2 * kb][2], S[2 * kb][3]), pk2(S[2 * kb + 1][0], S[2 * kb + 1][1]), pk2(S[2 * kb + 1][2], S[2 * kb + 1][3]));
#pragma unroll
            for (int sb = 0; sb < 2; ++sb) vB[sb] = *(const LAS bf16x8*)(vT + (16 * w + n) * 72 + 32 * sb + quad * 8);
#pragma unroll
            for (int tt = 0; tt < 4; ++tt) { f32x4 acc = {0.f, 0.f, 0.f, 0.f};
#pragma unroll
                for (int kb = 0; kb < 4; ++kb) { const bf16x4 a0 = *(const LAS bf16x4*)(qi + (16 * tt + n) * 136 + 32 * kb + quad * 4), a1 = *(const LAS bf16x4*)(qi + (16 * tt + n) * 136 + 32 * kb + 16 + quad * 4);
                    acc = MFMA(__builtin_shufflevector(a0, a1, 0, 1, 2, 3, 4, 5, 6, 7), Sb[kb], acc); }
#pragma unroll
                for (int sb = 0; sb < 2; ++sb) if (32 * sb <= 16 * tt + 15) { const bf16x8 a = *(const LAS bf16x8*)(sc + (16 * tt + n) * 72 + 32 * sb + quad * 8); acc = MFMA(a, vB[sb], acc); }
#pragma unroll
                for (int j = 0; j < 4; ++j) { const int ti = 16 * tt + quad * 4 + j; O[(size_t)(rowb + (dir ? 63 - ti : ti)) * 512 + head * 128 + 16 * w + n] = f2bf(acc[j]); } }
#pragma unroll
            for (int k8 = 0; k8 < 8; ++k8) { const f32x4 c4 = *(const LAS f32x4*)(c63s + 16 * k8 + quad * 4);
                f32x4 s = S[k8]; s[0] *= __expf(c4[0]); s[1] *= __expf(c4[1]); s[2] *= __expf(c4[2]); s[3] *= __expf(c4[3]);
#pragma unroll
                for (int sb = 0; sb < 2; ++sb) { const bf16x8 a = *(const LAS bf16x8*)(keT + (16 * k8 + n) * 72 + 32 * sb + quad * 8); s = MFMA(a, vB[sb], s); }
                S[k8] = s; }
        }
        __syncthreads();
    }
}

__device__ __forceinline__ void hg_pre_unit(const Ctx& p, int e, int u, LAS unsigned char* lds, bool dry) {
    const int tid = mk_tid(), w = __builtin_amdgcn_readfirstlane(tid >> 6), lane = tid & 63, n = lane & 15, quad = lane >> 4;
    const int head = u & 3, ch = u >> 2, b = ch / 36, tc = ch % 36;
    const int rowb = tc < 4 ? ML + b * 256 + tc * 64 : b * 2048 + (tc - 4) * 64;
    bf16_t* P = (bf16_t*)(p.ws + WS_P);
    LAS float* cum = (LAS float*)(lds + HG_CUM);
    LAS bf16_t* qt = (LAS bf16_t*)(lds + HG_QT); LAS bf16_t* kt = (LAS bf16_t*)(lds + HG_KT); LAS bf16_t* qi = (LAS bf16_t*)(lds + HG_QI);
    LAS bf16_t* keT = (LAS bf16_t*)(lds + HG_KET); LAS bf16_t* vT = (LAS bf16_t*)(lds + HG_VT); LAS bf16_t* sc = (LAS bf16_t*)(lds + HG_SC);
    LAS float* tot = (LAS float*)(lds + HG_TOT);
    const int t = lane, kc = w * 16;
    const int sk = tid & 127, sseg = tid >> 7;
    const float* lbp = (const float*)(p.ws + WS_LB) + e * 512 + head * 128 + kc;
    u32x4 rq0, rq1, rfa0, rfa1, rfb0, rfb1, rv0, rv1;
    { const bf16_t* pr = P + (size_t)(rowb + t) * 3072 + head * 128 + kc;
      rq0 = *(const u32x4*)(pr + 512); rq1 = *(const u32x4*)(pr + 520); rfa0 = *(const u32x4*)(pr + 1024); rfa1 = *(const u32x4*)(pr + 1032);
      rfb0 = *(const u32x4*)(pr + 1536); rfb1 = *(const u32x4*)(pr + 1544); rv0 = *(const u32x4*)(pr + 2048); rv1 = *(const u32x4*)(pr + 2056); }
    float lb[16];
#pragma unroll
    for (int i = 0; i < 4; ++i) { const f32x4 t4 = *(const f32x4*)(lbp + 4 * i); lb[4 * i] = t4[0]; lb[4 * i + 1] = t4[1]; lb[4 * i + 2] = t4[2]; lb[4 * i + 3] = t4[3]; }
    float qv[16];
    { const unsigned rq[8] = {rq0.x, rq0.y, rq0.z, rq0.w, rq1.x, rq1.y, rq1.z, rq1.w};
#pragma unroll
      for (int i = 0; i < 16; ++i) qv[i] = siluf((i & 1) ? bfhi(rq[i >> 1]) : bflo(rq[i >> 1])); }
#pragma unroll 1
    for (int dir = 0; dir < 2; ++dir) {
        const int s = dir ? 63 - t : t;
        bf16_t* O = (bf16_t*)(p.ws + (dir ? WS_OB : WS_OF));
        float kv[16];
        {
            const unsigned rv[8] = {rv0.x, rv0.y, rv0.z, rv0.w, rv1.x, rv1.y, rv1.z, rv1.w};
            const u32x4 f0 = dir ? rfb0 : rfa0, f1 = dir ? rfb1 : rfa1;
            const unsigned rf[8] = {f0.x, f0.y, f0.z, f0.w, f1.x, f1.y, f1.z, f1.w};
            float lf[16];
#pragma unroll
            for (int i = 0; i < 16; ++i) {
                float fl = (i & 1) ? bfhi(rf[i >> 1]) : bflo(rf[i >> 1]);
                fl = fminf(fmaxf(fl, -30.f), 30.f);
                const float en = __expf(-fl), sg = rcpf_(1.0f + en);
                kv[i] = (1.f - lb[i]) * en * sg;
                lf[i] = __logf(lb[i] + (1.f - lb[i]) * sg);
                vT[(kc + i) * 72 + s] = (bf16_t)((i & 1) ? (rv[i >> 1] >> 16) : (rv[i >> 1] & 0xffffu));
            }
#pragma unroll
            for (int i = 0; i < 4; ++i) *(LAS f32x4*)(cum + s * 132 + kc + 4 * i) = (f32x4){lf[4 * i], lf[4 * i + 1], lf[4 * i + 2], lf[4 * i + 3]};
        }
        __syncthreads();
        {
            float c[16];
#pragma unroll
            for (int i = 0; i < 16; ++i) c[i] = cum[(16 * sseg + i) * 132 + sk];
#pragma unroll
            for (int i = 1; i < 16; ++i) c[i] += c[i - 1];
#pragma unroll
            for (int i = 0; i < 16; ++i) cum[(16 * sseg + i) * 132 + sk] = c[i];
            tot[sseg * 128 + sk] = c[15];
        }
        __syncthreads();
        {
            const int seg = s >> 4;
            unsigned wq[8], wk[8], wi[8];
#pragma unroll
            for (int i4 = 0; i4 < 4; ++i4) {
                const f32x4 o0 = *(const LAS f32x4*)(tot + kc + 4 * i4), o1 = *(const LAS f32x4*)(tot + 128 + kc + 4 * i4), o2 = *(const LAS f32x4*)(tot + 256 + kc + 4 * i4);
                const f32x4 cl = *(const LAS f32x4*)(cum + s * 132 + kc + 4 * i4), l31 = *(const LAS f32x4*)(cum + 31 * 132 + kc + 4 * i4), l63 = *(const LAS f32x4*)(cum + 63 * 132 + kc + 4 * i4);
                float a[4], bq[4], cq[4], e63[4];
#pragma unroll
                for (int j = 0; j < 4; ++j) { const int ii = 4 * i4 + j;
                    const float off = (seg > 0 ? o0[j] : 0.f) + (seg > 1 ? o1[j] : 0.f) + (seg > 2 ? o2[j] : 0.f);
                    const float ct = cl[j] + off, c31 = l31[j] + o0[j], c63 = l63[j] + o0[j] + o1[j] + o2[j];
                    a[j] = qv[ii] * __expf(fminf(ct - c31, 80.f)); bq[j] = kv[ii] * __expf(fminf(c31 - ct, 80.f)); cq[j] = qv[ii] * __expf(ct);
                    keT[(kc + ii) * 72 + s] = f2bf(kv[ii] * __expf(c63 - ct)); e63[j] = __expf(c63); }
                if (s == 63 && !dry) { u32x2 ev; ev.x = pk2(e63[0], e63[1]); ev.y = pk2(e63[2], e63[3]);
                    *(u32x2*)((bf16_t*)(p.ws + WS_E63) + ((size_t)(dir * 288 + ch) * 4 + head) * 128 + kc + 4 * i4) = ev; }
                wq[2 * i4] = pk2(a[0], a[1]); wq[2 * i4 + 1] = pk2(a[2], a[3]); wk[2 * i4] = pk2(bq[0], bq[1]); wk[2 * i4 + 1] = pk2(bq[2], bq[3]); wi[2 * i4] = pk2(cq[0], cq[1]); wi[2 * i4 + 1] = pk2(cq[2], cq[3]);
            }
            *(LAS u32x4*)(qt + s * 136 + kc) = (u32x4){wq[0], wq[1], wq[2], wq[3]}; *(LAS u32x4*)(qt + s * 136 + kc + 8) = (u32x4){wq[4], wq[5], wq[6], wq[7]};
            *(LAS u32x4*)(kt + s * 136 + kc) = (u32x4){wk[0], wk[1], wk[2], wk[3]}; *(LAS u32x4*)(kt + s * 136 + kc + 8) = (u32x4){wk[4], wk[5], wk[6], wk[7]};
            *(LAS u32x4*)(qi + s * 136 + kc) = (u32x4){wi[0], wi[1], wi[2], wi[3]}; *(LAS u32x4*)(qi + s * 136 + kc + 8) = (u32x4){wi[4], wi[5], wi[6], wi[7]};
        }
        __syncthreads();
        {
            const int tt = w >> 1;
#pragma unroll
            for (int si = 0; si < 2; ++si) { const int st = (w & 1) * 2 + si; f32x4 acc = {0.f, 0.f, 0.f, 0.f};
                if (st <= tt) {
#pragma unroll
                    for (int kb = 0; kb < 4; ++kb) { const bf16x8 a = *(const LAS bf16x8*)(qt + (16 * tt + n) * 136 + 32 * kb + quad * 8), bb = *(const LAS bf16x8*)(kt + (16 * st + n) * 136 + 32 * kb + quad * 8);
                        acc = MFMA(a, bb, acc); } }
#pragma unroll
                for (int j = 0; j < 4; ++j) { const int ti = 16 * tt + quad * 4 + j, sidx = 16 * st + n; sc[ti * 72 + sidx] = (st <= tt && sidx <= ti) ? f2bf(acc[j]) : (bf16_t)0; } }
        }
        __syncthreads();
        {
            bf16x8 vB[2];
#pragma unroll
            for (int sb = 0; sb < 2; ++sb) vB[sb] = *(const LAS bf16x8*)(vT + (16 * w + n) * 72 + 32 * sb + quad * 8);
#pragma unroll
            for (int tt = 0; tt < 4; ++tt) { f32x4 acc = {0.f, 0.f, 0.f, 0.f};
#pragma unroll
                for (int sb = 0; sb < 2; ++sb) if (32 * sb <= 16 * tt + 15) { const bf16x8 a = *(const LAS bf16x8*)(sc + (16 * tt + n) * 72 + 32 * sb + quad * 8); acc = MFMA(a, vB[sb], acc); }
#pragma unroll
                for (int j = 0; j < 4; ++j) { const int ti = 16 * tt + quad * 4 + j; if (!dry) O[(size_t)(rowb + (dir ? 63 - ti : ti)) * 512 + head * 128 + 16 * w + n] = f2bf(acc[j]); } }
            if (!dry) { const int r = tid >> 3, c16 = (tid & 7) * 16; const u32x4 x0 = *(const LAS u32x4*)(qi + r * 136 + c16), x1 = *(const LAS u32x4*)(qi + r * 136 + c16 + 8);
              bf16_t* dq = dir ? (bf16_t*)(p.ws + WS_Q1) + (size_t)(rowb + r) * 512 + head * 128 + c16 : P + (size_t)(rowb + r) * 3072 + 512 + head * 128 + c16;
              *(u32x4*)dq = x0; *(u32x4*)(dq + 8) = x1; }
            if (!dry) { const int r = tid >> 3, c16 = (tid & 7) * 16, k = 2 * r + (c16 >> 6), s0 = c16 & 63;
              const u32x4 x0 = *(const LAS u32x4*)(keT + k * 72 + s0), x1 = *(const LAS u32x4*)(keT + k * 72 + s0 + 8), y0 = *(const LAS u32x4*)(vT + k * 72 + s0), y1 = *(const LAS u32x4*)(vT + k * 72 + s0 + 8);
              bf16_t* dk = P + (size_t)(rowb + r) * 3072 + (dir ? 1536 : 1024) + head * 128 + c16; *(u32x4*)dk = x0; *(u32x4*)(dk + 8) = x1;
              bf16_t* dv = dir ? (bf16_t*)(p.ws + WS_VT1) + (size_t)(rowb + r) * 512 + head * 128 + c16 : P + (size_t)(rowb + r) * 3072 + 2048 + head * 128 + c16; *(u32x4*)dv = y0; *(u32x4*)(dv + 8) = y1; }
        }
        __syncthreads();
    }
}

constexpr int HC_BUF = 17408 + 18432 + 18432 + 512;
static_assert(2 * HC_BUF <= LDS_BYTES - 256, "chain lds");
__device__ __forceinline__ void hgrn_chain2(const Ctx& p, int chain, LAS unsigned char* lds, bool dry) {
    const int tid = mk_tid(), w = __builtin_amdgcn_readfirstlane(tid >> 6), lane = tid & 63, n = lane & 15, quad = lane >> 4;
    const int b = chain >> 3, dir = (chain >> 2) & 1, head = chain & 3;
    const bf16_t* P = (const bf16_t*)(p.ws + WS_P);
    bf16_t* O = (bf16_t*)(p.ws + (dir ? WS_OB : WS_OF));
    const bf16_t* srcQ = dir ? (const bf16_t*)(p.ws + WS_Q1) + head * 128 : P + 512 + head * 128; const int ldq = dir ? 512 : 3072;
    const bf16_t* srcK = P + (dir ? 1536 : 1024) + head * 128;
    const bf16_t* srcV = dir ? (const bf16_t*)(p.ws + WS_VT1) + head * 128 : P + 2048 + head * 128; const int ldv = dir ? 512 : 3072;
    const bf16_t* E63 = (const bf16_t*)(p.ws + WS_E63);
    const int r = tid >> 3, c16 = (tid & 7) * 16, kk2 = 2 * r + (c16 >> 6), s0 = c16 & 63;
    f32x4 S[8];
#pragma unroll
    for (int i = 0; i < 8; ++i) S[i] = (f32x4){0.f, 0.f, 0.f, 0.f};
    u32x4 pq0, pq1, pk0, pk1, pv0, pv1; unsigned pe = 0u;
    auto fetch = [&](int pc) { const int tc = dir == 0 ? pc : (pc < 4 ? 3 - pc : 39 - pc); const int rowb = tc < 4 ? ML + b * 256 + tc * 64 : b * 2048 + (tc - 4) * 64;
        const bf16_t* q = srcQ + (size_t)(rowb + r) * ldq + c16; pq0 = *(const u32x4*)q; pq1 = *(const u32x4*)(q + 8);
        const bf16_t* k = srcK + (size_t)(rowb + r) * 3072 + c16; pk0 = *(const u32x4*)k; pk1 = *(const u32x4*)(k + 8);
        const bf16_t* v = srcV + (size_t)(rowb + r) * ldv + c16; pv0 = *(const u32x4*)v; pv1 = *(const u32x4*)(v + 8);
        if (tid < 64) pe = *(const unsigned*)(E63 + ((size_t)(dir * 288 + b * 36 + tc) * 4 + head) * 128 + tid * 2); };
    fetch(0);
#pragma unroll 1
    for (int pc = 0; pc < 36; ++pc) {
        LAS unsigned char* buf = lds + (pc & 1) * HC_BUF;
        LAS bf16_t* qi = (LAS bf16_t*)buf; LAS bf16_t* keT = (LAS bf16_t*)(buf + 17408); LAS bf16_t* vT = (LAS bf16_t*)(buf + 17408 + 18432); LAS float* e63 = (LAS float*)(buf + 17408 + 2 * 18432);
        *(LAS u32x4*)(qi + r * 136 + c16) = pq0; *(LAS u32x4*)(qi + r * 136 + c16 + 8) = pq1;
        *(LAS u32x4*)(keT + kk2 * 72 + s0) = pk0; *(LAS u32x4*)(keT + kk2 * 72 + s0 + 8) = pk1;
        *(LAS u32x4*)(vT + kk2 * 72 + s0) = pv0; *(LAS u32x4*)(vT + kk2 * 72 + s0 + 8) = pv1;
        if (tid < 64) { e63[tid * 2] = bflo(pe); e63[tid * 2 + 1] = bfhi(pe); }
        __syncthreads();
        const int tc = dir == 0 ? pc : (pc < 4 ? 3 - pc : 39 - pc); const int rowb = tc < 4 ? ML + b * 256 + tc * 64 : b * 2048 + (tc - 4) * 64;
        if (pc < 35) fetch(pc + 1);
        unsigned short oin[4][4];
#pragma unroll
        for (int tt = 0; tt < 4; ++tt)
#pragma unroll
            for (int j = 0; j < 4; ++j) { const int ti = 16 * tt + quad * 4 + j; oin[tt][j] = O[(size_t)(rowb + (dir ? 63 - ti : ti)) * 512 + head * 128 + 16 * w + n]; }
        bf16x8 Sb[4], vB[2];
#pragma unroll
        for (int kb = 0; kb < 4; ++kb) Sb[kb] = mk8(pk2(S[2 * kb][0], S[2 * kb][1]), pk2(S[2 * kb][2], S[2 * kb][3]), pk2(S[2 * kb + 1][0], S[2 * kb + 1][1]), pk2(S[2 * kb + 1][2], S[2 * kb + 1][3]));
#pragma unroll
        for (int sb = 0; sb < 2; ++sb) vB[sb] = *(const LAS bf16x8*)(vT + (16 * w + n) * 72 + 32 * sb + quad * 8);
        f32x4 acc[4];
#pragma unroll
        for (int tt = 0; tt < 4; ++tt) { acc[tt] = (f32x4){0.f, 0.f, 0.f, 0.f};
#pragma unroll
            for (int kb = 0; kb < 4; ++kb) { const bf16x4 a0 = *(const LAS bf16x4*)(qi + (16 * tt + n) * 136 + 32 * kb + quad * 4), a1 = *(const LAS bf16x4*)(qi + (16 * tt + n) * 136 + 32 * kb + 16 + quad * 4);
                acc[tt] = MFMA(__builtin_shufflevector(a0, a1, 0, 1, 2, 3, 4, 5, 6, 7), Sb[kb], acc[tt]); } }
#pragma unroll
        for (int k8 = 0; k8 < 8; ++k8) { const f32x4 c4 = *(const LAS f32x4*)(e63 + 16 * k8 + quad * 4);
            f32x4 sv = S[k8] * c4;
#pragma unroll
            for (int sb = 0; sb < 2; ++sb) { const bf16x8 a = *(const LAS bf16x8*)(keT + (16 * k8 + n) * 72 + 32 * sb + quad * 8); sv = MFMA(a, vB[sb], sv); }
            S[k8] = sv; }
#pragma unroll
        for (int tt = 0; tt < 4; ++tt)
#pragma unroll
            for (int j = 0; j < 4; ++j) { const int ti = 16 * tt + quad * 4 + j; if (!dry) O[(size_t)(rowb + (dir ? 63 - ti : ti)) * 512 + head * 128 + 16 * w + n] = f2bf(acc[tt][j] + bf2f(oin[tt][j])); }
    }
    __syncthreads();
}

__device__ __forceinline__ void hgrn_combine(const Ctx& p, int e) {
    const int lane = mk_tid() & 63, wg = blockIdx.x * 8 + (mk_tid() >> 6), nw = gridDim.x * 8;
    const bf16_t* P = (const bf16_t*)(p.ws + WS_P); const unsigned* OF = (const unsigned*)(p.ws + WS_OF); const unsigned* OB = (const unsigned*)(p.ws + WS_OB);
    unsigned* MX = (unsigned*)(p.ws + WS_A); const float* on = p.in[23] + e * 128;
    const float g0 = on[lane * 2], g1 = on[lane * 2 + 1];
    for (int row = wg; row < MT; row += nw) {
        unsigned a[4], bq[4], gg[4];
#pragma unroll
        for (int h = 0; h < 4; ++h) { a[h] = OF[(size_t)row * 256 + h * 64 + lane]; bq[h] = OB[(size_t)row * 256 + h * 64 + lane]; gg[h] = *(const unsigned*)(P + (size_t)row * 3072 + 2560 + h * 128 + lane * 2); }
#pragma unroll
        for (int h = 0; h < 4; ++h) {
            const float v0 = bflo(a[h]) + bflo(bq[h]), v1 = bfhi(a[h]) + bfhi(bq[h]); const float ss = wsum(v0 * v0 + v1 * v1); const float rs = rsqrtf(ss * (1.0f / 128.0f) + 1e-6f);
            MX[(size_t)row * 512 + 256 + h * 64 + lane] = pk2(v0 * rs * g0 * siluf(bflo(gg[h])), v1 * rs * g1 * siluf(bfhi(gg[h]))); }
    }
}

__device__ __forceinline__ void odd_post1(const Ctx& p, int o) {
    const int lane = mk_tid() & 63, wg = blockIdx.x * 8 + (mk_tid() >> 6), nw = gridDim.x * 8;
    bf16_t* P = (bf16_t*)(p.ws + WS_P); bf16_t* A23 = (bf16_t*)(p.ws + WS_A);
    const float* rope = (const float*)(p.ws + WS_ROPE);
    const float nq = p.in[26][o * 128 + lane], nk = p.in[26][o * 128 + 64 + lane], nr = p.in[33][o * 128 + 64 + lane];
    float gq[6], gk[4];
#pragma unroll
    for (int i = 0; i < 6; ++i) gq[i] = p.in[28][o * 384 + lane + 64 * i];
#pragma unroll
    for (int i = 0; i < 4; ++i) gk[i] = p.in[29][o * 256 + lane + 64 * i];
    const int ax = lane >> 5, f = lane & 15, hh = (lane >> 4) & 1;
    for (int row = wg; row < MT; row += nw) {
        bf16_t* pr = P + (size_t)row * 2304; const bool lat = row < ML; const int tk = row & 2047; const int pos = ax ? (tk & 63) : (tk >> 6);
        const float cs = rope[(pos * 16 + f) * 2], sn = rope[(pos * 16 + f) * 2 + 1];
        float x[17], xq[6], xk[4];
#pragma unroll
        for (int v = 0; v < 17; ++v) x[v] = bf2f(pr[(v < 16 ? v * 64 : 2176) + lane]);
#pragma unroll
        for (int i = 0; i < 6; ++i) xq[i] = bf2f(pr[1536 + lane + 64 * i]);
#pragma unroll
        for (int i = 0; i < 4; ++i) xk[i] = bf2f(pr[1920 + lane + 64 * i]);
#pragma unroll
        for (int v = 0; v < 17; ++v) { const float gn = v < 8 ? nq : (v < 16 ? nk : nr);
            const float ss = wsum(x[v] * x[v]); float y = x[v] * rsqrtf(ss * (1.0f / 64.0f) + 1e-6f) * gn;
            if (lat) { const float pt = __shfl_xor(y, 16); y = y * cs + (hh ? pt : -pt) * sn; }
            if (v < 8) y *= 0.125f * 1.4426950408889634f;
            pr[(v < 16 ? v * 64 : 2176) + lane] = f2bf(y); }
        { float ss = 0.f;
#pragma unroll
          for (int i = 0; i < 6; ++i) ss += xq[i] * xq[i];
          ss = wsum(ss); const float rs = rsqrtf(ss * (1.0f / 384.0f) + 1e-6f);
#pragma unroll
          for (int i = 0; i < 6; ++i) A23[(size_t)row * 640 + lane + 64 * i] = f2bf(xq[i] * rs * gq[i]); }
        { float ss = 0.f;
#pragma unroll
          for (int i = 0; i < 4; ++i) ss += xk[i] * xk[i];
          ss = wsum(ss); const float rs = rsqrtf(ss * (1.0f / 256.0f) + 1e-6f);
#pragma unroll
          for (int i = 0; i < 4; ++i) A23[(size_t)row * 640 + 384 + lane + 64 * i] = f2bf(xk[i] * rs * gk[i]); }
    }
}
__device__ __forceinline__ void odd_post2(const Ctx& p, int o) {
    const int lane = mk_tid() & 63, wg = blockIdx.x * 8 + (mk_tid() >> 6), nw = gridDim.x * 8;
    bf16_t* UQ = (bf16_t*)(p.ws + WS_U); bf16_t* UKV = UQ + 768;
    const float* rope = (const float*)(p.ws + WS_ROPE);
    const float qn0 = p.in[32][o * 256 + lane], qn1 = p.in[32][o * 256 + 64 + lane], kn0 = p.in[32][o * 256 + 128 + lane], kn1 = p.in[32][o * 256 + 192 + lane], rn = p.in[33][o * 128 + lane];
    const int ax = lane >> 5, f = lane & 15, hh = (lane >> 4) & 1; const float scl = 0.07216878364870322f * 1.4426950408889634f;
    for (int row = wg; row < MT; row += nw) {
        const bool lat = row < ML; const int tk = row & 2047; const int pos = ax ? (tk & 63) : (tk >> 6);
        const float cs = rope[(pos * 16 + f) * 2], sn = rope[(pos * 16 + f) * 2 + 1];
        bf16_t* uq = UQ + (size_t)row * 1792; bf16_t* ukv = UKV + (size_t)row * 1792;
        float a0[4], a1[4], ar[4], k0[4], k1[4];
#pragma unroll
        for (int h = 0; h < 4; ++h) { a0[h] = bf2f(uq[h * 192 + lane]); a1[h] = bf2f(uq[h * 192 + 64 + lane]); ar[h] = bf2f(uq[h * 192 + 128 + lane]); k0[h] = bf2f(ukv[h * 256 + lane]); k1[h] = bf2f(ukv[h * 256 + 64 + lane]); }
#pragma unroll
        for (int h = 0; h < 4; ++h) {
            { const float ss = wsum(a0[h] * a0[h] + a1[h] * a1[h]); const float rs = rsqrtf(ss * (1.0f / 128.0f) + 1e-6f) * scl;
              uq[h * 192 + lane] = f2bf(a0[h] * rs * qn0); uq[h * 192 + 64 + lane] = f2bf(a1[h] * rs * qn1); }
            { const float ss = wsum(ar[h] * ar[h]); float y = ar[h] * rsqrtf(ss * (1.0f / 64.0f) + 1e-6f) * rn;
              if (lat) { const float pt = __shfl_xor(y, 16); y = y * cs + (hh ? pt : -pt) * sn; }
              uq[h * 192 + 128 + lane] = f2bf(y * scl); }
            { const float ss = wsum(k0[h] * k0[h] + k1[h] * k1[h]); const float rs = rsqrtf(ss * (1.0f / 128.0f) + 1e-6f);
              ukv[h * 256 + lane] = f2bf(k0[h] * rs * kn0); ukv[h * 256 + 64 + lane] = f2bf(k1[h] * rs * kn1); }
        }
    }
}

constexpr int AT_VT = 25600, AT_VRS = 288;
typedef short s16x4 __attribute__((ext_vector_type(4)));
template <int OFF> __device__ __forceinline__ s16x4 tr_read(unsigned vb) { s16x4 r; asm volatile("ds_read_b64_tr_b16 %0, %1 offset:%2" : "=&v"(r) : "v"(vb), "i"(OFF) : "memory"); return r; }
template <int DT> __device__ __forceinline__ void pv_pair(f32x4 (&O)[8][2], unsigned vb, const bf16x8 (&Pf)[2][2]) {
    const s16x4 a00 = tr_read<(0) * AT_VRS + DT * 32>(vb), a01 = tr_read<(16) * AT_VRS + DT * 32>(vb), a10 = tr_read<(32) * AT_VRS + DT * 32>(vb), a11 = tr_read<(48) * AT_VRS + DT * 32>(vb);
    const s16x4 b00 = tr_read<(0) * AT_VRS + (DT + 1) * 32>(vb), b01 = tr_read<(16) * AT_VRS + (DT + 1) * 32>(vb), b10 = tr_read<(32) * AT_VRS + (DT + 1) * 32>(vb), b11 = tr_read<(48) * AT_VRS + (DT + 1) * 32>(vb);
    asm volatile("s_waitcnt lgkmcnt(0)" ::: "memory"); __builtin_amdgcn_sched_barrier(0);
#define PK8(L, H) (bf16x8){L[0], L[1], L[2], L[3], H[0], H[1], H[2], H[3]}
    const bf16x8 va0 = PK8(a00, a01), va1 = PK8(a10, a11), vb0 = PK8(b00, b01), vb1 = PK8(b10, b11);
#undef PK8
    O[DT][0] = MFMA(va0, Pf[0][0], O[DT][0]); O[DT][1] = MFMA(va0, Pf[1][0], O[DT][1]); O[DT + 1][0] = MFMA(vb0, Pf[0][0], O[DT + 1][0]); O[DT + 1][1] = MFMA(vb0, Pf[1][0], O[DT + 1][1]);
    O[DT][0] = MFMA(va1, Pf[0][1], O[DT][0]); O[DT][1] = MFMA(va1, Pf[1][1], O[DT][1]); O[DT + 1][0] = MFMA(vb1, Pf[0][1], O[DT + 1][0]); O[DT + 1][1] = MFMA(vb1, Pf[1][1], O[DT + 1][1]);
}
constexpr int AT_BUF = 45056;
template <int DQ, int K1W>
__device__ __forceinline__ void attn_core(LAS unsigned char* lds, const bf16_t* __restrict__ Q, int qld, int qrow0, const bf16_t* __restrict__ K1, int k1ld,
                                          const bf16_t* __restrict__ K2, int k2ld, const bf16_t* __restrict__ V, int vld, int b, int ntiles, float mref, f32x4 (&O)[8][2]) {
    constexpr int NDK = DQ / 32, KP = DQ + 8, NKL = DQ / 64, C8 = DQ / 8;
    const int tid = mk_tid(), w = __builtin_amdgcn_readfirstlane(tid >> 6), lane = tid & 63, n = lane & 15, quad = lane >> 4;
    const unsigned vb0 = (unsigned)(size_t)(lds + AT_VT) + (unsigned)((quad * 4 + (n >> 2)) * AT_VRS + (n & 3) * 8);
    bf16x8 Qf[2][NDK];
#pragma unroll
    for (int qt = 0; qt < 2; ++qt)
#pragma unroll
        for (int dk = 0; dk < NDK; ++dk) Qf[qt][dk] = *(const bf16x8*)(Q + (size_t)(qrow0 + w * 32 + qt * 16 + n) * qld + dk * 32 + quad * 8);
    float lrun[2] = {0.f, 0.f};
#pragma unroll
    for (int dt = 0; dt < 8; ++dt) { O[dt][0] = (f32x4){0.f, 0.f, 0.f, 0.f}; O[dt][1] = (f32x4){0.f, 0.f, 0.f, 0.f}; }
    u32x4 kr[NKL], vr[2];
    auto issue = [&](int ktile) {
        const int rowb = ktile < 4 ? ML + b * 256 + ktile * 64 : b * 2048 + (ktile - 4) * 64;
#pragma unroll
        for (int i = 0; i < NKL; ++i) { const int idx = tid + i * 512, key = idx / C8, d0 = (idx % C8) * 8;
            const bf16_t* src = d0 < K1W ? K1 + (size_t)(rowb + key) * k1ld + d0 : K2 + (size_t)(rowb + key) * k2ld + (d0 - K1W);
            kr[i] = *(const u32x4*)src; }
#pragma unroll
        for (int i = 0; i < 2; ++i) { const int idx = tid + i * 512, key = idx >> 4, d0 = (idx & 15) * 8; vr[i] = *(const u32x4*)(V + (size_t)(rowb + key) * vld + d0); }
    };
    auto stage = [&](int bufi) { LAS bf16_t* Ks = (LAS bf16_t*)(lds + bufi * AT_BUF); LAS bf16_t* Vs = (LAS bf16_t*)(lds + bufi * AT_BUF + AT_VT);
#pragma unroll
        for (int i = 0; i < NKL; ++i) { const int idx = tid + i * 512, key = idx / C8, d0 = (idx % C8) * 8; *(LAS u32x4*)(Ks + key * KP + d0) = kr[i]; }
#pragma unroll
        for (int i = 0; i < 2; ++i) { const int idx = tid + i * 512, key = idx >> 4, d0 = (idx & 15) * 8; *(LAS u32x4*)(Vs + key * (AT_VRS / 2) + d0) = vr[i]; } };
    issue(0);
    __syncthreads();
    stage(0);
    if (ntiles > 1) issue(1);
    __syncthreads();
#pragma unroll 1
    for (int ktile = 0; ktile < ntiles; ++ktile) {
        const int bufi = ktile & 1;
        LAS bf16_t* Ks = (LAS bf16_t*)(lds + bufi * AT_BUF);
        const unsigned vb = vb0 + (unsigned)(bufi * AT_BUF);
        f32x4 s[4][2];
#pragma unroll
        for (int st = 0; st < 4; ++st) { s[st][0] = (f32x4){0.f, 0.f, 0.f, 0.f}; s[st][1] = (f32x4){0.f, 0.f, 0.f, 0.f};
#pragma unroll
            for (int dk = 0; dk < NDK; ++dk) { const bf16x8 a = *(const LAS bf16x8*)(Ks + (16 * st + n) * KP + 32 * dk + quad * 8);
                s[st][0] = MFMA(a, Qf[0][dk], s[st][0]); s[st][1] = MFMA(a, Qf[1][dk], s[st][1]); }
            asm volatile("" ::: "memory"); }
        bf16x8 Pf[2][2];
#pragma unroll
        for (int qt = 0; qt < 2; ++qt) {
            f32x4 ls4 = {0.f, 0.f, 0.f, 0.f};
#pragma unroll
            for (int st = 0; st < 4; ++st) { const f32x4 d = s[st][qt] - mref; f32x4 e;
#pragma unroll
                for (int j = 0; j < 4; ++j) e[j] = __builtin_amdgcn_exp2f(d[j]);
                s[st][qt] = e; ls4 += e; }
            lrun[qt] += (ls4[0] + ls4[1]) + (ls4[2] + ls4[3]);
#pragma unroll
            for (int kb = 0; kb < 2; ++kb) Pf[qt][kb] = mk8(pk2(s[2 * kb][qt][0], s[2 * kb][qt][1]), pk2(s[2 * kb][qt][2], s[2 * kb][qt][3]), pk2(s[2 * kb + 1][qt][0], s[2 * kb + 1][qt][1]), pk2(s[2 * kb + 1][qt][2], s[2 * kb + 1][qt][3]));
        }
        pv_pair<0>(O, vb, Pf); pv_pair<2>(O, vb, Pf); pv_pair<4>(O, vb, Pf); pv_pair<6>(O, vb, Pf);
        if (ktile + 1 < ntiles) { stage(bufi ^ 1); if (ktile + 2 < ntiles) issue(ktile + 2); }
        __syncthreads();
    }
#pragma unroll
    for (int qt = 0; qt < 2; ++qt) { float l = lrun[qt]; l += __shfl_xor(l, 16); l += __shfl_xor(l, 32); const float inv = rcpf_(l);
#pragma unroll
        for (int dt = 0; dt < 8; ++dt) O[dt][qt] *= inv; }
}

__device__ __forceinline__ void attn_phase(const Ctx& p, int o, int l, bool need_ctx, LAS unsigned char* lds) {
    const int lane = mk_tid() & 63;
    const bf16_t* P = (const bf16_t*)(p.ws + WS_P); const bf16_t* UQ = (const bf16_t*)(p.ws + WS_U); const bf16_t* UKV = UQ + 768;
    bf16_t* MX = (bf16_t*)(p.ws + WS_A);
    const float lam_init = l == 1 ? 0.35550906759f : 0.55605820416f;
    float lam;
    { const float* lv = p.in[25] + o * 256; const float d1 = wsum(lv[lane] * lv[64 + lane]), d2 = wsum(lv[128 + lane] * lv[192 + lane]);
      lam = __uint_as_float(__builtin_amdgcn_readfirstlane(__float_as_uint(expf(d1) - expf(d2) + lam_init))); }
    float mref_d, mref_m;
    { const float L2E = 1.4426950408889634f;
      float gq = fabsf(p.in[26][o * 128 + lane]), gk = fabsf(p.in[26][o * 128 + 64 + lane]);
      float n0a = fmaxf(fabsf(p.in[32][o * 256 + lane]), fabsf(p.in[32][o * 256 + 64 + lane])), n1a = fmaxf(fabsf(p.in[32][o * 256 + 128 + lane]), fabsf(p.in[32][o * 256 + 192 + lane]));
      float r0 = fabsf(p.in[33][o * 128 + lane]), r1 = fabsf(p.in[33][o * 128 + 64 + lane]);
#pragma unroll
      for (int off = 32; off >= 1; off >>= 1) { gq = fmaxf(gq, __shfl_xor(gq, off)); gk = fmaxf(gk, __shfl_xor(gk, off)); n0a = fmaxf(n0a, __shfl_xor(n0a, off)); n1a = fmaxf(n1a, __shfl_xor(n1a, off)); r0 = fmaxf(r0, __shfl_xor(r0, off)); r1 = fmaxf(r1, __shfl_xor(r1, off)); }
      mref_d = __uint_as_float(__builtin_amdgcn_readfirstlane(__float_as_uint(64.0f * gq * gk * 0.125f * L2E * 1.01f + 0.5f)));
      mref_m = __uint_as_float(__builtin_amdgcn_readfirstlane(__float_as_uint(sqrtf((128.f * n0a * n0a + 64.f * r0 * r0) * (128.f * n1a * n1a + 64.f * r1 * r1)) * 0.07216878364870322f * L2E * 1.01f + 0.5f))); }
    const int nunits = need_ctx ? 576 : 512;
#pragma unroll 1
    for (int u = blockIdx.x; u < nunits; u += gridDim.x) {
        const bool isctx = u >= 512; const int uu = isctx ? u - 512 : u;
        const bool mla = isctx ? (uu < 32) : (uu < 256); const int v = isctx ? (uu & 31) : (uu & 255);
        int b, head, qb;
        if (isctx) { b = v >> 2; head = v & 3; qb = 0; } else { b = v >> 5; head = (v >> 3) & 3; qb = v & 7; }
        const int qrow0 = isctx ? ML + b * 256 : b * 2048 + qb * 256; const int ntiles = isctx ? 4 : 36;
        f32x4 O[8][2];
        if (mla) {
            attn_core<192, 128>(lds, UQ + head * 192, 1792, qrow0, UKV + head * 256, 1792, P + 2176, 2304, UKV + head * 256 + 128, 1792, b, ntiles, mref_m, O);
            const int t3 = mk_tid(), w = t3 >> 6, n = t3 & 15, quad = (t3 & 63) >> 4;
#pragma unroll
            for (int qt = 0; qt < 2; ++qt) { const size_t row = (size_t)(qrow0 + w * 32 + qt * 16 + n);
#pragma unroll
                for (int dt = 0; dt < 8; ++dt) { u32x2 ww; ww.x = pk2(O[dt][qt][0], O[dt][qt][1]); ww.y = pk2(O[dt][qt][2], O[dt][qt][3]); *(u32x2*)(MX + row * 1024 + 512 + head * 128 + 16 * dt + quad * 4) = ww; } }
        } else {
            LAS u32x2* O1s = (LAS u32x2*)(lds + 2 * AT_BUF) + mk_tid();
            attn_core<64, 64>(lds, P + head * 128, 2304, qrow0, P + 512 + head * 128, 2304, P, 2304, P + 1024 + head * 128, 2304, b, ntiles, mref_d, O);
#pragma unroll
            for (int dt = 0; dt < 8; ++dt)
#pragma unroll
                for (int qt = 0; qt < 2; ++qt) { u32x2 t2; t2.x = pk2(O[dt][qt][0], O[dt][qt][1]); t2.y = pk2(O[dt][qt][2], O[dt][qt][3]); O1s[(dt * 2 + qt) * 512] = t2; }
            attn_core<64, 64>(lds, P + head * 128 + 64, 2304, qrow0, P + 512 + head * 128 + 64, 2304, P, 2304, P + 1024 + head * 128, 2304, b, ntiles, mref_d, O);
            const float* sl = p.in[27] + o * 128; const int t3 = mk_tid(), w = t3 >> 6, n = t3 & 15, quad = (t3 & 63) >> 4, quad2 = quad;
#pragma unroll
            for (int qt = 0; qt < 2; ++qt) { const size_t row = (size_t)(qrow0 + w * 32 + qt * 16 + n); float ss = 0.f;
#pragma unroll
                for (int dt = 0; dt < 8; ++dt) { { const u32x2 t2 = O1s[(dt * 2 + qt) * 512]; O[dt][qt] = (f32x4){bflo(t2.x), bfhi(t2.x), bflo(t2.y), bfhi(t2.y)} - lam * O[dt][qt]; } ss += O[dt][qt][0] * O[dt][qt][0] + O[dt][qt][1] * O[dt][qt][1] + O[dt][qt][2] * O[dt][qt][2] + O[dt][qt][3] * O[dt][qt][3]; }
                ss += __shfl_xor(ss, 16); ss += __shfl_xor(ss, 32); const float rs = rsqrtf(ss * (1.0f / 128.0f) + 1e-6f) * (1.0f - lam_init);
#pragma unroll
                for (int dt = 0; dt < 8; ++dt) { const f32x4 g = *(const f32x4*)(sl + 16 * dt + quad2 * 4); u32x2 ww; ww.x = pk2(O[dt][qt][0] * rs * g[0], O[dt][qt][1] * rs * g[1]); ww.y = pk2(O[dt][qt][2] * rs * g[2], O[dt][qt][3] * rs * g[3]);
                    *(u32x2*)(MX + row * 1024 + head * 128 + 16 * dt + quad * 4) = ww; } }
        }
    }
}

#ifdef REP_PH
#define HG_DRY (reps == 0 && ph == REP_PH)
#else
#define HG_DRY false
#endif
#ifdef GONLY
#define GSEL(k) && (GONLY == k)
#else
#define GSEL(k)
#endif
__global__ void __launch_bounds__(512) mega(Params kp) {
    extern __shared__ __attribute__((aligned(16))) unsigned char shm[];
    LAS unsigned char* lds = (LAS unsigned char*)shm;
    cg::grid_group grid = cg::this_grid();
    { const float** tabw = (const float**)(kp.ws + WS_TAB); const int t = threadIdx.x; if (t < 34) tabw[t] = kp.in[t]; }
    volatile LAS unsigned* bst = (volatile LAS unsigned*)(lds + LDS_BYTES - 256);
    if (threadIdx.x < 2) bst[threadIdx.x] = 0u;
    __syncthreads();
    const XcdBarrier xbar = xcd_barrier_post((unsigned*)(kp.ws + WS_BAR), bst);
    const int ph_hi = kp.ph_hi;
#ifdef REP_PH
    int reps = 0;
#endif
#pragma unroll 1
    for (int ph = kp.ph_lo; ph < ph_hi; ++ph) {
        unsigned char* ws = kp.ws; asm volatile("" : "+s"(ws));
        Ctx p; p.ws = ws; p.in = (const float* const*)(ws + WS_TAB); p.out = kp.out;
        const int bid = blockIdx.x, nb = gridDim.x, w = __builtin_amdgcn_readfirstlane(mk_tid() >> 6);
        if (ph == 0) {
#if !defined(ONLY) || ONLY==0

#if defined(REP_PH) && defined(REP_PART)
 prep_phase(p, lds, reps ? REP_PART : 0);
#else
 prep_phase(p, lds, 0);
#endif
#endif
 }
        else if (ph == 1) prep2_phase(p, lds);
        else {
            const int l = (ph - 2) / 10, s = (ph - 2) % 10, eo = l >> 1;
            if (s == 0 || s == 7) continue;
            float* SS = (float*)(ws + WS_SS); const float* BIAS = (const float*)(ws + WS_BIAS) + (size_t)l * 9 * 8704; const bool odd = l & 1; const bool need_ctx = l < 3; const int Mres = need_ctx ? MT : ML;
            const float* mod = (const float*)(ws + WS_MOD) + (size_t)l * 9 * 6144;
            const bf16_t* Abuf = (const bf16_t*)(ws + WS_A);
            if (s == 1) {
#if !defined(ONLY) || ONLY==4
                EpiStore<true> E; E.O = (bf16_t*)(ws + WS_P); E.ss = SS + (size_t)(2 * l) * MT; E.bias = BIAS;
                if (!odd) { E.ldc = 3072; run_gemm(lds, Abuf, (const bf16_t*)(ws + WS_WAB) + (size_t)eo * 3072 * 1024, MT, 3072, 1024, E); }
                else { E.ldc = 2304; run_gemm(lds, Abuf, (const bf16_t*)(ws + WS_WCD) + (size_t)eo * 2304 * 1024, MT, 2304, 1024, E); }
#endif
            }
            else if (s == 2) {
                if (!odd) {
#if !defined(ONLY) || ONLY==1
                    for (int u = bid; u < 1152; u += nb) hg_pre_unit(p, eo, u, lds, HG_DRY);
                    if (!HG_DRY)
#endif
#if !defined(ONLY) || ONLY==2
                    for (int u = w * nb + bid; u < 1152; u += 8 * nb) s5_unit<1>(p, eo, u / 36, u % 36, lds);
#endif
                } else odd_post1(p, eo);
            }
            else if (s == 3) {
                if (!odd) s5_carry(p, eo);
                else {
#if !defined(ONLY) || ONLY==4
                    EpiStore<false> E; E.O = (bf16_t*)(ws + WS_U); E.ldc = 1792; E.ss = nullptr; E.bias = nullptr; run_gemm(lds, Abuf, (const bf16_t*)(ws + WS_WU) + (size_t)eo * 1792 * 640, MT, 1792, 640, E);
#endif
                }
            }
            else if (s == 4) {
                if (!odd) {
                    const bool split = nb >= 128;
#if !defined(ONLY) || ONLY==1
                    for (int chn = bid; chn < 64; chn += nb) hgrn_chain2(p, chn, lds, HG_DRY);
                    if (!HG_DRY)
#endif
#if !defined(ONLY) || ONLY==2
                    if (!split || bid >= 64) { const int nbb = split ? nb - 64 : nb, bb = split ? bid - 64 : bid;
                        for (int u = w * nbb + bb; u < 1152; u += 8 * nbb) s5_unit<2>(p, eo, u / 36, u % 36, lds); }
#endif
                } else odd_post2(p, eo);
            }
            else if (s == 5) {
                if (!odd) {
#if !defined(ONLY) || ONLY==4
                    EpiGLU E; E.MX = (bf16_t*)(ws + WS_A); E.Z = (const bf16_t*)(ws + WS_Z); E.bias = p.in[21] + eo * 512;
                    run_gemm(lds, (const bf16_t*)(ws + WS_Z), (const bf16_t*)(ws + WS_WGLU) + (size_t)eo * 512 * 512, MT, 512, 512, E);
                    __syncthreads();
#endif
                    hgrn_combine(p, eo);
                } else {
#if !defined(ONLY) || ONLY==3
                    attn_phase(p, eo, l, need_ctx, lds);
#endif
                }
            }
            else if (s == 6 || s == 9) {
#if !defined(ONLY) || ONLY==4
                EpiRes E; E.H = (float*)(ws + WS_H); E.gate = mod + (s == 6 ? 2 : 5) * 1024; E.out = (l == 3 && s == 9) ? p.out : nullptr;
                if (s == 6) { E.Hb = (bf16_t*)(ws + WS_HB1); E.gn = p.in[7] + l * 1024; E.scn = mod + 4 * 1024; E.ss = SS + (size_t)(2 * l + 1) * MT; }
                else if (l < 3) { E.Hb = (bf16_t*)(ws + WS_A); E.gn = p.in[6] + (l + 1) * 1024; E.scn = mod + 9 * 6144 + 1024; E.ss = SS + (size_t)(2 * l + 2) * MT; }
                else { E.Hb = nullptr; E.gn = nullptr; E.scn = nullptr; E.ss = nullptr; }
                if (s == 6) run_gemm(lds, Abuf, (const bf16_t*)(ws + WS_WO) + (size_t)l * 1024 * 1024, Mres, 1024, 1024, E);
                else run_gemm(lds, (const bf16_t*)(ws + WS_P), (const bf16_t*)(ws + WS_WFO) + (size_t)l * 1024 * 2816, Mres, 1024, 2816, E);
#endif
            }
            else if (s == 8) {
#if !defined(ONLY) || ONLY==4
                EpiSwiGLU E; E.G = (bf16_t*)(ws + WS_P); E.ss = SS + (size_t)(2 * l + 1) * MT; E.bias = BIAS + 3072;
                run_gemm(lds, (const bf16_t*)(ws + WS_HB1), (const bf16_t*)(ws + WS_WFI) + (size_t)l * 5632 * 1024, Mres, 5632, 1024, E);
#endif
            }
        }
        if (ph + 1 < ph_hi) { if (ph_hi > 1000) grid.sync(); else xcd_barrier(xbar); }
#ifdef EXTRA_SYNC
        if (ph == 0) { for (int q = 0; q < 32; ++q) xcd_barrier(xbar); }
#endif
#ifdef REP_PH
        if (ph == REP_PH && reps < 1) { ++reps; --ph; }
#endif
    }
}

extern "C" void kernel_launch(void* const* d_in, const int* in_sizes, int n_in, void* d_out, int out_size, void* d_ws, size_t ws_size, hipStream_t stream) {
    static int grid = 0;
    if (grid == 0) {
        if (n_in != 34 || ws_size < WS_NEED) { fprintf(stderr, "kernel_launch: unexpected n_in %d / ws_size %zu (need %zu)\n", n_in, ws_size, (size_t)WS_NEED); }
        int dev = 0, cus = 0, per_cu = 0;
        hipGetDevice(&dev); hipDeviceGetAttribute(&cus, hipDeviceAttributeMultiprocessorCount, dev);
        hipFuncSetAttribute((const void*)mega, hipFuncAttributeMaxDynamicSharedMemorySize, LDS_BYTES);
        hipOccupancyMaxActiveBlocksPerMultiprocessor(&per_cu, (const void*)mega, 512, LDS_BYTES);
        (void)hipGetLastError();
        if (per_cu < 1) fprintf(stderr, "kernel_launch: occupancy query says %d blocks per CU\n", per_cu);
        grid = cus > 0 ? cus : 256;
    }
    hipMemsetAsync((char*)d_ws + WS_SS, 0, 8ull * MT * 4 + XCD_BAR_WORDS * 4, stream);
    Params p{};
    for (int i = 0; i < 34; ++i) p.in[i] = (const float*)d_in[i];
    p.out = (float*)d_out; p.ws = (unsigned char*)d_ws;
#if MK_MODE == 0
    p.ph_lo = 0; p.ph_hi = NPH;
    void* args[] = {&p};
    hipError_t e = hipLaunchCooperativeKernel((const void*)mega, dim3(grid), dim3(512), args, LDS_BYTES, stream);
    if (e != hipSuccess) fprintf(stderr, "cooperative launch failed: %s (grid %d)\n", hipGetErrorString(e), grid);
#else
    for (int ph = 0; ph < NPH; ++ph) { p.ph_lo = ph; p.ph_hi = ph + 1; hipLaunchKernelGGL(mega, dim3(grid), dim3(512), LDS_BYTES, stream, p); }
#endif
}
```
